# Optimizing an MI355X kernel written in HIP

```python
import jax, jax.numpy as jnp
from jax import lax
import numpy as np

D_MODEL = 4096
BATCH = 1
SEQ = 16384
DEPTH = 1

N_ATTN_HEADS = 16
HEAD_DIM = 128
D_ATTN = N_ATTN_HEADS * HEAD_DIM
MOBA_BLOCK = 256
MOBA_TOPK = 3
QUERY_CHUNK = 64
ROPE_THETA = 10000.0
D_CONV = 2048
CONV_GROUPS = 16
CONV_WIDTH = 3
D_FF = 11008
FFN_CONV_WIDTH = 3
D_PLE = 256
N_BRANCHES = 2
RMS_EPS = 1e-6
IN_SPLITS = (D_ATTN, D_ATTN, D_ATTN, D_CONV, D_CONV, D_CONV, D_MODEL, D_MODEL)
D_IN_PROJ = sum(IN_SPLITS)

kernel_name = "hybrid_moba_shortconv_convffn_block"


def rms_norm(x, g):
    xf = x.astype(jnp.float32)
    y = xf * lax.rsqrt(jnp.mean(xf * xf, axis=-1, keepdims=True) + RMS_EPS)
    return (y * g.astype(jnp.float32)).astype(x.dtype)


def causal_dwconv(x, w):
    width = w.shape[0]
    s = x.shape[1]
    xp = jnp.pad(x, ((0, 0), (width - 1, 0), (0, 0)))
    y = w[width - 1] * x
    for j in range(width - 1):
        y = y + w[j] * xp[:, j:j + s]
    return y


def rope(x, positions):
    half = x.shape[-1] // 2
    inv_freq = ROPE_THETA ** (-jnp.arange(half, dtype=jnp.float32) / half)
    ang = positions.astype(jnp.float32)[:, None, :, None] * inv_freq
    cos, sin = jnp.cos(ang), jnp.sin(ang)
    xf = x.astype(jnp.float32)
    x1, x2 = xf[..., :half], xf[..., half:]
    return jnp.concatenate([x1 * cos - x2 * sin, x2 * cos + x1 * sin], axis=-1).astype(x.dtype)


def moba_attention(q, k, v):
    b, h, s, d = q.shape
    nb = -(-s // MOBA_BLOCK)
    s_pad = nb * MOBA_BLOCK
    topk = min(MOBA_TOPK, nb)
    pad = ((0, 0), (0, 0), (0, s_pad - s), (0, 0))
    kp = jnp.pad(k, pad)
    vp = jnp.pad(v, pad)
    k_blocks = kp.reshape(b, h, nb, MOBA_BLOCK, d)
    v_blocks = vp.reshape(b, h, nb, MOBA_BLOCK, d)
    k_mean = jnp.mean(k_blocks.astype(jnp.float32), axis=3).astype(k.dtype)
    scale = d ** -0.5
    n_chunks = s // QUERY_CHUNK
    b_idx = jnp.arange(b)[:, None, None, None]
    h_idx = jnp.arange(h)[None, :, None, None]
    blk_ids = jnp.arange(nb)

    def chunk(c):
        q0 = c * QUERY_CHUNK
        qb = q0 // MOBA_BLOCK
        qc = lax.dynamic_slice_in_dim(q, q0, QUERY_CHUNK, axis=2)
        qpos = q0 + jnp.arange(QUERY_CHUNK)
        gate = jnp.einsum('bhqd,bhnd->bhqn', qc, k_mean).astype(jnp.float32)
        gate = jnp.where(blk_ids < qb, gate, -jnp.inf)
        _, idx = lax.top_k(gate, topk)
        sel_valid = idx < qb
        k_sel = k_blocks[b_idx, h_idx, idx]
        v_sel = v_blocks[b_idx, h_idx, idx]
        s_sel = jnp.einsum('bhqd,bhqjkd->bhqjk', qc, k_sel).astype(jnp.float32) * scale
        s_sel = jnp.where(sel_valid[..., None], s_sel, -jnp.inf)
        s_sel = s_sel.reshape(b, h, QUERY_CHUNK, topk * MOBA_BLOCK)
        own0 = qb * MOBA_BLOCK
        k_own = lax.dynamic_slice_in_dim(kp, own0, MOBA_BLOCK, axis=2)
        v_own = lax.dynamic_slice_in_dim(vp, own0, MOBA_BLOCK, axis=2)
        s_own = jnp.einsum('bhqd,bhkd->bhqk', qc, k_own).astype(jnp.float32) * scale
        kpos = own0 + jnp.arange(MOBA_BLOCK)
        s_own = jnp.where(kpos[None, :] <= qpos[:, None], s_own, -jnp.inf)
        probs = jax.nn.softmax(jnp.concatenate([s_sel, s_own], axis=-1), axis=-1)
        p_sel = probs[..., :topk * MOBA_BLOCK].reshape(b, h, QUERY_CHUNK, topk, MOBA_BLOCK).astype(v.dtype)
        p_own = probs[..., topk * MOBA_BLOCK:].astype(v.dtype)
        return (jnp.einsum('bhqjk,bhqjkd->bhqd', p_sel, v_sel)
                + jnp.einsum('bhqk,bhkd->bhqd', p_own, v_own))

    outs = lax.map(chunk, jnp.arange(n_chunks))
    return outs.transpose(1, 2, 0, 3, 4).reshape(b, h, s, d)


def setup_inputs(seed: int = 0) -> dict:
    key = jax.random.key(seed)
    ks = jax.random.split(key, 17)
    f32 = jnp.float32

    def nrm(k, shape, fan_in):
        return jax.random.normal(k, shape, f32) * (fan_in ** -0.5)

    def gain(k, shape):
        return 1.0 + 0.05 * jax.random.normal(k, shape, f32)

    return {
        "x": jax.random.normal(ks[0], (BATCH, SEQ, D_MODEL), f32),
        "p": jax.random.normal(ks[1], (DEPTH, BATCH, SEQ, D_PLE), f32),
        "positions": jnp.broadcast_to(jnp.arange(SEQ, dtype=jnp.int32), (BATCH, SEQ)),
        "w_norm_mix": gain(ks[2], (DEPTH, D_MODEL)),
        "w_in": nrm(ks[3], (DEPTH, D_MODEL, D_IN_PROJ), D_MODEL),
        "q_norm": gain(ks[4], (DEPTH, HEAD_DIM)),
        "k_norm": gain(ks[5], (DEPTH, HEAD_DIM)),
        "conv_mix_w": nrm(ks[6], (DEPTH, CONV_WIDTH, D_CONV), CONV_WIDTH),
        "w_attn_branch": nrm(ks[7], (DEPTH, D_ATTN, D_MODEL), D_ATTN),
        "w_conv_branch": nrm(ks[8], (DEPTH, D_CONV, D_MODEL), D_CONV),
        "w_out": nrm(ks[9], (DEPTH, D_MODEL, D_MODEL), D_MODEL),
        "w_norm_ffn": gain(ks[10], (DEPTH, D_MODEL)),
        "w_up": nrm(ks[11], (DEPTH, D_MODEL, 2 * D_FF), D_MODEL),
        "ffn_conv_w": nrm(ks[12], (DEPTH, FFN_CONV_WIDTH, 2 * D_FF), FFN_CONV_WIDTH),
        "w_down": nrm(ks[13], (DEPTH, D_FF, D_MODEL), D_FF),
        "w_ple": nrm(ks[14], (DEPTH, D_PLE, D_MODEL), D_PLE),
        "w_ple_gate": nrm(ks[15], (DEPTH, D_MODEL, D_MODEL), D_MODEL),
    }


def reference(x, p, positions, w_norm_mix, w_in, q_norm, k_norm, conv_mix_w,
              w_attn_branch, w_conv_branch, w_out, w_norm_ffn, w_up, ffn_conv_w,
              w_down, w_ple, w_ple_gate):
    b, s, _ = x.shape
    offsets = [int(o) for o in np.cumsum(IN_SPLITS)[:-1]]
    for i in range(DEPTH):
        h = rms_norm(x, w_norm_mix[i])
        z = h @ w_in[i]
        q, k, v, cb, cc, cx, g_attn, g_conv = jnp.split(z, offsets, axis=-1)

        def heads(t):
            return t.reshape(b, s, N_ATTN_HEADS, HEAD_DIM).transpose(0, 2, 1, 3)

        qh = rope(rms_norm(heads(q), q_norm[i]), positions)
        kh = rope(rms_norm(heads(k), k_norm[i]), positions)
        vh = heads(v)
        attn = moba_attention(qh, kh, vh).transpose(0, 2, 1, 3).reshape(b, s, D_ATTN)

        conv_out = cb * causal_dwconv(cc * cx, conv_mix_w[i])

        merged = (jax.nn.sigmoid(g_attn) * (attn @ w_attn_branch[i])
                  + jax.nn.sigmoid(g_conv) * (conv_out @ w_conv_branch[i]))
        x = x + merged @ w_out[i]

        h2 = rms_norm(x, w_norm_ffn[i])
        u = causal_dwconv(h2 @ w_up[i], ffn_conv_w[i])
        u_g, u_v = jnp.split(u, 2, axis=-1)
        x = x + (jax.nn.silu(u_g) * u_v) @ w_down[i]

        x = x + jax.nn.sigmoid(x @ w_ple_gate[i]) * (p[i] @ w_ple[i])
    return x
```

```cpp
#include <hip/hip_runtime.h>
#include <cstdio>
#include <cstdint>
#include <cmath>
namespace pg8 {
#define PG8_LAS __attribute__((address_space(3)))
typedef unsigned short bf16_t;
typedef short bf16x8 __attribute__((ext_vector_type(8)));
typedef float f32x4 __attribute__((ext_vector_type(4)));
typedef unsigned u32x4 __attribute__((ext_vector_type(4)));
constexpr int BM = 256, BK = 64, HALF = 128, HTB = HALF * BK * 2  , STAGE_BYTES = 8 * HTB, NXCD = 8, WGM = 8;

__host__ __device__ __forceinline__ int lds_byte(int r, int c) { const int st = (r >> 4) * 2 + (c >> 5), rr = r & 15, cc = c & 31, ob = rr * 64 + cc * 2; return st * 1024 + (ob ^ (((ob >> 9) & 1) << 5)); }
__host__ __device__ __forceinline__ void stage_rc(int b, int& R, int& C) { const int st = b / 1024, sb = b % 1024, swz = sb ^ (((sb >> 9) & 1) << 5); R = (st >> 1) * 16 + swz / 64; C = (st & 1) * 32 + (swz % 64) / 2; }
__host__ __device__ __forceinline__ int perm32(int rho) { const int n = rho >> 4, i = rho & 15; return 8 * (i >> 2) + 4 * n + (i & 3); }

struct Unit { int pm, pn; };
struct Gemm { const bf16_t* A; const bf16_t* Bt; int M, N, K; };

struct StaticOrder {
    int nM, nN, nwg, G, c;
    __host__ __device__ void init(int M, int N, int G_, int c_) { nM = M / BM; nN = N / BM; nwg = nM * nN; G = G_; c = c_; }
    __host__ __device__ bool next(int i, Unit& u) const {
        const long L = (long)i * G + c; if (L >= nwg) return false;
        int wgid = (int)L; { const int q = nwg / NXCD, r = nwg % NXCD, xcd = wgid % NXCD, off = wgid / NXCD; wgid = (xcd < r ? xcd * (q + 1) : r * (q + 1) + (xcd - r) * q) + off; }
        const int nig = WGM * nN, gid = wgid / nig, fm = gid * WGM, gsz = (nM - fm) < WGM ? (nM - fm) : WGM;
        u.pm = fm + ((wgid % nig) % gsz); u.pn = (wgid % nig) / gsz; return true;
    }
    __device__ __forceinline__ void a_ready(const Unit&) const {}
    __device__ __forceinline__ void done(const Unit&) const {}
};

__device__ __forceinline__ unsigned cvt_pk_bf16(float lo, float hi) { unsigned r; asm volatile("v_cvt_pk_bf16_f32 %0, %1, %2" : "=v"(r) : "v"(lo), "v"(hi)); return r; }
typedef unsigned u32x2 __attribute__((ext_vector_type(2)));
__device__ __forceinline__ float bf_lo(unsigned w) { return __uint_as_float(w << 16); }
__device__ __forceinline__ float bf_hi(unsigned w) { return __uint_as_float(w & 0xffff0000u); }
__device__ __forceinline__ float sigm(float v) { return __builtin_amdgcn_rcpf(1.0f + __expf(-v)); }
__device__ __forceinline__ u32x4 pack8(const f32x4& v0, const f32x4& v1) { u32x4 w; w.x = cvt_pk_bf16(v0[0], v0[1]); w.y = cvt_pk_bf16(v0[2], v0[3]); w.z = cvt_pk_bf16(v1[0], v1[1]); w.w = cvt_pk_bf16(v1[2], v1[3]); return w; }

struct EpiZ {
    static constexpr bool PERM = true, AFTER_DRAIN = false;
    bf16_t* Z; int M;
    __device__ __forceinline__ void operator()(const f32x4 (&acc)[2][2][4][2], const Unit& u, int wr, int wc, int fr, int fq) const {
        const int row0 = u.pm * BM + wr * 64 + fr;
        bf16_t* base; int ldc, colt; const bool sg = u.pn >= 48;
        if (!sg) { base = Z + (size_t)(u.pn >> 3) * ((size_t)M * 2048); ldc = 2048; colt = (u.pn & 7) * 256; }
        else { const int g = u.pn - 48; base = Z + (size_t)6 * M * 2048 + (size_t)(g >> 4) * ((size_t)M * 4096); ldc = 4096; colt = (g & 15) * 256; }
        const int col0 = colt + wc * 32 + 8 * fq;
#pragma unroll
        for (int ai = 0; ai < 2; ++ai)
#pragma unroll
            for (int m = 0; m < 4; ++m) { bf16_t* rowp = base + (size_t)(row0 + ai * HALF + m * 16) * ldc + col0;
#pragma unroll
                for (int bj = 0; bj < 2; ++bj) { f32x4 v0 = acc[ai][bj][m][0], v1 = acc[ai][bj][m][1];
                    if (sg) {
#pragma unroll
                        for (int e = 0; e < 4; ++e) { v0[e] = sigm(v0[e]); v1[e] = sigm(v1[e]); } }
                    *(u32x4*)(rowp + bj * HALF) = pack8(v0, v1); } }
    }
};
struct EpiBf {
    static constexpr bool PERM = true, AFTER_DRAIN = false;
    bf16_t* O; int ldc;
    __device__ __forceinline__ void operator()(const f32x4 (&acc)[2][2][4][2], const Unit& u, int wr, int wc, int fr, int fq) const {
        const int row0 = u.pm * BM + wr * 64 + fr, col0 = u.pn * BM + wc * 32 + 8 * fq;
#pragma unroll
        for (int ai = 0; ai < 2; ++ai)
#pragma unroll
            for (int m = 0; m < 4; ++m) { bf16_t* rowp = O + (size_t)(row0 + ai * HALF + m * 16) * ldc + col0;
#pragma unroll
                for (int bj = 0; bj < 2; ++bj) *(u32x4*)(rowp + bj * HALF) = pack8(acc[ai][bj][m][0], acc[ai][bj][m][1]); }
    }
};
template <bool ADD> struct EpiGate {
    static constexpr bool PERM = true, AFTER_DRAIN = false;
    const bf16_t* G; const bf16_t* T1; bf16_t* O; int ldc;
    __device__ __forceinline__ void operator()(const f32x4 (&acc)[2][2][4][2], const Unit& u, int wr, int wc, int fr, int fq) const {
        const int row0 = u.pm * BM + wr * 64 + fr, col0 = u.pn * BM + wc * 32 + 8 * fq;
#pragma unroll
        for (int ai = 0; ai < 2; ++ai)
#pragma unroll
            for (int m = 0; m < 4; ++m) { const size_t ro = (size_t)(row0 + ai * HALF + m * 16) * ldc + col0;
#pragma unroll
                for (int bj = 0; bj < 2; ++bj) { const size_t o = ro + bj * HALF; const u32x4 g = *(const u32x4*)(G + o);
                    f32x4 v0 = acc[ai][bj][m][0], v1 = acc[ai][bj][m][1];
                    v0[0] *= bf_lo(g.x); v0[1] *= bf_hi(g.x); v0[2] *= bf_lo(g.y); v0[3] *= bf_hi(g.y); v1[0] *= bf_lo(g.z); v1[1] *= bf_hi(g.z); v1[2] *= bf_lo(g.w); v1[3] *= bf_hi(g.w);
                    if (ADD) { const u32x4 t = *(const u32x4*)(T1 + o);
                        v0[0] += bf_lo(t.x); v0[1] += bf_hi(t.x); v0[2] += bf_lo(t.y); v0[3] += bf_hi(t.y); v1[0] += bf_lo(t.z); v1[1] += bf_hi(t.z); v1[2] += bf_lo(t.w); v1[3] += bf_hi(t.w); }
                    *(u32x4*)(O + o) = pack8(v0, v1); } }
    }
};
struct EpiRes {
    static constexpr bool PERM = false, AFTER_DRAIN = false;
    const float* base; float* out; bf16_t* XN; int ldc;
    __device__ __forceinline__ void operator()(const f32x4 (&acc)[2][2][4][2], const Unit& u, int wr, int wc, int fr, int fq) const {
        const int row0 = u.pm * BM + wr * 64 + fr, col0 = u.pn * BM + wc * 32 + 4 * fq;
#pragma unroll
        for (int ai = 0; ai < 2; ++ai)
#pragma unroll
            for (int m = 0; m < 4; ++m) { const size_t ro = (size_t)(row0 + ai * HALF + m * 16) * ldc + col0;
#pragma unroll
                for (int bj = 0; bj < 2; ++bj)
#pragma unroll
                    for (int n = 0; n < 2; ++n) { const size_t o = ro + bj * HALF + n * 16; const f32x4 v = *(const f32x4*)(base + o) + acc[ai][bj][m][n];
                        *(f32x4*)(out + o) = v;
                        if (XN) { u32x2 w; w.x = cvt_pk_bf16(v[0], v[1]); w.y = cvt_pk_bf16(v[2], v[3]); *(u32x2*)(XN + o) = w; } } }
    }
};
struct EpiFinal {
    static constexpr bool PERM = false, AFTER_DRAIN = false;
    float* out; const bf16_t* PP; int ldc;
    __device__ __forceinline__ void operator()(const f32x4 (&acc)[2][2][4][2], const Unit& u, int wr, int wc, int fr, int fq) const {
        const int row0 = u.pm * BM + wr * 64 + fr, col0 = u.pn * BM + wc * 32 + 4 * fq;
#pragma unroll
        for (int ai = 0; ai < 2; ++ai)
#pragma unroll
            for (int m = 0; m < 4; ++m) { const size_t ro = (size_t)(row0 + ai * HALF + m * 16) * ldc + col0;
#pragma unroll
                for (int bj = 0; bj < 2; ++bj)
#pragma unroll
                    for (int n = 0; n < 2; ++n) { const size_t o = ro + bj * HALF + n * 16; const f32x4 a = acc[ai][bj][m][n]; const u32x2 pw = *(const u32x2*)(PP + o);
                        f32x4 v = *(const f32x4*)(out + o);
                        v[0] += sigm(a[0]) * bf_lo(pw.x); v[1] += sigm(a[1]) * bf_hi(pw.x); v[2] += sigm(a[2]) * bf_lo(pw.y); v[3] += sigm(a[3]) * bf_hi(pw.y);
                        *(f32x4*)(out + o) = v; } }
    }
};


template <class Epi, class Sched, bool ALIGN_EPI = false, bool SP2 = false>
__device__ __forceinline__ void gemm_phase(PG8_LAS unsigned char* lds, const Gemm g, const Sched& S, const Epi& E) {
    const int tid = threadIdx.x, wid = __builtin_amdgcn_readfirstlane(tid >> 6), lane = tid & 63, wr = wid >> 2, wc = wid & 3, fr = lane & 15, fq = lane >> 4;
    const int K = g.K, nt = K / BK;
    unsigned voffA[2], voffB[2];
#pragma unroll
    for (int i = 0; i < 2; ++i) { int R, C; stage_rc(tid * 16 + i * 8192, R, C); const int Rb = Epi::PERM ? ((R & ~31) + perm32(R & 31)) : R;
        voffA[i] = (unsigned)(R * K + C) * 2u; voffB[i] = (unsigned)(Rb * K + C) * 2u; }
    const size_t kstep = (size_t)(BK * 2);
    const size_t hstep = (size_t)HALF * K * 2;
    const size_t tstep = 2 * hstep;
    const unsigned ldsw = (unsigned)wid * 1024u;
    const int aoff = lds_byte(wr * 64 + fr, fq * 8), boff = lds_byte(wc * 32 + fr, fq * 8);
#define PG8_SA(b, h) (((b) * 2 + (h)) * HTB)
#define PG8_SB(b, h) ((4 + (b) * 2 + (h)) * HTB)
#define PG8_STAGE(bufoff, gbase, voff) do { _Pragma("unroll") for (int _i = 0; _i < 2; ++_i) \
        __builtin_amdgcn_global_load_lds((const unsigned*)((const char*)(gbase) + (voff)[_i]), (PG8_LAS unsigned*)(lds + (bufoff) + ldsw + _i * 8192), 16, 0, 0); } while (0)
#define PG8_LDA(dst, b, h) do { _Pragma("unroll") for (int m = 0; m < 4; ++m) _Pragma("unroll") for (int k = 0; k < 2; ++k) dst[m][k] = *(const PG8_LAS bf16x8*)(lds + PG8_SA(b, h) + aoff + m * 2048 + k * 1024); } while (0)
#define PG8_LDB(dst, b, h) do { _Pragma("unroll") for (int n = 0; n < 2; ++n) _Pragma("unroll") for (int k = 0; k < 2; ++k) dst[n][k] = *(const PG8_LAS bf16x8*)(lds + PG8_SB(b, h) + boff + n * 2048 + k * 1024); } while (0)
#define PG8_MMA(ai, bj, At, Bt) do { __builtin_amdgcn_s_setprio(1); _Pragma("unroll") for (int m = 0; m < 4; ++m) _Pragma("unroll") for (int n = 0; n < 2; ++n) _Pragma("unroll") for (int k = 0; k < 2; ++k) \
        acc[ai][bj][m][n] = __builtin_amdgcn_mfma_f32_16x16x32_bf16(Bt[n][k], At[m][k], acc[ai][bj][m][n], 0, 0, 0); __builtin_amdgcn_s_setprio(0); } while (0)
#define PG8_WAIT_V(n) asm volatile("s_waitcnt vmcnt(" #n ")" ::: "memory")
#define PG8_WAIT_L(n) asm volatile("s_waitcnt lgkmcnt(" #n ")" ::: "memory")
#define PG8_BAR __builtin_amdgcn_s_barrier()
#define PG8_SCHED __builtin_amdgcn_sched_barrier(0)
    Unit cur, nxt; int ui = 0;
    if (!S.next(0, cur)) return;
    f32x4 acc[2][2][4][2];
#pragma unroll
    for (int a = 0; a < 2; ++a)
#pragma unroll
        for (int b = 0; b < 2; ++b)
#pragma unroll
            for (int m = 0; m < 4; ++m)
#pragma unroll
                for (int n = 0; n < 2; ++n) acc[a][b][m][n] = (f32x4){0.f, 0.f, 0.f, 0.f};
    bf16x8 At[4][2], B0[2][2], B1[2][2];
    const char* cA = (const char*)g.A + (size_t)cur.pm * tstep; const char* cB = (const char*)g.Bt + (size_t)cur.pn * tstep;
    S.a_ready(cur);
    if constexpr (SP2) {
        PG8_STAGE(PG8_SB(0, 0), cB, voffB); PG8_STAGE(PG8_SB(0, 1), cB + hstep, voffB); PG8_STAGE(PG8_SA(0, 0), cA, voffA); PG8_STAGE(PG8_SA(0, 1), cA + hstep, voffA);
        if (wr == 1) PG8_BAR;
        PG8_WAIT_V(2); PG8_BAR;
        PG8_STAGE(PG8_SB(1, 0), cB + kstep, voffB); PG8_STAGE(PG8_SA(1, 0), cA + kstep, voffA); PG8_STAGE(PG8_SB(1, 1), cB + hstep + kstep, voffB);
        PG8_WAIT_V(6); PG8_BAR;
    } else {
        PG8_STAGE(PG8_SB(0, 0), cB, voffB); PG8_STAGE(PG8_SA(0, 0), cA, voffA); PG8_STAGE(PG8_SB(0, 1), cB + hstep, voffB); PG8_STAGE(PG8_SA(0, 1), cA + hstep, voffA);
        if (wr == 1) PG8_BAR;
        PG8_WAIT_V(4); PG8_BAR;
        PG8_STAGE(PG8_SB(1, 0), cB + kstep, voffB); PG8_STAGE(PG8_SA(1, 0), cA + kstep, voffA); PG8_STAGE(PG8_SB(1, 1), cB + hstep + kstep, voffB);
        PG8_WAIT_V(6); PG8_BAR;
    }
    for (;;) {
        const bool has_next = S.next(ui + 1, nxt);
        const char* nA = has_next ? (const char*)g.A + (size_t)nxt.pm * tstep : cA; const char* nB = has_next ? (const char*)g.Bt + (size_t)nxt.pn * tstep : cB;
        for (int t = 0; t < nt; t += 2) {
            const bool last = (t == nt - 2);
            const char* a1 = cA + (size_t)(t + 1) * kstep;
            const char* a2 = last ? nA : cA + (size_t)(t + 2) * kstep; const char* b2 = last ? nB : cB + (size_t)(t + 2) * kstep;
            const char* a3 = a2 + kstep; const char* b3 = b2 + kstep;
            if (last && has_next) S.a_ready(nxt);
            if constexpr (SP2) {
            PG8_LDB(B0, 0, 0); PG8_LDB(B1, 0, 1); PG8_SCHED; PG8_LDA(At, 0, 0); PG8_STAGE(PG8_SA(1, 1), a1 + hstep, voffA);
            PG8_WAIT_V(8); PG8_WAIT_L(0); PG8_BAR; PG8_MMA(0, 0, At, B0); PG8_MMA(0, 1, At, B1); PG8_BAR; PG8_SCHED;
            PG8_LDA(At, 0, 1); PG8_STAGE(PG8_SB(0, 0), b2, voffB); PG8_STAGE(PG8_SB(0, 1), b2 + hstep, voffB); PG8_STAGE(PG8_SA(0, 0), a2, voffA);
            PG8_WAIT_V(8); PG8_WAIT_L(0); PG8_BAR; PG8_MMA(1, 0, At, B0); PG8_MMA(1, 1, At, B1); PG8_BAR; PG8_SCHED;
            PG8_LDB(B0, 1, 0); PG8_LDB(B1, 1, 1); PG8_SCHED; PG8_LDA(At, 1, 0); PG8_STAGE(PG8_SA(0, 1), a2 + hstep, voffA);
            PG8_WAIT_V(8); PG8_WAIT_L(0); PG8_BAR; PG8_MMA(0, 0, At, B0); PG8_MMA(0, 1, At, B1); PG8_BAR; PG8_SCHED;
            PG8_LDA(At, 1, 1); PG8_STAGE(PG8_SB(1, 0), b3, voffB); PG8_STAGE(PG8_SB(1, 1), b3 + hstep, voffB); PG8_STAGE(PG8_SA(1, 0), a3, voffA);
            PG8_WAIT_V(8); PG8_WAIT_L(0); PG8_BAR; PG8_MMA(1, 0, At, B0); PG8_MMA(1, 1, At, B1); PG8_BAR; PG8_SCHED;
            } else {
            PG8_LDB(B0, 0, 0); PG8_SCHED; PG8_LDA(At, 0, 0); PG8_STAGE(PG8_SA(1, 1), a1 + hstep, voffA);
            PG8_WAIT_L(8); PG8_BAR; PG8_WAIT_L(0); PG8_MMA(0, 0, At, B0); PG8_BAR; PG8_SCHED;
            PG8_LDB(B1, 0, 1); PG8_STAGE(PG8_SB(0, 0), b2, voffB);
            PG8_BAR; PG8_WAIT_L(0); PG8_MMA(0, 1, At, B1); PG8_BAR;
            PG8_LDA(At, 0, 1); PG8_STAGE(PG8_SA(0, 0), a2, voffA);
            PG8_BAR; PG8_WAIT_L(0); PG8_MMA(1, 0, At, B0); PG8_BAR; PG8_SCHED;
            PG8_STAGE(PG8_SB(0, 1), b2 + hstep, voffB);
            PG8_WAIT_V(6); PG8_BAR; PG8_MMA(1, 1, At, B1); PG8_BAR;
            PG8_LDB(B0, 1, 0); PG8_SCHED; PG8_LDA(At, 1, 0); PG8_STAGE(PG8_SA(0, 1), a2 + hstep, voffA);
            PG8_WAIT_L(8); PG8_BAR; PG8_WAIT_L(0); PG8_MMA(0, 0, At, B0); PG8_BAR; PG8_SCHED;
            PG8_LDB(B1, 1, 1); PG8_STAGE(PG8_SB(1, 0), b3, voffB);
            PG8_BAR; PG8_WAIT_L(0); PG8_MMA(0, 1, At, B1); PG8_BAR;
            PG8_LDA(At, 1, 1); PG8_STAGE(PG8_SA(1, 0), a3, voffA);
            PG8_BAR; PG8_WAIT_L(0); PG8_MMA(1, 0, At, B0); PG8_BAR; PG8_SCHED;
            PG8_STAGE(PG8_SB(1, 1), b3 + hstep, voffB);
            PG8_WAIT_V(6); PG8_BAR; PG8_MMA(1, 1, At, B1); PG8_BAR;
            }
        }
        if constexpr (ALIGN_EPI) { if (wr == 0) PG8_BAR; }
        if constexpr (!Epi::AFTER_DRAIN) { E(acc, cur, wr, wc, fr, fq); S.done(cur); }
        if (!has_next) break;
#pragma unroll
        for (int a = 0; a < 2; ++a)
#pragma unroll
            for (int b = 0; b < 2; ++b)
#pragma unroll
                for (int m = 0; m < 4; ++m)
#pragma unroll
                    for (int n = 0; n < 2; ++n) acc[a][b][m][n] = (f32x4){0.f, 0.f, 0.f, 0.f};
        cur = nxt; cA = nA; cB = nB; ++ui;
        if constexpr (ALIGN_EPI) { if (wr == 1) PG8_BAR; }
    }
    PG8_WAIT_V(0);
    if constexpr (!ALIGN_EPI) { if (wr == 0) PG8_BAR; }
    PG8_BAR;
    if constexpr (Epi::AFTER_DRAIN) { E.fused(acc, cur, wr, wc, fr, fq, lds, wid, lane); S.done(cur); }
#undef PG8_SA
#undef PG8_SB
#undef PG8_STAGE
#undef PG8_LDA
#undef PG8_LDB
#undef PG8_MMA
#undef PG8_WAIT_V
#undef PG8_WAIT_L
#undef PG8_BAR
#undef PG8_SCHED
}
}
#define GAS __attribute__((address_space(1)))
#define LAS __attribute__((address_space(3)))
typedef unsigned short bf16;
typedef unsigned v4u __attribute__((ext_vector_type(4)));
typedef float f32x4 __attribute__((ext_vector_type(4)));
typedef short bf16x8 __attribute__((ext_vector_type(8)));
typedef GAS unsigned gu32;
typedef GAS unsigned long long gu64;
#define RLX_AGENT __ATOMIC_RELAXED, __HIP_MEMORY_SCOPE_AGENT
#define LDS_WAIT() asm volatile("s_waitcnt lgkmcnt(0)" ::: "memory")
#define VM_WAIT() asm volatile("s_waitcnt vmcnt(0)" ::: "memory")
__device__ __forceinline__ unsigned long long rt() { return __builtin_amdgcn_s_memrealtime(); }
__device__ __forceinline__ unsigned f2bf(float f) { unsigned u = __builtin_bit_cast(unsigned, f); return (u + 0x7fffu + ((u >> 16) & 1u)) >> 16; }
__device__ __forceinline__ unsigned pk2(float lo, float hi) { return f2bf(lo) | (f2bf(hi) << 16); }

#define XB_TMO      128
#define XB_XCNT(j)  (256  + 64 * (j))
#define XB_XSUB(j)  (1280 + 64 * (j))
#define XB_XGEN(j)  (2304 + 64 * (j))
#define XB_TOP      3328
#define XB_TOPGEN   3392
#define XCD_BAR_WORDS 3456
#define XB_SPIN_CAP (1u << 18)

__device__ __forceinline__ unsigned xb_ld(unsigned* p)              { return __hip_atomic_load(p, __ATOMIC_RELAXED, __HIP_MEMORY_SCOPE_AGENT); }
__device__ __forceinline__ unsigned xb_add(unsigned* p, unsigned v) { return __hip_atomic_fetch_add(p, v, __ATOMIC_RELAXED, __HIP_MEMORY_SCOPE_AGENT); }
__device__ __forceinline__ unsigned xb_xcc_id() { return (unsigned)__builtin_amdgcn_s_getreg((3 << 11) | 20) & 0xFu; }
#define XB_SPIN(cond, bar) do { unsigned _sp = 0; while (cond) { __builtin_amdgcn_s_sleep(1); \
    if ((++_sp & 255u) == 0u) { if (xb_ld(&(bar)[XB_TMO])) break; if (_sp > XB_SPIN_CAP) { atomicAdd(&(bar)[XB_TMO], 1u); break; } } } } while (0)

struct XcdBarrier {
    unsigned* bar; unsigned x;
    volatile LAS unsigned* st;
};

__device__ __forceinline__ XcdBarrier xcd_barrier_post(unsigned* bar, volatile LAS unsigned* st) {
    XcdBarrier b; b.bar = bar; b.x = xb_xcc_id(); b.st = st;
    if (threadIdx.x == 0) (void)xb_add(&bar[XB_XCNT(b.x)], 1u);
    return b;
}
__device__ __forceinline__ void xcd_barrier_complete(unsigned* bar, unsigned x, unsigned& nloc, unsigned& nx) {
    const unsigned G = gridDim.x * gridDim.y * gridDim.z;
    unsigned sum, cnt, mine, sp = 0u;
    for (;;) {
        sum = 0u; cnt = 0u; mine = 0u;
#pragma unroll
        for (unsigned j = 0; j < 16; ++j) { const unsigned c = xb_ld(&bar[XB_XCNT(j)]); sum += c; cnt += (c > 0u) ? 1u : 0u; mine = (j == x) ? c : mine; }
        if (sum == G) break;
        __builtin_amdgcn_s_sleep(1);
        if ((++sp & 255u) == 0u) { if (xb_ld(&bar[XB_TMO])) break; if (sp > XB_SPIN_CAP) { atomicAdd(&bar[XB_TMO], 1u); break; } }
    }
    nloc = mine > 0u ? mine : 1u; nx = cnt > 0u ? cnt : 1u;
}

__device__ __forceinline__ void xcd_barrier(const XcdBarrier& b) {
    asm volatile("s_waitcnt vmcnt(0)" ::: "memory");
    __syncthreads();
    if (threadIdx.x == 0) {
        unsigned* bar = b.bar;
        __builtin_amdgcn_s_waitcnt(0);
        unsigned nloc = b.st[0], nx = b.st[1];
        if (nloc == 0u) { xcd_barrier_complete(bar, b.x, nloc, nx); b.st[0] = nloc; b.st[1] = nx; }
        const unsigned old = xb_add(&bar[XB_XSUB(b.x)], 1u);
        const unsigned gen = old / nloc;
        if (old + 1u == (gen + 1u) * nloc) {
            __builtin_amdgcn_fence(__ATOMIC_RELEASE, "agent");
            asm volatile("s_waitcnt vmcnt(0)" ::: "memory");
            const unsigned og = xb_add(&bar[XB_TOP], 1u);
            const unsigned tg = og / nx;
            if (og + 1u == (tg + 1u) * nx) xb_add(&bar[XB_TOPGEN], 1u);
            else XB_SPIN(xb_ld(&bar[XB_TOPGEN]) == tg, bar);
            __builtin_amdgcn_fence(__ATOMIC_ACQUIRE, "agent");
            xb_add(&bar[XB_XGEN(b.x)], 1u);
            asm volatile("s_waitcnt vmcnt(0)" ::: "memory");
        } else {
            XB_SPIN(xb_ld(&bar[XB_XGEN(b.x)]) == gen, bar);
            __builtin_amdgcn_fence(__ATOMIC_ACQUIRE, "agent");
            asm volatile("s_waitcnt vmcnt(0)" ::: "memory");
        }
    }
    __syncthreads();
}

constexpr int NWAVES = 8;
constexpr int M = 16384, D = 4096, DIN = 20480, DA = 2048, NH = 16, HD = 128, DFF = 11008, DFH = 5504, DPLE = 256, NBLK = 64, BLK = 256;
constexpr float RMS_EPS = 1e-6f;
constexpr float ATT_SCALE = 0.08838834764831845f;
#ifndef MK_PER_PHASE
#define MK_PER_PHASE 1
#endif
constexpr int NPH = 17;

constexpr size_t MiB = 1u << 20;
constexpr size_t WS_CTL = 0, CTL_ZERO_BYTES = 1 * MiB;
constexpr size_t WS_KMEAN = 1 * MiB;
constexpr size_t WS_LSE = 2 * MiB;
constexpr size_t WS_PB = 8 * MiB;
constexpr size_t WS_WUP = 16 * MiB, WS_WDN = 188 * MiB, WS_WPG = 274 * MiB, WS_WP = 306 * MiB;
constexpr size_t WS_XN = 309 * MiB;
constexpr size_t WS_WO = 438 * MiB, WS_WA = 470 * MiB, WS_WC = 486 * MiB, WS_WIN = 502 * MiB;
constexpr size_t WS_Z = 662 * MiB;
constexpr size_t WS_Q = WS_Z, WS_K = WS_Z + 64 * MiB, WS_V = WS_Z + 128 * MiB, WS_CB = WS_Z + 192 * MiB, WS_CC = WS_Z + 256 * MiB, WS_CX = WS_Z + 320 * MiB, WS_GA = WS_Z + 384 * MiB, WS_GC = WS_Z + 512 * MiB;
constexpr size_t WS_LIST = 1302 * MiB;
constexpr size_t WS_END = 1336 * MiB;
constexpr size_t WS_S0 = WS_XN, WS_S1 = WS_XN + 64 * MiB, WS_S2 = WS_CC;
constexpr size_t WS_T1 = WS_XN, WS_MERGED = WS_K, WS_PP = WS_GC, WS_Y = 438 * MiB, WS_ACT = 782 * MiB;
static_assert(WS_Y + (size_t)M * DFF * 2 <= WS_ACT && WS_ACT + (size_t)M * DFF * 2 <= WS_PP && WS_LIST + (size_t)16 * 516096 * 4 <= WS_END && WS_GC + 128 * MiB == WS_LIST, "d_ws map");
constexpr int CW_TMO = 0, CW_CODE = 1, CW_BAR = 4096, CW_CNT = 16384;
constexpr int LIST_PER_HEAD = 516096;
__host__ __device__ __forceinline__ int list_base(int h, int j) { return h * LIST_PER_HEAD + 256 * (63 * j - (j * (j - 1)) / 2); }

constexpr int RING_OFF = 0, RING_BYTES = 131072;
constexpr int MISC_OFF = 153600;
constexpr int LDS_BYTES = 155648;

struct Args { const void* in[17]; float* out; unsigned char* ws; int ph_lo, ph_hi, use_bar, pad; };

__device__ __forceinline__ float wave_sum(float v) {
#pragma unroll
    for (int o = 1; o < 64; o <<= 1) v += __shfl_xor(v, o);
    return v;
}
__device__ __forceinline__ float wave_max(float v) {
#pragma unroll
    for (int o = 1; o < 64; o <<= 1) v = fmaxf(v, __shfl_xor(v, o));
    return v;
}
__device__ __forceinline__ float bflo(unsigned w) { return __uint_as_float(w << 16); }
__device__ __forceinline__ float bfhi(unsigned w) { return __uint_as_float(w & 0xffff0000u); }

template <int RM> __device__ __forceinline__ int rowmap(int n) {
    if (RM == 0) return n;
    if (n < DFF) return (n / DFH) * DFF + (n % DFH);
    const int n2 = n - DFF; return (n2 / DFH) * DFF + DFH + (n2 % DFH);
}
template <int RM> __device__ __forceinline__ void p0_transpose_item(const float* W, int K, int N, bf16* WT, LAS float* scr, int item, int lane) {
    const int nblk = N / 64, kb = item / nblk, nb = item % nblk, k0 = 64 * kb, n0 = 64 * nb;
    const float* src = W + (size_t)k0 * N + n0 + lane;
#pragma unroll 16
    for (int i = 0; i < 64; ++i) scr[i * 65 + lane] = src[(size_t)i * N];
    LDS_WAIT(); asm volatile("" ::: "memory");
    const int c = lane >> 3, nl = lane & 7;
#pragma unroll
    for (int j = 0; j < 8; ++j) { const int n = nl + 8 * j; const LAS float* s = scr + (8 * c) * 65 + n;
        v4u o; o.x = pk2(s[0 * 65], s[1 * 65]); o.y = pk2(s[2 * 65], s[3 * 65]); o.z = pk2(s[4 * 65], s[5 * 65]); o.w = pk2(s[6 * 65], s[7 * 65]);
        *(v4u*)(WT + (size_t)rowmap<RM>(n0 + n) * K + k0 + 8 * c) = o; }
    LDS_WAIT(); asm volatile("" ::: "memory");
}
__device__ __forceinline__ void rms_row_to_bf16(const float* xrow, const float* g, bf16* orow, int lane) {
    const f32x4* xr = (const f32x4*)xrow + lane;
    f32x4 v[16]; float s = 0.f;
#pragma unroll
    for (int j = 0; j < 16; ++j) { v[j] = xr[64 * j]; s += (v[j].x * v[j].x + v[j].y * v[j].y) + (v[j].z * v[j].z + v[j].w * v[j].w); }
    const float r = 1.0f / sqrtf(wave_sum(s) * (1.f / D) + RMS_EPS);
    unsigned long long* o8 = (unsigned long long*)orow + lane;
    const f32x4* gr = (const f32x4*)g + lane;
#pragma unroll
    for (int j = 0; j < 16; ++j) { const f32x4 gv = gr[64 * j];
        o8[64 * j] = (unsigned long long)pk2(v[j].x * r * gv.x, v[j].y * r * gv.y) | ((unsigned long long)pk2(v[j].z * r * gv.z, v[j].w * r * gv.w) << 32); }
}

__device__ __forceinline__ void p0_prologue(LAS unsigned char* lds, const Args& a, int G, int wave, int lane) {
    unsigned char* ws = a.ws;
    LAS float* scr = (LAS float*)lds + wave * (64 * 65);
    const int gw = blockIdx.x * NWAVES + wave, NGW = G * NWAVES;
    constexpr int I_IN = (D / 64) * (DIN / 64), I_A = (DA / 64) * (D / 64), I_O = (D / 64) * (D / 64), I_UP = (D / 64) * (2 * DFF / 64), I_DN = (DFF / 64) * (D / 64), I_P = (DPLE / 64) * (D / 64);
    constexpr int NITEMS = I_IN + 2 * I_A + 2 * I_O + I_UP + I_DN + I_P;
    for (int it = gw; it < NITEMS; it += NGW) {
        int r = it;
        if (r < I_IN) { p0_transpose_item<0>((const float*)a.in[4], D, DIN, (bf16*)(ws + WS_WIN), scr, r, lane); continue; } r -= I_IN;
        if (r < I_UP) { p0_transpose_item<1>((const float*)a.in[12], D, 2 * DFF, (bf16*)(ws + WS_WUP), scr, r, lane); continue; } r -= I_UP;
        if (r < I_DN) { p0_transpose_item<0>((const float*)a.in[14], DFF, D, (bf16*)(ws + WS_WDN), scr, r, lane); continue; } r -= I_DN;
        if (r < I_A) { p0_transpose_item<0>((const float*)a.in[8], DA, D, (bf16*)(ws + WS_WA), scr, r, lane); continue; } r -= I_A;
        if (r < I_A) { p0_transpose_item<0>((const float*)a.in[9], DA, D, (bf16*)(ws + WS_WC), scr, r, lane); continue; } r -= I_A;
        if (r < I_O) { p0_transpose_item<0>((const float*)a.in[10], D, D, (bf16*)(ws + WS_WO), scr, r, lane); continue; } r -= I_O;
        if (r < I_O) { p0_transpose_item<0>((const float*)a.in[16], D, D, (bf16*)(ws + WS_WPG), scr, r, lane); continue; } r -= I_O;
        p0_transpose_item<0>((const float*)a.in[15], DPLE, D, (bf16*)(ws + WS_WP), scr, r, lane);
    }
    const float* x = (const float*)a.in[0]; const float* g1 = (const float*)a.in[3]; bf16* XN = (bf16*)(ws + WS_XN);
    for (int m = gw; m < M; m += NGW) rms_row_to_bf16(x + (size_t)m * D, g1, XN + (size_t)m * D, lane);
    const f32x4* p4 = (const f32x4*)a.in[1]; v4u* pb = (v4u*)(ws + WS_PB);
    for (int i = gw * 64 + lane; i < M * DPLE / 8; i += NGW * 64) { const f32x4 u0 = p4[2 * i], u1 = p4[2 * i + 1]; v4u o; o.x = pk2(u0.x, u0.y); o.y = pk2(u0.z, u0.w); o.z = pk2(u1.x, u1.y); o.w = pk2(u1.z, u1.w); pb[i] = o; }
}

__device__ __forceinline__ void p2_qk(LAS unsigned char* lds, unsigned char* ws, const int* pos, const float* qn, const float* kn, int G, int tid, int wave, int lane) {
    LAS float* red = (LAS float*)lds;
    bf16* Qb = (bf16*)(ws + WS_Q); bf16* Kb = (bf16*)(ws + WS_K); float* kmean = (float*)(ws + WS_KMEAN);
    const int hh = lane >> 5, jj = lane & 31;
    const float if0 = (float)pow(10000.0, -(double)(2 * jj) / 64.0), if1 = (float)pow(10000.0, -(double)(2 * jj + 1) / 64.0);
    const float gq0 = qn[2 * jj], gq1 = qn[2 * jj + 1], gq2 = qn[64 + 2 * jj], gq3 = qn[65 + 2 * jj];
    const float gk0 = kn[2 * jj], gk1 = kn[2 * jj + 1], gk2 = kn[64 + 2 * jj], gk3 = kn[65 + 2 * jj];
    for (int it = blockIdx.x; it < NBLK * 4; it += G) {
        const int jb = it >> 2, hg = it & 3;
        float ks[2][4];
#pragma unroll
        for (int i = 0; i < 2; ++i)
#pragma unroll
            for (int e = 0; e < 4; ++e) ks[i][e] = 0.f;
        for (int tt = 0; tt < 32; ++tt) {
            const int t = jb * BLK + wave * 32 + tt;
            const float pf = (float)pos[t];
            const float a0 = pf * if0, a1 = pf * if1;
            const float s0 = sinf(a0), c0 = cosf(a0), s1 = sinf(a1), c1 = cosf(a1);
#pragma unroll
            for (int ten = 0; ten < 2; ++ten)
#pragma unroll
                for (int i2 = 0; i2 < 2; ++i2) {
                    const int head = hg * 4 + i2 * 2 + hh;
                    bf16* ptr = (ten ? Kb : Qb) + (size_t)t * DA + head * HD + 2 * jj;
                    const unsigned lo = *(const unsigned*)ptr, hi = *(const unsigned*)(ptr + 64);
                    const float x0 = bflo(lo), x1 = bfhi(lo), x2 = bflo(hi), x3 = bfhi(hi);
                    float ss = (x0 * x0 + x1 * x1) + (x2 * x2 + x3 * x3);
#pragma unroll
                    for (int o = 1; o < 32; o <<= 1) ss += __shfl_xor(ss, o);
                    const float r = 1.0f / sqrtf(ss * (1.f / HD) + RMS_EPS);
                    const float y0 = x0 * r * (ten ? gk0 : gq0), y1 = x1 * r * (ten ? gk1 : gq1), y2 = x2 * r * (ten ? gk2 : gq2), y3 = x3 * r * (ten ? gk3 : gq3);
                    const float o0 = y0 * c0 - y2 * s0, o1 = y1 * c1 - y3 * s1, o2 = y2 * c0 + y0 * s0, o3 = y3 * c1 + y1 * s1;
                    *(unsigned*)ptr = pk2(o0, o1); *(unsigned*)(ptr + 64) = pk2(o2, o3);
                    if (ten) { ks[i2][0] += o0; ks[i2][1] += o1; ks[i2][2] += o2; ks[i2][3] += o3; }
                }
        }
#pragma unroll
        for (int i2 = 0; i2 < 2; ++i2) *(LAS f32x4*)(red + ((wave * 2 + i2) * 64 + lane) * 4) = (f32x4){ks[i2][0], ks[i2][1], ks[i2][2], ks[i2][3]};
        __syncthreads();
        {
            const int hl = tid >> 7, d = tid & 127, i2 = hl >> 1, h2 = hl & 1;
            const int j2 = (d & 63) >> 1, e = ((d >> 6) << 1) + (d & 1), ln = h2 * 32 + j2;
            float s = 0.f;
#pragma unroll
            for (int w = 0; w < 8; ++w) s += red[((w * 2 + i2) * 64 + ln) * 4 + e];
            kmean[((size_t)(hg * 4 + hl) * NBLK + jb) * HD + d] = s * (1.f / BLK);
        }
        __syncthreads();
    }
}
__device__ __forceinline__ void p2_conv(unsigned char* ws, const float* cw, int G, int wave, int lane) {
    bf16* CB = (bf16*)(ws + WS_CB); const bf16* CC = (const bf16*)(ws + WS_CC); const bf16* CX = (const bf16*)(ws + WS_CX);
    const int gw = blockIdx.x * NWAVES + wave, NGW = G * NWAVES;
    for (int it = gw; it < (M / 32) * 4; it += NGW) {
        const int rc = it >> 2, st = it & 3, c = st * 512 + lane * 8, t0 = rc * 32;
        float w0[8], w1[8], w2[8], p1[8], p2[8];
#pragma unroll
        for (int e = 0; e < 8; ++e) { w0[e] = cw[c + e]; w1[e] = cw[DA + c + e]; w2[e] = cw[2 * DA + c + e]; p1[e] = 0.f; p2[e] = 0.f; }
        if (t0 >= 2) {
            const v4u a2 = *(const v4u*)(CC + (size_t)(t0 - 2) * DA + c), b2 = *(const v4u*)(CX + (size_t)(t0 - 2) * DA + c);
            const v4u a1 = *(const v4u*)(CC + (size_t)(t0 - 1) * DA + c), b1 = *(const v4u*)(CX + (size_t)(t0 - 1) * DA + c);
#pragma unroll
            for (int e = 0; e < 4; ++e) { p2[2 * e] = bflo(a2[e]) * bflo(b2[e]); p2[2 * e + 1] = bfhi(a2[e]) * bfhi(b2[e]); p1[2 * e] = bflo(a1[e]) * bflo(b1[e]); p1[2 * e + 1] = bfhi(a1[e]) * bfhi(b1[e]); }
        }
#pragma unroll 4
        for (int tt = 0; tt < 32; ++tt) {
            const size_t o = (size_t)(t0 + tt) * DA + c;
            const v4u a = *(const v4u*)(CC + o), b = *(const v4u*)(CX + o), g = *(const v4u*)(CB + o);
            float pr[8], out[8];
#pragma unroll
            for (int e = 0; e < 4; ++e) { pr[2 * e] = bflo(a[e]) * bflo(b[e]); pr[2 * e + 1] = bfhi(a[e]) * bfhi(b[e]); }
#pragma unroll
            for (int e = 0; e < 8; ++e) { const float gb = (e & 1) ? bfhi(g[e >> 1]) : bflo(g[e >> 1]); out[e] = gb * (w2[e] * pr[e] + w1[e] * p1[e] + w0[e] * p2[e]); p2[e] = p1[e]; p1[e] = pr[e]; }
            v4u ov; ov.x = pk2(out[0], out[1]); ov.y = pk2(out[2], out[3]); ov.z = pk2(out[4], out[5]); ov.w = pk2(out[6], out[7]);
            *(v4u*)(CB + o) = ov;
        }
    }
}

__device__ __forceinline__ void p3_gate(LAS unsigned char* lds, unsigned char* ws, gu32* ctl, int G, int tid, int wave, int lane) {
    LAS float* kmT = (LAS float*)lds; LAS float* qs = (LAS float*)(lds + 32768) + wave * 128;
    const bf16* Qb = (const bf16*)(ws + WS_Q); const float* kmean = (const float*)(ws + WS_KMEAN); unsigned* list = (unsigned*)(ws + WS_LIST);
    for (int it = blockIdx.x; it < NH * (NBLK - 1); it += G) {
        const int h = it / (NBLK - 1), qb = 1 + it % (NBLK - 1);
        __syncthreads();
        for (int i = tid; i < 64 * 128; i += NWAVES * 64) { const int j = i >> 7, d = i & 127; kmT[d * 64 + j] = (j < qb) ? kmean[((size_t)h * NBLK + j) * HD + d] : 0.f; }
        __syncthreads();
        const int nvalid = qb < 3 ? qb : 3;
        for (int tt = 0; tt < 32; ++tt) {
            const int t = qb * BLK + wave * 32 + tt;
            const unsigned qw = *(const unsigned*)(Qb + (size_t)t * DA + h * HD + 2 * lane);
            qs[2 * lane] = bflo(qw); qs[2 * lane + 1] = bfhi(qw);
            LDS_WAIT(); asm volatile("" ::: "memory");
            float g = 0.f;
#pragma unroll 8
            for (int d = 0; d < 128; d += 4) { const f32x4 qv = *(const LAS f32x4*)(qs + d);
                g += qv.x * kmT[d * 64 + lane]; g += qv.y * kmT[(d + 1) * 64 + lane]; g += qv.z * kmT[(d + 2) * 64 + lane]; g += qv.w * kmT[(d + 3) * 64 + lane]; }
            if (lane >= qb) g = -INFINITY;
            int sel = 0;
#pragma unroll
            for (int s = 0; s < 3; ++s) {
                float bv = g; int bi = lane;
#pragma unroll
                for (int o = 1; o < 64; o <<= 1) { const float ov = __shfl_xor(bv, o); const int oi = __shfl_xor(bi, o); if (ov > bv || (ov == bv && oi < bi)) { bv = ov; bi = oi; } }
                if (lane == s) sel = bi;
                if (lane == bi) g = -INFINITY;
            }
            if (lane < nvalid) { const unsigned p = __hip_atomic_fetch_add((unsigned*)ctl + CW_CNT + h * NBLK + sel, 1u, __ATOMIC_RELAXED, __HIP_MEMORY_SCOPE_AGENT);
                list[list_base(h, sel) + p] = ((unsigned)lane << 14) | (unsigned)t; }
            asm volatile("" ::: "memory");
        }
    }
}

__device__ __forceinline__ void attn_partial_wave(const bf16* Qb, const bf16* Kb, const bf16* Vb, int t, int h, int j, int nkeys, LAS float* qs, int lane, float& m, float& l, float& o0, float& o1) {
    const unsigned qw = *(const unsigned*)(Qb + (size_t)t * DA + h * HD + 2 * lane);
    qs[2 * lane] = bflo(qw); qs[2 * lane + 1] = bfhi(qw);
    LDS_WAIT(); asm volatile("" ::: "memory");
    float sc[4];
#pragma unroll
    for (int r = 0; r < 4; ++r) {
        const int key = r * 64 + lane; const bf16* kr = Kb + (size_t)(j * BLK + key) * DA + h * HD; float s = 0.f;
#pragma unroll 4
        for (int c = 0; c < 16; ++c) { const v4u kv = *(const v4u*)(kr + 8 * c); const f32x4 qa = *(const LAS f32x4*)(qs + 8 * c), qb = *(const LAS f32x4*)(qs + 8 * c + 4);
            s += bflo(kv.x) * qa.x + bfhi(kv.x) * qa.y + bflo(kv.y) * qa.z + bfhi(kv.y) * qa.w + bflo(kv.z) * qb.x + bfhi(kv.z) * qb.y + bflo(kv.w) * qb.z + bfhi(kv.w) * qb.w; }
        sc[r] = key < nkeys ? s * ATT_SCALE : -INFINITY;
    }
    m = wave_max(fmaxf(fmaxf(sc[0], sc[1]), fmaxf(sc[2], sc[3])));
    float p[4]; float ls = 0.f;
#pragma unroll
    for (int r = 0; r < 4; ++r) { p[r] = __expf(sc[r] - m); ls += p[r]; }
    l = wave_sum(ls);
    o0 = 0.f; o1 = 0.f;
    const bf16* vb = Vb + (size_t)(j * BLK) * DA + h * HD + 2 * lane;
#pragma unroll
    for (int r = 0; r < 4; ++r) {
        if (r * 64 < nkeys) {
#pragma unroll 8
            for (int kl = 0; kl < 64; ++kl) { const float pk = __uint_as_float(__builtin_amdgcn_readlane(__float_as_uint(p[r]), kl));
                const unsigned vw = *(const unsigned*)(vb + (size_t)(r * 64 + kl) * DA); o0 += pk * bflo(vw); o1 += pk * bfhi(vw); }
        }
    }
    asm volatile("" ::: "memory");
}
__device__ __forceinline__ void p4_routed(LAS unsigned char* lds, unsigned char* ws, gu32* ctl, int G, int tid, int wave, int lane) {
    LAS int* pre = (LAS int*)lds;
    LAS float* qs = (LAS float*)(lds + 8192) + wave * 128;
    const bf16* Qb = (const bf16*)(ws + WS_Q); const bf16* Kb = (const bf16*)(ws + WS_K); const bf16* Vb = (const bf16*)(ws + WS_V);
    const unsigned* list = (const unsigned*)(ws + WS_LIST); float* lse = (float*)(ws + WS_LSE);
    if (wave == 0) {
        int c[16]; int s = 0;
#pragma unroll
        for (int i = 0; i < 16; ++i) { c[i] = (int)__hip_atomic_load((unsigned*)ctl + CW_CNT + lane * 16 + i, __ATOMIC_RELAXED, __HIP_MEMORY_SCOPE_AGENT); s += c[i]; }
        int inc = s;
#pragma unroll
        for (int o = 1; o < 64; o <<= 1) { const int v = __shfl_up(inc, o); if (lane >= o) inc += v; }
        int run = inc - s;
#pragma unroll
        for (int i = 0; i < 16; ++i) { pre[lane * 16 + i] = run; run += c[i]; }
        if (lane == 63) pre[1024] = run;
    }
    __syncthreads();
    const int total = pre[1024];
    const int gw = blockIdx.x * NWAVES + wave, NGW = G * NWAVES;
    for (int e = gw; e < total; e += NGW) {
        int lo = 0, hi = 1024;
        while (hi - lo > 1) { const int mid = (lo + hi) >> 1; if (pre[mid] <= e) lo = mid; else hi = mid; }
        const int h = lo >> 6, j = lo & 63;
        const unsigned ent = list[list_base(h, j) + (e - pre[lo])];
        const int t = (int)(ent & 16383u), s = (int)(ent >> 14);
        float m, l, o0, o1;
        attn_partial_wave(Qb, Kb, Vb, t, h, j, BLK, qs, lane, m, l, o0, o1);
        const float il = 1.0f / l;
        bf16* So = (bf16*)(ws + (s == 0 ? WS_S0 : (s == 1 ? WS_S1 : WS_S2)));
        *(unsigned*)(So + (size_t)t * DA + h * HD + 2 * lane) = pk2(o0 * il, o1 * il);
        if (lane == 0) lse[((size_t)s * NH + h) * M + t] = m + __logf(l);
    }
}
__device__ __forceinline__ void p5_own(LAS unsigned char* lds, unsigned char* ws, int G, int wave, int lane) {
    LAS float* qs = (LAS float*)(lds + 8192) + wave * 128;
    bf16* Qb = (bf16*)(ws + WS_Q); const bf16* Kb = (const bf16*)(ws + WS_K); const bf16* Vb = (const bf16*)(ws + WS_V);
    const float* lse = (const float*)(ws + WS_LSE);
    const int gw = blockIdx.x * NWAVES + wave, NGW = G * NWAVES;
    for (int it = gw; it < NH * M; it += NGW) {
        const int h = it & 15, t = it >> 4, j = t >> 8;
        float m, l, o0, o1;
        attn_partial_wave(Qb, Kb, Vb, t, h, j, (t & 255) + 1, qs, lane, m, l, o0, o1);
        const int nvalid = j < 3 ? j : 3;
        float ls[3]; float mx = m + __logf(l);
        const float lown = mx;
#pragma unroll
        for (int s = 0; s < 3; ++s) { ls[s] = (s < nvalid) ? lse[((size_t)s * NH + h) * M + t] : -INFINITY; mx = fmaxf(mx, ls[s]); }
        float wsum = __expf(lown - mx); const float wo = wsum / l;
        float r0 = o0 * wo, r1 = o1 * wo;
#pragma unroll
        for (int s = 0; s < 3; ++s) if (s < nvalid) { const float w = __expf(ls[s] - mx); wsum += w;
            const unsigned pw = *(const unsigned*)((const bf16*)(ws + (s == 0 ? WS_S0 : (s == 1 ? WS_S1 : WS_S2))) + (size_t)t * DA + h * HD + 2 * lane);
            r0 += w * bflo(pw); r1 += w * bfhi(pw); }
        const float iw = 1.0f / wsum;
        *(unsigned*)(Qb + (size_t)t * DA + h * HD + 2 * lane) = pk2(r0 * iw, r1 * iw);
    }
}

__device__ __forceinline__ void p_ffn_gate(unsigned char* ws, const float* fw, int hf, int G, int wave, int lane) {
    const bf16* Y = (const bf16*)(ws + WS_Y); bf16* ACT = (bf16*)(ws + WS_ACT);
    const int gw = blockIdx.x * NWAVES + wave, NGW = G * NWAVES;
    for (int it = gw; it < (M / 32) * 11; it += NGW) {
        const int rc = it / 11, st = it % 11, c = st * 512 + lane * 8, t0 = rc * 32;
        if (c >= DFH) continue;
        float wg[3][8], wv[3][8], g1[8], g2[8], v1[8], v2[8];
#pragma unroll
        for (int j = 0; j < 3; ++j)
#pragma unroll
            for (int e = 0; e < 8; ++e) { wg[j][e] = fw[(size_t)j * 2 * DFF + hf * DFH + c + e]; wv[j][e] = fw[(size_t)j * 2 * DFF + DFF + hf * DFH + c + e]; }
#pragma unroll
        for (int e = 0; e < 8; ++e) { g1[e] = 0.f; g2[e] = 0.f; v1[e] = 0.f; v2[e] = 0.f; }
        if (t0 >= 2) {
            const v4u a2 = *(const v4u*)(Y + (size_t)(t0 - 2) * DFF + c), b2 = *(const v4u*)(Y + (size_t)(t0 - 2) * DFF + DFH + c);
            const v4u a1 = *(const v4u*)(Y + (size_t)(t0 - 1) * DFF + c), b1 = *(const v4u*)(Y + (size_t)(t0 - 1) * DFF + DFH + c);
#pragma unroll
            for (int e = 0; e < 4; ++e) { g2[2 * e] = bflo(a2[e]); g2[2 * e + 1] = bfhi(a2[e]); v2[2 * e] = bflo(b2[e]); v2[2 * e + 1] = bfhi(b2[e]);
                g1[2 * e] = bflo(a1[e]); g1[2 * e + 1] = bfhi(a1[e]); v1[2 * e] = bflo(b1[e]); v1[2 * e + 1] = bfhi(b1[e]); }
        }
#pragma unroll 2
        for (int tt = 0; tt < 32; ++tt) {
            const size_t ro = (size_t)(t0 + tt) * DFF;
            const v4u a = *(const v4u*)(Y + ro + c), b = *(const v4u*)(Y + ro + DFH + c);
            float out[8];
#pragma unroll
            for (int e = 0; e < 8; ++e) { const float yg = (e & 1) ? bfhi(a[e >> 1]) : bflo(a[e >> 1]), yv = (e & 1) ? bfhi(b[e >> 1]) : bflo(b[e >> 1]);
                const float ug = wg[2][e] * yg + wg[1][e] * g1[e] + wg[0][e] * g2[e], uv = wv[2][e] * yv + wv[1][e] * v1[e] + wv[0][e] * v2[e];
                out[e] = ug * __builtin_amdgcn_rcpf(1.0f + __expf(-ug)) * uv; g2[e] = g1[e]; g1[e] = yg; v2[e] = v1[e]; v1[e] = yv; }
            v4u ov; ov.x = pk2(out[0], out[1]); ov.y = pk2(out[2], out[3]); ov.z = pk2(out[4], out[5]); ov.w = pk2(out[6], out[7]);
            *(v4u*)(ACT + ro + hf * DFH + c) = ov;
        }
    }
}

__global__ void __launch_bounds__(NWAVES * 64, 2) block_fwd(Args args) {
    extern __shared__ __attribute__((aligned(16))) unsigned char lds_raw[];
    LAS unsigned char* lds = (LAS unsigned char*)lds_raw;
    volatile LAS unsigned* MISC = (volatile LAS unsigned*)(lds + MISC_OFF);
    const int tid = threadIdx.x, lane = tid & 63, wave = __builtin_amdgcn_readfirstlane(tid >> 6), G = gridDim.x;
    unsigned char* ws = args.ws; gu32* ctl = (gu32*)(ws + WS_CTL);
    for (int u = tid; u < (LDS_BYTES - MISC_OFF) / 4; u += NWAVES * 64) ((LAS unsigned*)(lds + MISC_OFF))[u] = 0u;
    __syncthreads();
    XcdBarrier bar; bar.bar = (unsigned*)ctl + CW_BAR; bar.x = 0; bar.st = nullptr;
    if (args.use_bar) bar = xcd_barrier_post((unsigned*)ctl + CW_BAR, MISC + 8);
    const int lo = args.ph_lo, hi = args.ph_hi;
#define IN(k) (lo <= (k) && (k) < hi)
#define SEAM(k) do { if (IN(k) && IN((k) + 1)) xcd_barrier(bar); } while (0)
    bf16* const XN = (bf16*)(ws + WS_XN);
    float* const out = args.out;

    if (IN(0)) { p0_prologue(lds, args, G, wave, lane); } SEAM(0);
    if (IN(1)) {
        pg8::Gemm g{XN, (const bf16*)(ws + WS_WIN), M, DIN, D}; pg8::StaticOrder S; S.init(M, DIN, G, (int)blockIdx.x);
        pg8::EpiZ E{(bf16*)(ws + WS_Z), M};
        pg8::gemm_phase<pg8::EpiZ, pg8::StaticOrder, true, true>(lds + RING_OFF, g, S, E);
    } SEAM(1);
    if (IN(2)) { p2_qk(lds, ws, (const int*)args.in[2], (const float*)args.in[5], (const float*)args.in[6], G, tid, wave, lane); p2_conv(ws, (const float*)args.in[7], G, wave, lane); } SEAM(2);
    if (IN(3)) { p3_gate(lds, ws, ctl, G, tid, wave, lane); } SEAM(3);
    if (IN(4)) { p4_routed(lds, ws, ctl, G, tid, wave, lane); } SEAM(4);
    if (IN(5)) { p5_own(lds, ws, G, wave, lane); } SEAM(5);
    if (IN(6)) {
        pg8::Gemm g{(const bf16*)(ws + WS_Q), (const bf16*)(ws + WS_WA), M, D, DA}; pg8::StaticOrder S; S.init(M, D, G, (int)blockIdx.x);
        pg8::EpiGate<false> E{(const bf16*)(ws + WS_GA), nullptr, (bf16*)(ws + WS_T1), D};
        pg8::gemm_phase<pg8::EpiGate<false>, pg8::StaticOrder, true, true>(lds + RING_OFF, g, S, E);
    } SEAM(6);
    if (IN(7)) {
        pg8::Gemm g{(const bf16*)(ws + WS_CB), (const bf16*)(ws + WS_WC), M, D, DA}; pg8::StaticOrder S; S.init(M, D, G, (int)blockIdx.x);
        pg8::EpiGate<true> E{(const bf16*)(ws + WS_GC), (const bf16*)(ws + WS_T1), (bf16*)(ws + WS_MERGED), D};
        pg8::gemm_phase<pg8::EpiGate<true>, pg8::StaticOrder, true, true>(lds + RING_OFF, g, S, E);
    } SEAM(7);
    if (IN(8)) {
        pg8::Gemm g{(const bf16*)(ws + WS_MERGED), (const bf16*)(ws + WS_WO), M, D, D}; pg8::StaticOrder S; S.init(M, D, G, (int)blockIdx.x);
        pg8::EpiRes E{(const float*)args.in[0], out, nullptr, D};
        pg8::gemm_phase<pg8::EpiRes, pg8::StaticOrder, true, true>(lds + RING_OFF, g, S, E);
    } SEAM(8);
    if (IN(9)) {
        const int gw = blockIdx.x * NWAVES + wave, NGW = G * NWAVES;
        for (int m = gw; m < M; m += NGW) rms_row_to_bf16(out + (size_t)m * D, (const float*)args.in[11], XN + (size_t)m * D, lane);
    } SEAM(9);
    if (IN(10)) {
        pg8::Gemm g{(const bf16*)(ws + WS_PB), (const bf16*)(ws + WS_WP), M, D, DPLE}; pg8::StaticOrder S; S.init(M, D, G, (int)blockIdx.x);
        pg8::EpiBf E{(bf16*)(ws + WS_PP), D};
        pg8::gemm_phase<pg8::EpiBf, pg8::StaticOrder, true, true>(lds + RING_OFF, g, S, E);
    } SEAM(10);
    if (IN(11)) {
        pg8::Gemm g{XN, (const bf16*)(ws + WS_WUP), M, DFF, D}; pg8::StaticOrder S; S.init(M, DFF, G, (int)blockIdx.x);
        pg8::EpiBf E{(bf16*)(ws + WS_Y), DFF};
        pg8::gemm_phase<pg8::EpiBf, pg8::StaticOrder, true, true>(lds + RING_OFF, g, S, E);
    } SEAM(11);
    if (IN(12)) { p_ffn_gate(ws, (const float*)args.in[13], 0, G, wave, lane); } SEAM(12);
    if (IN(13)) {
        pg8::Gemm g{XN, (const bf16*)(ws + WS_WUP) + (size_t)DFF * D, M, DFF, D}; pg8::StaticOrder S; S.init(M, DFF, G, (int)blockIdx.x);
        pg8::EpiBf E{(bf16*)(ws + WS_Y), DFF};
        pg8::gemm_phase<pg8::EpiBf, pg8::StaticOrder, true, true>(lds + RING_OFF, g, S, E);
    } SEAM(13);
    if (IN(14)) { p_ffn_gate(ws, (const float*)args.in[13], 1, G, wave, lane); } SEAM(14);
    if (IN(15)) {
        pg8::Gemm g{(const bf16*)(ws + WS_ACT), (const bf16*)(ws + WS_WDN), M, D, DFF}; pg8::StaticOrder S; S.init(M, D, G, (int)blockIdx.x);
        pg8::EpiRes E{out, out, XN, D};
        pg8::gemm_phase<pg8::EpiRes, pg8::StaticOrder, true, true>(lds + RING_OFF, g, S, E);
    } SEAM(15);
    if (IN(16)) {
        pg8::Gemm g{XN, (const bf16*)(ws + WS_WPG), M, D, D}; pg8::StaticOrder S; S.init(M, D, G, (int)blockIdx.x);
        pg8::EpiFinal E{out, (const bf16*)(ws + WS_PP), D};
        pg8::gemm_phase<pg8::EpiFinal, pg8::StaticOrder, true, true>(lds + RING_OFF, g, S, E);
    }
#undef IN
#undef SEAM
}

extern "C" void kernel_launch(void* const* d_in, const int* in_sizes, int n_in, void* d_out, int out_size, void* d_ws, size_t ws_size, hipStream_t stream) {
    static int grid = 0;
    if (grid == 0) {
        if (n_in != 17 || in_sizes[0] != M * D || out_size != M * D || ws_size < WS_END) { fprintf(stderr, "kernel_launch: unexpected shapes / workspace (n_in %d, ws %zu, need %zu); nothing launched\n", n_in, ws_size, (size_t)WS_END); grid = -1; return; }
        int dev = 0, cus = 0, per_cu = 0;
        if (hipGetDevice(&dev) != hipSuccess || hipDeviceGetAttribute(&cus, hipDeviceAttributeMultiprocessorCount, dev) != hipSuccess) { grid = -1; return; }
        if (hipFuncSetAttribute((const void*)block_fwd, hipFuncAttributeMaxDynamicSharedMemorySize, LDS_BYTES) != hipSuccess) { fprintf(stderr, "kernel_launch: hipFuncSetAttribute failed\n"); grid = -1; return; }
        if (hipOccupancyMaxActiveBlocksPerMultiprocessor(&per_cu, (const void*)block_fwd, NWAVES * 64, LDS_BYTES) != hipSuccess || per_cu < 1) fprintf(stderr, "kernel_launch: occupancy query reports %d\n", per_cu);
        (void)hipGetLastError();
        grid = cus;
    }
    if (grid < 0) return;
    if (hipMemsetAsync((char*)d_ws + WS_CTL, 0, CTL_ZERO_BYTES, stream) != hipSuccess) return;
    Args a{};
    for (int i = 0; i < 17; ++i) a.in[i] = d_in[i];
    a.out = (float*)d_out; a.ws = (unsigned char*)d_ws; a.pad = 0;
#if MK_PER_PHASE
    for (int ph = 0; ph < NPH; ++ph) { a.ph_lo = ph; a.ph_hi = ph + 1; a.use_bar = 0; hipLaunchKernelGGL(block_fwd, dim3(grid), dim3(NWAVES * 64), LDS_BYTES, stream, a); }
#else
    a.ph_lo = 0; a.ph_hi = NPH; a.use_bar = 1;
    hipLaunchKernelGGL(block_fwd, dim3(grid), dim3(NWAVES * 64), LDS_BYTES, stream, a);
#endif
}
```

```cpp
#include <hip/hip_runtime.h>
#include <cstdio>
#include <cstdint>
#include <cmath>
namespace pg8 {
#define PG8_LAS __attribute__((address_space(3)))
typedef unsigned short bf16_t;
typedef short bf16x8 __attribute__((ext_vector_type(8)));
typedef float f32x4 __attribute__((ext_vector_type(4)));
typedef unsigned u32x4 __attribute__((ext_vector_type(4)));
constexpr int BM = 256, BK = 64, HALF = 128, HTB = HALF * BK * 2  , STAGE_BYTES = 8 * HTB, NXCD = 8, WGM = 8;

__host__ __device__ __forceinline__ int lds_byte(int r, int c) { const int st = (r >> 4) * 2 + (c >> 5), rr = r & 15, cc = c & 31, ob = rr * 64 + cc * 2; return st * 1024 + (ob ^ (((ob >> 9) & 1) << 5)); }
__host__ __device__ __forceinline__ void stage_rc(int b, int& R, int& C) { const int st = b / 1024, sb = b % 1024, swz = sb ^ (((sb >> 9) & 1) << 5); R = (st >> 1) * 16 + swz / 64; C = (st & 1) * 32 + (swz % 64) / 2; }
__host__ __device__ __forceinline__ int perm32(int rho) { const int n = rho >> 4, i = rho & 15; return 8 * (i >> 2) + 4 * n + (i & 3); }

struct Unit { int pm, pn, aux; };
struct Gemm { const bf16_t* A; const bf16_t* Bt; int M, N, K; size_t a_jump = 0, b_jump = 0, a_tstep = 0; };

struct StaticOrder {
    int nM, nN, nwg, G, c, wgm;
    __host__ __device__ void init(int M, int N, int G_, int c_, int wgm_ = WGM) { nM = M / BM; nN = N / BM; nwg = nM * nN; G = G_; c = c_; wgm = wgm_; }
    __host__ __device__ bool next(int i, Unit& u) const {
        const long L = (long)i * G + c; if (L >= nwg) return false;
        int wgid = (int)L; { const int q = nwg / NXCD, r = nwg % NXCD, xcd = wgid % NXCD, off = wgid / NXCD; wgid = (xcd < r ? xcd * (q + 1) : r * (q + 1) + (xcd - r) * q) + off; }
        const int nig = wgm * nN, gid = wgid / nig, fm = gid * wgm, gsz = (nM - fm) < wgm ? (nM - fm) : wgm;
        u.pm = fm + ((wgid % nig) % gsz); u.pn = (wgid % nig) / gsz; u.aux = 0; return true;
    }
    __device__ __forceinline__ void a_ready(const Unit&) const {}
    __device__ __forceinline__ void done(const Unit&) const {}
};

struct DualOrder {
    StaticOrder so;
    __host__ __device__ bool next(int i, Unit& u) const { if (!so.next(i >> 1, u)) return false; u.aux = i & 1; return true; }
    __device__ __forceinline__ void a_ready(const Unit&) const {}
    __device__ __forceinline__ void done(const Unit&) const {}
};

__device__ __forceinline__ unsigned cvt_pk_bf16(float lo, float hi) { unsigned r; asm volatile("s_nop 0\n\tv_cvt_pk_bf16_f32 %0, %1, %2" : "=v"(r) : "v"(lo), "v"(hi)); return r; }
typedef unsigned u32x2 __attribute__((ext_vector_type(2)));
__device__ __forceinline__ float bf_lo(unsigned w) { return __uint_as_float(w << 16); }
__device__ __forceinline__ float bf_hi(unsigned w) { return __uint_as_float(w & 0xffff0000u); }
__device__ __forceinline__ float sigm(float v) { return __builtin_amdgcn_rcpf(1.0f + __expf(-v)); }
__device__ __forceinline__ u32x4 pack8(const f32x4& v0, const f32x4& v1) { u32x4 w; w.x = cvt_pk_bf16(v0[0], v0[1]); w.y = cvt_pk_bf16(v0[2], v0[3]); w.z = cvt_pk_bf16(v1[0], v1[1]); w.w = cvt_pk_bf16(v1[2], v1[3]); return w; }

struct EpiZ {
    static constexpr bool PERM = true, AFTER_DRAIN = false, KEEP = false, APERM = false;
    bf16_t* Z; int M; int nostore;
    __device__ __forceinline__ void operator()(const f32x4 (&acc)[2][2][4][2], const Unit& u, int wr, int wc, int fr, int fq) const {
        const int row0 = u.pm * BM + wr * 64 + fr;
        if (u.pn < 48) {
            bf16_t* base = Z + (size_t)(u.pn >> 3) * ((size_t)M * 2048); const int col0 = (u.pn & 7) * 256 + wc * 32 + 8 * fq;
#pragma unroll
            for (int ai = 0; ai < 2; ++ai)
#pragma unroll
                for (int m = 0; m < 4; ++m) { bf16_t* rowp = base + (size_t)(row0 + ai * HALF + m * 16) * 2048 + col0;
#pragma unroll
                    for (int bj = 0; bj < 2; ++bj) *(u32x4*)(rowp + bj * HALF) = pack8(acc[ai][bj][m][0], acc[ai][bj][m][1]); }
        } else {
            bf16_t* GAb = Z + (size_t)6 * M * 2048; bf16_t* GCb = GAb + (size_t)M * 4096; const int col0 = (u.pn - 48) * 128 + wc * 32 + 8 * fq;
#pragma unroll
            for (int ai = 0; ai < 2; ++ai)
#pragma unroll
                for (int m = 0; m < 4; ++m) { const size_t o = (size_t)(row0 + ai * HALF + m * 16) * 4096 + col0;
                    f32x4 r0, r1, c0, c1;
#pragma unroll
                    for (int e = 0; e < 4; ++e) { c0[e] = fmaxf(sigm(acc[ai][1][m][0][e]), 1e-20f); c1[e] = fmaxf(sigm(acc[ai][1][m][1][e]), 1e-20f);
                        r0[e] = sigm(acc[ai][0][m][0][e]) * __builtin_amdgcn_rcpf(c0[e]); r1[e] = sigm(acc[ai][0][m][1][e]) * __builtin_amdgcn_rcpf(c1[e]); }
                    *(u32x4*)(GAb + o) = pack8(r0, r1); *(u32x4*)(GCb + o) = pack8(c0, c1); }
        }
    }
};
struct EpiBf {
    static constexpr bool PERM = true, AFTER_DRAIN = false, KEEP = false, APERM = false;
    bf16_t* O; int ldc;
    __device__ __forceinline__ void operator()(const f32x4 (&acc)[2][2][4][2], const Unit& u, int wr, int wc, int fr, int fq) const {
        const int row0 = u.pm * BM + wr * 64 + fr, col0 = u.pn * BM + wc * 32 + 8 * fq;
#pragma unroll
        for (int ai = 0; ai < 2; ++ai)
#pragma unroll
            for (int m = 0; m < 4; ++m) { bf16_t* rowp = O + (size_t)(row0 + ai * HALF + m * 16) * ldc + col0;
#pragma unroll
                for (int bj = 0; bj < 2; ++bj) *(u32x4*)(rowp + bj * HALF) = pack8(acc[ai][bj][m][0], acc[ai][bj][m][1]); }
    }
};
struct EpiDual {
    static constexpr bool PERM = true, AFTER_DRAIN = false, KEEP = true, APERM = false;
    const bf16_t* GA; const bf16_t* GC; bf16_t* O; int ldc;
    __device__ __forceinline__ void operator()(f32x4 (&acc)[2][2][4][2], const Unit& u, int wr, int wc, int fr, int fq) const {
        const int row0 = u.pm * BM + wr * 64 + fr, col0 = u.pn * BM + wc * 32 + 8 * fq;
        const bf16_t* src = u.aux == 0 ? GA : GC;
        u32x4 cq[2][4][2];
#pragma unroll
        for (int ai = 0; ai < 2; ++ai)
#pragma unroll
            for (int m = 0; m < 4; ++m)
#pragma unroll
                for (int bj = 0; bj < 2; ++bj) cq[ai][m][bj] = *(const u32x4*)(src + (size_t)(row0 + ai * HALF + m * 16) * ldc + col0 + bj * HALF);
        if (u.aux == 0) {
#pragma unroll
            for (int ai = 0; ai < 2; ++ai)
#pragma unroll
                for (int m = 0; m < 4; ++m)
#pragma unroll
                    for (int bj = 0; bj < 2; ++bj) { const u32x4 c = cq[ai][m][bj];
                        acc[ai][bj][m][0][0] *= bf_lo(c.x); acc[ai][bj][m][0][1] *= bf_hi(c.x); acc[ai][bj][m][0][2] *= bf_lo(c.y); acc[ai][bj][m][0][3] *= bf_hi(c.y);
                        acc[ai][bj][m][1][0] *= bf_lo(c.z); acc[ai][bj][m][1][1] *= bf_hi(c.z); acc[ai][bj][m][1][2] *= bf_lo(c.w); acc[ai][bj][m][1][3] *= bf_hi(c.w); }
        } else {
#pragma unroll
            for (int ai = 0; ai < 2; ++ai)
#pragma unroll
                for (int m = 0; m < 4; ++m)
#pragma unroll
                    for (int bj = 0; bj < 2; ++bj) { const size_t o = (size_t)(row0 + ai * HALF + m * 16) * ldc + col0 + bj * HALF; const u32x4 c = cq[ai][m][bj];
                        f32x4 v0 = acc[ai][bj][m][0], v1 = acc[ai][bj][m][1];
                        v0[0] *= bf_lo(c.x); v0[1] *= bf_hi(c.x); v0[2] *= bf_lo(c.y); v0[3] *= bf_hi(c.y); v1[0] *= bf_lo(c.z); v1[1] *= bf_hi(c.z); v1[2] *= bf_lo(c.w); v1[3] *= bf_hi(c.w);
                        *(u32x4*)(O + o) = pack8(v0, v1); }
        }
    }
};
#define DPP_F(OLD, SRC, CTRL) __builtin_bit_cast(float, __builtin_amdgcn_update_dpp(__builtin_bit_cast(int, (float)(OLD)), __builtin_bit_cast(int, (float)(SRC)), (CTRL), 0xf, 0xf, false))
struct EpiFfn {
    static constexpr bool PERM = true, AFTER_DRAIN = false, KEEP = false, APERM = true;
    bf16_t* ACT; const float* cw; PG8_LAS float* ex; int Mrows, DFFc; const float* rss; float inv_d, eps;
    __device__ __forceinline__ void operator()(f32x4 (&acc)[2][2][4][2], const Unit& u, int wr, int wc, int fr, int fq) const {
        const int wave = wr * 4 + wc;
#pragma unroll
        for (int ai = 0; ai < 2; ++ai)
#pragma unroll
            for (int m = 0; m < 4; ++m) { const int row = u.pm * 254 - 2 + ai * HALF + wr * 64 + 4 * fr + m;
                const int rc = row < 0 ? 0 : (row >= Mrows ? Mrows - 1 : row);
                const float rv = __builtin_amdgcn_rsqf(rss[rc] * inv_d + eps), rs = (row == rc) ? rv : 0.f;
#pragma unroll
                for (int bj = 0; bj < 2; ++bj)
#pragma unroll
                    for (int n = 0; n < 2; ++n) acc[ai][bj][m][n] *= rs; }
        if (fr == 15) {
#pragma unroll
            for (int ai = 0; ai < 2; ++ai)
#pragma unroll
                for (int bj = 0; bj < 2; ++bj)
#pragma unroll
                    for (int n = 0; n < 2; ++n)
#pragma unroll
                        for (int w = 0; w < 2; ++w) *(PG8_LAS f32x4*)(ex + ((((((wave * 2 + ai) * 2 + bj) * 2 + n) * 4 + fq) * 2 + w) << 2)) = acc[ai][bj][2 + w][n];
        }
        asm volatile("s_waitcnt lgkmcnt(0)" ::: "memory"); __builtin_amdgcn_s_barrier(); asm volatile("" ::: "memory");
        const int cg = u.pn * 128 + wc * 32 + 8 * fq;
        f32x4 wga[2][3], wva[2][3];
#pragma unroll
        for (int n = 0; n < 2; ++n)
#pragma unroll
            for (int j = 0; j < 3; ++j) { wga[n][j] = *(const f32x4*)(cw + (size_t)j * 2 * DFFc + cg + 4 * n); wva[n][j] = *(const f32x4*)(cw + (size_t)j * 2 * DFFc + DFFc + cg + 4 * n); }
#pragma unroll
        for (int ai = 0; ai < 2; ++ai) {
            u32x2 held[4];
#pragma unroll
            for (int n = 0; n < 2; ++n) {
                f32x4 wg[3], wv[3];
#pragma unroll
                for (int j = 0; j < 3; ++j) { wg[j] = wga[n][j]; wv[j] = wva[n][j]; }
                const int sw = wr == 1 ? wave - 4 : wave + 4, sai = wr == 1 ? ai : 0; const bool has = (wr == 1) || (ai == 1);
                const int hb = (((((sw * 2 + sai) * 2 + 0) * 2 + n) * 4 + fq) * 2) << 2, hv = (((((sw * 2 + sai) * 2 + 1) * 2 + n) * 4 + fq) * 2) << 2;
                const f32x4 z4 = (f32x4){0.f, 0.f, 0.f, 0.f};
                const f32x4 g62 = has ? *(const PG8_LAS f32x4*)(ex + hb) : z4, g63 = has ? *(const PG8_LAS f32x4*)(ex + hb + 4) : z4;
                const f32x4 v62 = has ? *(const PG8_LAS f32x4*)(ex + hv) : z4, v63 = has ? *(const PG8_LAS f32x4*)(ex + hv + 4) : z4;
                f32x4 gp3, gp2, vp3, vp2;
#pragma unroll
                for (int e = 0; e < 4; ++e) { gp3[e] = DPP_F(g63[e], acc[ai][0][3][n][e], 0x111); gp2[e] = DPP_F(g62[e], acc[ai][0][2][n][e], 0x111);
                                              vp3[e] = DPP_F(v63[e], acc[ai][1][3][n][e], 0x111); vp2[e] = DPP_F(v62[e], acc[ai][1][2][n][e], 0x111); }
#pragma unroll
                for (int m = 0; m < 4; ++m) {
                    const int rl = ai * HALF + wr * 64 + 4 * fr + m, row = u.pm * 254 - 2 + rl;
                    const f32x4 g0 = acc[ai][0][m][n], v0 = acc[ai][1][m][n];
                    const f32x4 g1 = m == 0 ? gp3 : acc[ai][0][m > 0 ? m - 1 : 0][n], g2 = m == 0 ? gp2 : (m == 1 ? gp3 : acc[ai][0][m > 1 ? m - 2 : 0][n]);
                    const f32x4 v1 = m == 0 ? vp3 : acc[ai][1][m > 0 ? m - 1 : 0][n], v2 = m == 0 ? vp2 : (m == 1 ? vp3 : acc[ai][1][m > 1 ? m - 2 : 0][n]);
                    f32x4 ov;
#pragma unroll
                    for (int e = 0; e < 4; ++e) {
                        const float ug = wg[2][e] * g0[e] + wg[1][e] * g1[e] + wg[0][e] * g2[e], uv = wv[2][e] * v0[e] + wv[1][e] * v1[e] + wv[0][e] * v2[e];
                        ov[e] = ug * __builtin_amdgcn_rcpf(1.0f + __expf(-ug)) * uv;
                    }
                    u32x2 w; w.x = cvt_pk_bf16(ov[0], ov[1]); w.y = cvt_pk_bf16(ov[2], ov[3]);
                    if (n == 0) held[m] = w;
                    else { const int rowc = (rl >= 2 && row < Mrows) ? row : Mrows;
                        *(u32x4*)(ACT + (size_t)rowc * DFFc + cg) = (u32x4){held[m].x, held[m].y, w.x, w.y}; }
                }
            }
        }
    }
};
struct EpiX1 {
    static constexpr bool PERM = true, AFTER_DRAIN = false, KEEP = false, APERM = false;
    const float* X; bf16_t* X1B; float* rss; int ldc;
    __device__ __forceinline__ void operator()(f32x4 (&acc)[2][2][4][2], const Unit& u, int wr, int wc, int fr, int fq) const {
        const int row0 = u.pm * BM + wr * 64 + fr, col0 = u.pn * BM + wc * 32 + 8 * fq;
#pragma unroll
        for (int ai = 0; ai < 2; ++ai) {
            f32x4 xq[4][2][2];
#pragma unroll
            for (int m = 0; m < 4; ++m)
#pragma unroll
                for (int bj = 0; bj < 2; ++bj) { const size_t o = (size_t)(row0 + ai * HALF + m * 16) * ldc + col0 + bj * HALF; xq[m][bj][0] = *(const f32x4*)(X + o); xq[m][bj][1] = *(const f32x4*)(X + o + 4); }
#pragma unroll
            for (int m = 0; m < 4; ++m) { const int row = row0 + ai * HALF + m * 16; const size_t ro = (size_t)row * ldc + col0; float ss = 0.f;
#pragma unroll
                for (int bj = 0; bj < 2; ++bj) { const size_t o = ro + bj * HALF;
                    const f32x4 v0 = xq[m][bj][0] + acc[ai][bj][m][0], v1 = xq[m][bj][1] + acc[ai][bj][m][1];
                    ss += (v0[0] * v0[0] + v0[1] * v0[1]) + (v0[2] * v0[2] + v0[3] * v0[3]) + (v1[0] * v1[0] + v1[1] * v1[1]) + (v1[2] * v1[2] + v1[3] * v1[3]);
                    *(u32x4*)(X1B + o) = pack8(v0, v1); }
                ss += __shfl_xor(ss, 16); ss += __shfl_xor(ss, 32);
                if (fq == 0) unsafeAtomicAdd(rss + row, ss); }
        }
    }
};
struct EpiX2 {
    static constexpr bool PERM = true, AFTER_DRAIN = false, KEEP = false, APERM = false;
    const bf16_t* X1B; bf16_t* XN; int ldc;
    __device__ __forceinline__ void operator()(f32x4 (&acc)[2][2][4][2], const Unit& u, int wr, int wc, int fr, int fq) const {
        const int row0 = u.pm * BM + wr * 64 + fr, col0 = u.pn * BM + wc * 32 + 8 * fq;
        u32x4 tq[2][4][2];
#pragma unroll
        for (int ai = 0; ai < 2; ++ai)
#pragma unroll
            for (int m = 0; m < 4; ++m)
#pragma unroll
                for (int bj = 0; bj < 2; ++bj) tq[ai][m][bj] = *(const u32x4*)(X1B + (size_t)(row0 + ai * HALF + m * 16) * ldc + col0 + bj * HALF);
#pragma unroll
        for (int ai = 0; ai < 2; ++ai)
#pragma unroll
            for (int m = 0; m < 4; ++m)
#pragma unroll
                for (int bj = 0; bj < 2; ++bj) { const size_t o = (size_t)(row0 + ai * HALF + m * 16) * ldc + col0 + bj * HALF; const u32x4 t = tq[ai][m][bj];
                    f32x4 v0 = acc[ai][bj][m][0], v1 = acc[ai][bj][m][1];
                    v0[0] += bf_lo(t.x); v0[1] += bf_hi(t.x); v0[2] += bf_lo(t.y); v0[3] += bf_hi(t.y); v1[0] += bf_lo(t.z); v1[1] += bf_hi(t.z); v1[2] += bf_lo(t.w); v1[3] += bf_hi(t.w);
                    *(u32x4*)(XN + o) = pack8(v0, v1); }
    }
};
struct EpiOut {
    static constexpr bool PERM = true, AFTER_DRAIN = false, KEEP = false, APERM = false;
    const bf16_t* XN; const bf16_t* PP; float* out; int ldc;
    __device__ __forceinline__ void operator()(f32x4 (&acc)[2][2][4][2], const Unit& u, int wr, int wc, int fr, int fq) const {
        const int row0 = u.pm * BM + wr * 64 + fr, col0 = u.pn * BM + wc * 32 + 8 * fq;
#pragma unroll
        for (int ai = 0; ai < 2; ++ai) {
            u32x4 tq[4][2], pq[4][2];
#pragma unroll
            for (int m = 0; m < 4; ++m)
#pragma unroll
                for (int bj = 0; bj < 2; ++bj) { const size_t o = (size_t)(row0 + ai * HALF + m * 16) * ldc + col0 + bj * HALF; tq[m][bj] = *(const u32x4*)(XN + o); pq[m][bj] = *(const u32x4*)(PP + o); }
#pragma unroll
            for (int m = 0; m < 4; ++m)
#pragma unroll
                for (int bj = 0; bj < 2; ++bj) { const size_t o = (size_t)(row0 + ai * HALF + m * 16) * ldc + col0 + bj * HALF; const u32x4 t = tq[m][bj], p = pq[m][bj];
                    const f32x4 a0 = acc[ai][bj][m][0], a1 = acc[ai][bj][m][1]; f32x4 v0, v1;
                    v0[0] = bf_lo(t.x) + sigm(a0[0]) * bf_lo(p.x); v0[1] = bf_hi(t.x) + sigm(a0[1]) * bf_hi(p.x); v0[2] = bf_lo(t.y) + sigm(a0[2]) * bf_lo(p.y); v0[3] = bf_hi(t.y) + sigm(a0[3]) * bf_hi(p.y);
                    v1[0] = bf_lo(t.z) + sigm(a1[0]) * bf_lo(p.z); v1[1] = bf_hi(t.z) + sigm(a1[1]) * bf_hi(p.z); v1[2] = bf_lo(t.w) + sigm(a1[2]) * bf_lo(p.w); v1[3] = bf_hi(t.w) + sigm(a1[3]) * bf_hi(p.w);
                    *(f32x4*)(out + o) = v0; *(f32x4*)(out + o + 4) = v1; }
        }
    }
};

template <class Epi, class Sched, bool ALIGN_EPI = false, bool SP2 = false>
__device__ __forceinline__ void gemm_phase(PG8_LAS unsigned char* lds, const Gemm g, const Sched& S, const Epi& E) {
    const int tid = threadIdx.x, wid = __builtin_amdgcn_readfirstlane(tid >> 6), lane = tid & 63, wr = wid >> 2, wc = wid & 3, fr = lane & 15, fq = lane >> 4;
    const int K = g.K, nt = K / BK;
    unsigned voffA[2], voffB[2];
#pragma unroll
    for (int i = 0; i < 2; ++i) { int R, C; stage_rc(tid * 16 + i * 8192, R, C); const int Rb = Epi::PERM ? ((R & ~31) + perm32(R & 31)) : R;
        const int Ra = Epi::APERM ? ((R & ~63) + 4 * (R & 15) + ((R & 63) >> 4)) : R;
        voffA[i] = (unsigned)(Ra * K + C) * 2u; voffB[i] = (unsigned)(Rb * K + C) * 2u; }
    const size_t kstep = (size_t)(BK * 2);
    const size_t hstep = (size_t)HALF * K * 2;
    const size_t tstep = 2 * hstep; const size_t atstep = g.a_tstep ? g.a_tstep : tstep;
    const unsigned ldsw = (unsigned)wid * 1024u;
    const int aoff = lds_byte(wr * 64 + fr, fq * 8), boff = lds_byte(wc * 32 + fr, fq * 8);
#define PG8_SA(b, h) (((b) * 2 + (h)) * HTB)
#define PG8_SB(b, h) ((4 + (b) * 2 + (h)) * HTB)
#define PG8_STAGE(bufoff, gbase, voff) do { _Pragma("unroll") for (int _i = 0; _i < 2; ++_i) \
        __builtin_amdgcn_global_load_lds((const unsigned*)((const char*)(gbase) + (voff)[_i]), (PG8_LAS unsigned*)(lds + (bufoff) + ldsw + _i * 8192), 16, 0, 0); } while (0)
#define PG8_LDA(dst, b, h) do { _Pragma("unroll") for (int m = 0; m < 4; ++m) _Pragma("unroll") for (int k = 0; k < 2; ++k) dst[m][k] = *(const PG8_LAS bf16x8*)(lds + PG8_SA(b, h) + aoff + m * 2048 + k * 1024); } while (0)
#define PG8_LDB(dst, b, h) do { _Pragma("unroll") for (int n = 0; n < 2; ++n) _Pragma("unroll") for (int k = 0; k < 2; ++k) dst[n][k] = *(const PG8_LAS bf16x8*)(lds + PG8_SB(b, h) + boff + n * 2048 + k * 1024); } while (0)
#define PG8_MMA(ai, bj, At, Bt) do { __builtin_amdgcn_s_setprio(1); _Pragma("unroll") for (int k = 0; k < 2; ++k) _Pragma("unroll") for (int m = 0; m < 4; ++m) _Pragma("unroll") for (int n_ = 0; n_ < 2; ++n_) { const int n = (m & 1) ? 1 - n_ : n_; \
        acc[ai][bj][m][n] = __builtin_amdgcn_mfma_f32_16x16x32_bf16(Bt[n][k], At[m][k], acc[ai][bj][m][n], 0, 0, 0); } __builtin_amdgcn_s_setprio(0); } while (0)
#define PG8_WAIT_V(n) asm volatile("s_waitcnt vmcnt(" #n ")" ::: "memory")
#define PG8_WAIT_L(n) asm volatile("s_waitcnt lgkmcnt(" #n ")" ::: "memory")
#define PG8_BAR __builtin_amdgcn_s_barrier()
#define PG8_SCHED __builtin_amdgcn_sched_barrier(0)
    Unit cur, nxt; int ui = 0;
    if (!S.next(0, cur)) return;
    f32x4 acc[2][2][4][2];
#pragma unroll
    for (int a = 0; a < 2; ++a)
#pragma unroll
        for (int b = 0; b < 2; ++b)
#pragma unroll
            for (int m = 0; m < 4; ++m)
#pragma unroll
                for (int n = 0; n < 2; ++n) acc[a][b][m][n] = (f32x4){0.f, 0.f, 0.f, 0.f};
    bf16x8 At[4][2], B0[2][2], B1[2][2];
    const char* cA = (const char*)g.A + (size_t)cur.pm * atstep + (cur.aux ? g.a_jump : 0); const char* cB = (const char*)g.Bt + (size_t)cur.pn * tstep + (cur.aux ? g.b_jump : 0);
    S.a_ready(cur);
    if constexpr (SP2) {
        PG8_STAGE(PG8_SB(0, 0), cB, voffB); PG8_STAGE(PG8_SB(0, 1), cB + hstep, voffB); PG8_STAGE(PG8_SA(0, 0), cA, voffA); PG8_STAGE(PG8_SA(0, 1), cA + hstep, voffA);
        if (wr == 1) PG8_BAR;
        PG8_WAIT_V(2); PG8_BAR;
        PG8_STAGE(PG8_SB(1, 0), cB + kstep, voffB); PG8_STAGE(PG8_SA(1, 0), cA + kstep, voffA); PG8_STAGE(PG8_SB(1, 1), cB + hstep + kstep, voffB);
        PG8_WAIT_V(6); PG8_BAR;
    } else {
        PG8_STAGE(PG8_SB(0, 0), cB, voffB); PG8_STAGE(PG8_SA(0, 0), cA, voffA); PG8_STAGE(PG8_SB(0, 1), cB + hstep, voffB); PG8_STAGE(PG8_SA(0, 1), cA + hstep, voffA);
        if (wr == 1) PG8_BAR;
        PG8_WAIT_V(4); PG8_BAR;
        PG8_STAGE(PG8_SB(1, 0), cB + kstep, voffB); PG8_STAGE(PG8_SA(1, 0), cA + kstep, voffA); PG8_STAGE(PG8_SB(1, 1), cB + hstep + kstep, voffB);
        PG8_WAIT_V(6); PG8_BAR;
    }
    for (;;) {
        const bool has_next = S.next(ui + 1, nxt);
        const char* nA = has_next ? (const char*)g.A + (size_t)nxt.pm * atstep + (nxt.aux ? g.a_jump : 0) : cA; const char* nB = has_next ? (const char*)g.Bt + (size_t)nxt.pn * tstep + (nxt.aux ? g.b_jump : 0) : cB;
        for (int t = 0; t < nt; t += 2) {
            const bool last = (t == nt - 2);
            const char* a1 = cA + (size_t)(t + 1) * kstep;
            const char* a2 = last ? nA : cA + (size_t)(t + 2) * kstep; const char* b2 = last ? nB : cB + (size_t)(t + 2) * kstep;
            const char* a3 = a2 + kstep; const char* b3 = b2 + kstep;
            if (last && has_next) S.a_ready(nxt);
            if constexpr (SP2) {
            PG8_LDB(B0, 0, 0); PG8_LDB(B1, 0, 1); PG8_SCHED; PG8_LDA(At, 0, 0); PG8_STAGE(PG8_SA(1, 1), a1 + hstep, voffA);
            PG8_WAIT_V(8); PG8_WAIT_L(0); PG8_BAR; PG8_MMA(0, 0, At, B0); PG8_MMA(0, 1, At, B1); PG8_BAR; PG8_SCHED;
            PG8_LDA(At, 0, 1); PG8_STAGE(PG8_SB(0, 0), b2, voffB); PG8_STAGE(PG8_SB(0, 1), b2 + hstep, voffB); PG8_STAGE(PG8_SA(0, 0), a2, voffA);
            PG8_WAIT_V(8); PG8_WAIT_L(0); PG8_BAR; PG8_MMA(1, 0, At, B0); PG8_MMA(1, 1, At, B1); PG8_BAR; PG8_SCHED;
            PG8_LDB(B0, 1, 0); PG8_LDB(B1, 1, 1); PG8_SCHED; PG8_LDA(At, 1, 0); PG8_STAGE(PG8_SA(0, 1), a2 + hstep, voffA);
            PG8_WAIT_V(8); PG8_WAIT_L(0); PG8_BAR; PG8_MMA(0, 0, At, B0); PG8_MMA(0, 1, At, B1); PG8_BAR; PG8_SCHED;
            PG8_LDA(At, 1, 1); PG8_STAGE(PG8_SB(1, 0), b3, voffB); PG8_STAGE(PG8_SB(1, 1), b3 + hstep, voffB); PG8_STAGE(PG8_SA(1, 0), a3, voffA);
            PG8_WAIT_V(8); PG8_WAIT_L(0); PG8_BAR; PG8_MMA(1, 0, At, B0); PG8_MMA(1, 1, At, B1); PG8_BAR; PG8_SCHED;
            } else {
            PG8_LDB(B0, 0, 0); PG8_SCHED; PG8_LDA(At, 0, 0); PG8_STAGE(PG8_SA(1, 1), a1 + hstep, voffA);
            PG8_WAIT_L(8); PG8_BAR; PG8_WAIT_L(0); PG8_MMA(0, 0, At, B0); PG8_BAR; PG8_SCHED;
            PG8_LDB(B1, 0, 1); PG8_STAGE(PG8_SB(0, 0), b2, voffB);
            PG8_BAR; PG8_WAIT_L(0); PG8_MMA(0, 1, At, B1); PG8_BAR;
            PG8_LDA(At, 0, 1); PG8_STAGE(PG8_SA(0, 0), a2, voffA);
            PG8_BAR; PG8_WAIT_L(0); PG8_MMA(1, 0, At, B0); PG8_BAR; PG8_SCHED;
            PG8_STAGE(PG8_SB(0, 1), b2 + hstep, voffB);
            PG8_WAIT_V(6); PG8_BAR; PG8_MMA(1, 1, At, B1); PG8_BAR;
            PG8_LDB(B0, 1, 0); PG8_SCHED; PG8_LDA(At, 1, 0); PG8_STAGE(PG8_SA(0, 1), a2 + hstep, voffA);
            PG8_WAIT_L(8); PG8_BAR; PG8_WAIT_L(0); PG8_MMA(0, 0, At, B0); PG8_BAR; PG8_SCHED;
            PG8_LDB(B1, 1, 1); PG8_STAGE(PG8_SB(1, 0), b3, voffB);
            PG8_BAR; PG8_WAIT_L(0); PG8_MMA(0, 1, At, B1); PG8_BAR;
            PG8_LDA(At, 1, 1); PG8_STAGE(PG8_SA(1, 0), a3, voffA);
            PG8_BAR; PG8_WAIT_L(0); PG8_MMA(1, 0, At, B0); PG8_BAR; PG8_SCHED;
            PG8_STAGE(PG8_SB(1, 1), b3 + hstep, voffB);
            PG8_WAIT_V(6); PG8_BAR; PG8_MMA(1, 1, At, B1); PG8_BAR;
            }
        }
        if constexpr (ALIGN_EPI) { if (wr == 0) PG8_BAR; }
        asm volatile("s_nop 15\n\ts_nop 7" ::: "memory");
        if constexpr (!Epi::AFTER_DRAIN) { E(acc, cur, wr, wc, fr, fq); S.done(cur); }
        if (!has_next) break;
        if (!Epi::KEEP || cur.aux != 0) {
#pragma unroll
        for (int a = 0; a < 2; ++a)
#pragma unroll
            for (int b = 0; b < 2; ++b)
#pragma unroll
                for (int m = 0; m < 4; ++m)
#pragma unroll
                    for (int n = 0; n < 2; ++n) acc[a][b][m][n] = (f32x4){0.f, 0.f, 0.f, 0.f};
        }
        cur = nxt; cA = nA; cB = nB; ++ui;
        if constexpr (ALIGN_EPI) { if (wr == 1) PG8_BAR; }
    }
    PG8_WAIT_V(0);
    if constexpr (!ALIGN_EPI) { if (wr == 0) PG8_BAR; }
    PG8_BAR;
    if constexpr (Epi::AFTER_DRAIN) { E.fused(acc, cur, wr, wc, fr, fq, lds, wid, lane); S.done(cur); }
#undef PG8_SA
#undef PG8_SB
#undef PG8_STAGE
#undef PG8_LDA
#undef PG8_LDB
#undef PG8_MMA
#undef PG8_WAIT_V
#undef PG8_WAIT_L
#undef PG8_BAR
#undef PG8_SCHED
}
}
#define GAS __attribute__((address_space(1)))
#define LAS __attribute__((address_space(3)))
typedef unsigned short bf16;
typedef unsigned v4u __attribute__((ext_vector_type(4)));
typedef float f32x4 __attribute__((ext_vector_type(4)));
typedef short bf16x8 __attribute__((ext_vector_type(8)));
typedef GAS unsigned gu32;
typedef GAS unsigned long long gu64;
#define RLX_AGENT __ATOMIC_RELAXED, __HIP_MEMORY_SCOPE_AGENT
#define LDS_WAIT() asm volatile("s_waitcnt lgkmcnt(0)" ::: "memory")
#define VM_WAIT() asm volatile("s_waitcnt vmcnt(0)" ::: "memory")
__device__ __forceinline__ unsigned long long rt() { return __builtin_amdgcn_s_memrealtime(); }
__device__ __forceinline__ unsigned f2bf(float f) { unsigned u = __builtin_bit_cast(unsigned, f); return (u + 0x7fffu + ((u >> 16) & 1u)) >> 16; }
typedef float pk2_f32x2 __attribute__((ext_vector_type(2))); typedef __bf16 pk2_bf16x2 __attribute__((ext_vector_type(2)));
__device__ __forceinline__ unsigned pk2(float lo, float hi) { pk2_f32x2 v = {lo, hi}; pk2_bf16x2 b = __builtin_convertvector(v, pk2_bf16x2); return __builtin_bit_cast(unsigned, b); }

#define XB_TMO      128
#define XB_XCNT(j)  (256  + 64 * (j))
#define XB_XSUB(j)  (1280 + 64 * (j))
#define XB_XGEN(j)  (2304 + 64 * (j))
#define XB_TOP      3328
#define XB_TOPGEN   3392
#define XCD_BAR_WORDS 3456
#define XB_SPIN_CAP (1u << 18)

__device__ __forceinline__ unsigned xb_ld(unsigned* p)              { return __hip_atomic_load(p, __ATOMIC_RELAXED, __HIP_MEMORY_SCOPE_AGENT); }
__device__ __forceinline__ unsigned xb_add(unsigned* p, unsigned v) { return __hip_atomic_fetch_add(p, v, __ATOMIC_RELAXED, __HIP_MEMORY_SCOPE_AGENT); }
__device__ __forceinline__ unsigned xb_xcc_id() { return (unsigned)__builtin_amdgcn_s_getreg((3 << 11) | 20) & 0xFu; }
#define XB_SPIN(cond, bar) do { unsigned _sp = 0; while (cond) { __builtin_amdgcn_s_sleep(1); \
    if ((++_sp & 255u) == 0u) { if (xb_ld(&(bar)[XB_TMO])) break; if (_sp > XB_SPIN_CAP) { atomicAdd(&(bar)[XB_TMO], 1u); break; } } } } while (0)

struct XcdBarrier {
    unsigned* bar; unsigned x;
    volatile LAS unsigned* st;
};

__device__ __forceinline__ XcdBarrier xcd_barrier_post(unsigned* bar, volatile LAS unsigned* st) {
    XcdBarrier b; b.bar = bar; b.x = xb_xcc_id(); b.st = st;
    if (threadIdx.x == 0) (void)xb_add(&bar[XB_XCNT(b.x)], 1u);
    return b;
}
__device__ __forceinline__ void xcd_barrier_complete(unsigned* bar, unsigned x, unsigned& nloc, unsigned& nx) {
    const unsigned G = gridDim.x * gridDim.y * gridDim.z;
    unsigned sum, cnt, mine, sp = 0u;
    for (;;) {
        sum = 0u; cnt = 0u; mine = 0u;
#pragma unroll
        for (unsigned j = 0; j < 16; ++j) { const unsigned c = xb_ld(&bar[XB_XCNT(j)]); sum += c; cnt += (c > 0u) ? 1u : 0u; mine = (j == x) ? c : mine; }
        if (sum == G) break;
        __builtin_amdgcn_s_sleep(1);
        if ((++sp & 255u) == 0u) { if (xb_ld(&bar[XB_TMO])) break; if (sp > XB_SPIN_CAP) { atomicAdd(&bar[XB_TMO], 1u); break; } }
    }
    nloc = mine > 0u ? mine : 1u; nx = cnt > 0u ? cnt : 1u;
}

__device__ __forceinline__ void xcd_barrier(const XcdBarrier& b) {
    asm volatile("s_waitcnt vmcnt(0)" ::: "memory");
    __syncthreads();
    if (threadIdx.x == 0) {
        unsigned* bar = b.bar;
        __builtin_amdgcn_s_waitcnt(0);
        unsigned nloc = b.st[0], nx = b.st[1];
        if (nloc == 0u) { xcd_barrier_complete(bar, b.x, nloc, nx); b.st[0] = nloc; b.st[1] = nx; }
        const unsigned old = xb_add(&bar[XB_XSUB(b.x)], 1u);
        const unsigned gen = old / nloc;
        if (old + 1u == (gen + 1u) * nloc) {
            __builtin_amdgcn_fence(__ATOMIC_RELEASE, "agent");
            asm volatile("s_waitcnt vmcnt(0)" ::: "memory");
            const unsigned og = xb_add(&bar[XB_TOP], 1u);
            const unsigned tg = og / nx;
            if (og + 1u == (tg + 1u) * nx) xb_add(&bar[XB_TOPGEN], 1u);
            else XB_SPIN(xb_ld(&bar[XB_TOPGEN]) == tg, bar);
            __builtin_amdgcn_fence(__ATOMIC_ACQUIRE, "agent");
            xb_add(&bar[XB_XGEN(b.x)], 1u);
            asm volatile("s_waitcnt vmcnt(0)" ::: "memory");
        } else {
            XB_SPIN(xb_ld(&bar[XB_XGEN(b.x)]) == gen, bar);
            __builtin_amdgcn_fence(__ATOMIC_ACQUIRE, "agent");
            asm volatile("s_waitcnt vmcnt(0)" ::: "memory");
        }
    }
    __syncthreads();
}

constexpr int NWAVES = 8;
constexpr int M = 16384, D = 4096, DIN = 20480, DA = 2048, NH = 16, HD = 128, DFF = 11008, DFH = 5504, DPLE = 256, NBLK = 64, BLK = 256;
constexpr float RMS_EPS = 1e-6f;
constexpr float ATT_SCALE = 0.08838834764831845f;
#ifndef MK_PER_PHASE
#define MK_PER_PHASE 0
#endif
#ifndef PROBE_PHASE
#define PROBE_PHASE -1
#endif
#ifndef PROBE_FLAGS
#define PROBE_FLAGS 0
#endif
constexpr int NPH = 17;
#ifndef GEMM_WGM
#define GEMM_WGM 4
#endif

constexpr size_t MiB = 1u << 20;
constexpr size_t WS_CTL = 0, CTL_ZERO_BYTES = 1 * MiB;
constexpr size_t WS_KMH = 1 * MiB, WS_KML = 1 * MiB + 256 * 1024;
constexpr size_t WS_LSE = 2 * MiB;
constexpr size_t WS_PB = 8 * MiB;
constexpr size_t WS_WUP = 16 * MiB, WS_WDN = 188 * MiB, WS_WPG = 274 * MiB, WS_WP = 306 * MiB;
constexpr size_t WS_XN = 309 * MiB;
constexpr size_t WS_WO = 438 * MiB, WS_WA = 470 * MiB, WS_WC = 486 * MiB, WS_WIN = 502 * MiB;
constexpr size_t WS_Z = 662 * MiB;
constexpr size_t WS_Q = WS_Z, WS_K = WS_Z + 64 * MiB, WS_V = WS_Z + 128 * MiB, WS_CB = WS_Z + 192 * MiB, WS_CC = WS_Z + 256 * MiB, WS_CX = WS_Z + 320 * MiB, WS_GA = WS_Z + 384 * MiB, WS_GC = WS_Z + 512 * MiB;
constexpr size_t WS_LIST = 1302 * MiB;
constexpr size_t WS_TAB = 1336 * MiB;
constexpr size_t WS_END = 1344 * MiB;
constexpr size_t WS_S0 = WS_XN, WS_S1 = WS_XN + 64 * MiB, WS_S2 = WS_CC;
constexpr size_t WS_T1 = WS_XN, WS_MERGED = WS_K, WS_PP = WS_GC, WS_Y = 438 * MiB, WS_ACT = 782 * MiB;
constexpr size_t WS_X1B = 502 * MiB;
static_assert(WS_Y + (size_t)M * DFF * 2 <= WS_ACT && WS_ACT + (size_t)(M + 1) * DFF * 2 <= WS_PP && WS_LIST + (size_t)16 * 516096 * 4 <= WS_TAB && WS_GC + 128 * MiB == WS_LIST, "d_ws map");
constexpr int CW_TMO = 0, CW_CODE = 1, CW_QHEAD = 64, CW_BAR = 4096, CW_CNT = 16384, CW_RSS = 32768;
constexpr int LIST_PER_HEAD = 516096;
__host__ __device__ __forceinline__ int list_base(int h, int j) { return h * LIST_PER_HEAD + 256 * (63 * j - (j * (j - 1)) / 2); }

constexpr int RING_OFF = 0, RING_BYTES = 131072;
constexpr int MISC_OFF = 153600;
constexpr int LDS_BYTES = 155648;

struct Args { const void* in[17]; float* out; unsigned char* ws; int ph_lo, ph_hi, use_bar, bar_off, flags, pad; };

__device__ __forceinline__ float wave_sum(float v) {
#pragma unroll
    for (int o = 1; o < 64; o <<= 1) v += __shfl_xor(v, o);
    return v;
}
__device__ __forceinline__ float wave_max(float v) {
#pragma unroll
    for (int o = 1; o < 64; o <<= 1) v = fmaxf(v, __shfl_xor(v, o));
    return v;
}
__device__ __forceinline__ float bflo(unsigned w) { return __uint_as_float(w << 16); }
__device__ __forceinline__ float bfhi(unsigned w) { return __uint_as_float(w & 0xffff0000u); }

template <int RM> __device__ __forceinline__ int rowmap(int n) {
    if (RM == 0) return n;
    if (RM == 2) {
        if (n < 6 * DA) return n;
        const int g = n - 6 * DA; return g < D ? 6 * DA + (g >> 7) * 256 + (g & 127) : 6 * DA + ((g - D) >> 7) * 256 + 128 + ((g - D) & 127);
    }
    if (n < DFF) return (n >> 7) * 256 + (n & 127);
    const int n2 = n - DFF; return (n2 >> 7) * 256 + 128 + (n2 & 127);
}
template <int RM> __device__ __forceinline__ void p0_transpose_item(const float* W, int K, int N, bf16* WT, LAS float* scrf, int item, int lane, const float* kscale = nullptr) {
    LAS unsigned* scr = (LAS unsigned*)scrf;
    const int nblk = N / 64, kb = item / nblk, nb = item % nblk, k0 = 64 * kb, n0 = 64 * nb;
    const float* src = W + (size_t)k0 * N + n0 + lane;
    float v[64];
#pragma unroll
    for (int i = 0; i < 64; ++i) v[i] = __builtin_nontemporal_load(src + (size_t)i * N);
    if (kscale) {
#pragma unroll
        for (int i = 0; i < 64; ++i) v[i] *= kscale[k0 + i]; }
#pragma unroll
    for (int i = 0; i < 32; ++i) scr[i * 65 + lane] = pk2(v[2 * i], v[2 * i + 1]);
    LDS_WAIT(); asm volatile("" ::: "memory");
    const int c = lane & 7, nl = lane >> 3;
#pragma unroll
    for (int j = 0; j < 8; ++j) { const int n = nl + 8 * j; const LAS unsigned* s = scr + (4 * c) * 65 + n;
        v4u o; o.x = s[0 * 65]; o.y = s[1 * 65]; o.z = s[2 * 65]; o.w = s[3 * 65];
        *(v4u*)(WT + (size_t)rowmap<RM>(n0 + n) * K + k0 + 8 * c) = o; }
    LDS_WAIT(); asm volatile("" ::: "memory");
}
__device__ __forceinline__ void rms_row_to_bf16(const float* xrow, const f32x4 (&gv)[16], bf16* orow, int lane) {
    const f32x4* xr = (const f32x4*)xrow + lane;
    f32x4 v[16]; float s = 0.f;
#pragma unroll
    for (int j = 0; j < 16; ++j) { v[j] = __builtin_nontemporal_load(xr + 64 * j); s += (v[j].x * v[j].x + v[j].y * v[j].y) + (v[j].z * v[j].z + v[j].w * v[j].w); }
    const float r = 1.0f / sqrtf(wave_sum(s) * (1.f / D) + RMS_EPS);
    unsigned long long* o8 = (unsigned long long*)orow + lane;
#pragma unroll
    for (int j = 0; j < 16; ++j)
        o8[64 * j] = (unsigned long long)pk2(v[j].x * r * gv[j].x, v[j].y * r * gv[j].y) | ((unsigned long long)pk2(v[j].z * r * gv[j].z, v[j].w * r * gv[j].w) << 32);
}

__device__ __forceinline__ void p0_prologue(LAS unsigned char* lds, const Args& a, int G, int wave, int lane) {
    unsigned char* ws = a.ws;
    LAS float* scr = (LAS float*)lds + wave * (64 * 65);
    const int gw = blockIdx.x * NWAVES + wave, NGW = G * NWAVES;
    constexpr int I_IN = (D / 64) * (DIN / 64), I_A = (DA / 64) * (D / 64), I_O = (D / 64) * (D / 64), I_UP = (D / 64) * (2 * DFF / 64), I_DN = (DFF / 64) * (D / 64), I_P = (DPLE / 64) * (D / 64);
    constexpr int NITEMS = I_IN + 2 * I_A + 2 * I_O + I_UP + I_DN + I_P;
    for (int it = gw; it < NITEMS; it += NGW) {
        int r = it;
        if (r < I_IN) { p0_transpose_item<2>((const float*)a.in[4], D, DIN, (bf16*)(ws + WS_WIN), scr, r, lane); continue; } r -= I_IN;
        if (r < I_UP) { p0_transpose_item<1>((const float*)a.in[12], D, 2 * DFF, (bf16*)(ws + WS_WUP), scr, r, lane, (const float*)a.in[11]); continue; } r -= I_UP;
        if (r < I_DN) { p0_transpose_item<0>((const float*)a.in[14], DFF, D, (bf16*)(ws + WS_WDN), scr, r, lane); continue; } r -= I_DN;
        if (r < I_A) { p0_transpose_item<0>((const float*)a.in[8], DA, D, (bf16*)(ws + WS_WA), scr, r, lane); continue; } r -= I_A;
        if (r < I_A) { p0_transpose_item<0>((const float*)a.in[9], DA, D, (bf16*)(ws + WS_WC), scr, r, lane); continue; } r -= I_A;
        if (r < I_O) { p0_transpose_item<0>((const float*)a.in[10], D, D, (bf16*)(ws + WS_WO), scr, r, lane); continue; } r -= I_O;
        if (r < I_O) { p0_transpose_item<0>((const float*)a.in[16], D, D, (bf16*)(ws + WS_WPG), scr, r, lane); continue; } r -= I_O;
        p0_transpose_item<0>((const float*)a.in[15], DPLE, D, (bf16*)(ws + WS_WP), scr, r, lane);
    }
    const float* x = (const float*)a.in[0]; const float* g1 = (const float*)a.in[3]; bf16* XN = (bf16*)(ws + WS_XN);
    f32x4 gv[16];
#pragma unroll
    for (int j = 0; j < 16; ++j) gv[j] = ((const f32x4*)g1)[lane + 64 * j];
    for (int m = gw; m < M; m += NGW) rms_row_to_bf16(x + (size_t)m * D, gv, XN + (size_t)m * D, lane);
    const f32x4* p4 = (const f32x4*)a.in[1]; v4u* pb = (v4u*)(ws + WS_PB);
    for (int i = gw * 64 + lane; i < M * DPLE / 8; i += NGW * 64) { const f32x4 u0 = p4[2 * i], u1 = p4[2 * i + 1]; v4u o; o.x = pk2(u0.x, u0.y); o.y = pk2(u0.z, u0.w); o.z = pk2(u1.x, u1.y); o.w = pk2(u1.z, u1.w); pb[i] = o; }
}

__device__ __forceinline__ void p0_rope_table(unsigned char* ws, const int* pos, int G, int wave, int lane) {
    typedef float f32x2v __attribute__((ext_vector_type(2)));
    f32x2v* tab = (f32x2v*)(ws + WS_TAB);
    const float ifr = (float)pow(10000.0, -(double)lane / 64.0);
    const int gw = blockIdx.x * NWAVES + wave, NGW = G * NWAVES;
    for (int t = gw; t < M; t += NGW) { const float a = (float)pos[t] * ifr; tab[(size_t)t * 64 + lane] = (f32x2v){cosf(a), sinf(a)}; }
}
__device__ __forceinline__ void p2_qk(LAS unsigned char* lds, unsigned char* ws, const float* qn, const float* kn, int G, int tid, int nost) {
    (void)nost;
    LAS float* red = (LAS float*)lds;
    bf16* __restrict__ Qb = (bf16*)(ws + WS_Q); bf16* __restrict__ Kb = (bf16*)(ws + WS_K);
    const f32x4* tab = (const f32x4*)(ws + WS_TAB);
    bf16* kmh = (bf16*)(ws + WS_KMH); bf16* kml = (bf16*)(ws + WS_KML);
    const int gidx = tid >> 3, c = tid & 7, hl = gidx & 3, ts = gidx >> 2;
    float gq[16], gk[16];
#pragma unroll
    for (int e = 0; e < 8; ++e) { gq[e] = qn[8 * c + e]; gq[8 + e] = qn[64 + 8 * c + e]; gk[e] = kn[8 * c + e]; gk[8 + e] = kn[64 + 8 * c + e]; }
    for (int it = blockIdx.x; it < NBLK * 4; it += G) {
        const int jb = it >> 2, hg = it & 3, head = hg * 4 + hl;
        float ks[16];
#pragma unroll
        for (int e = 0; e < 16; ++e) ks[e] = 0.f;
#pragma unroll 2
        for (int i = 0; i < 16; ++i) {
            const int t = jb * BLK + 16 * i + ts;
            const f32x4* tp = tab + (size_t)t * 32 + 4 * c;
            const f32x4 cs0 = tp[0], cs1 = tp[1], cs2 = tp[2], cs3 = tp[3];
            const float cs[16] = {cs0.x, cs0.y, cs0.z, cs0.w, cs1.x, cs1.y, cs1.z, cs1.w, cs2.x, cs2.y, cs2.z, cs2.w, cs3.x, cs3.y, cs3.z, cs3.w};
#pragma unroll
            for (int ten = 0; ten < 2; ++ten) {
                bf16* ptr = (ten ? Kb : Qb) + (size_t)t * DA + head * HD + 8 * c;
                const v4u lo = *(const v4u*)ptr, hi = *(const v4u*)(ptr + 64);
                float x[16];
#pragma unroll
                for (int e = 0; e < 4; ++e) { x[2 * e] = bflo(lo[e]); x[2 * e + 1] = bfhi(lo[e]); x[8 + 2 * e] = bflo(hi[e]); x[9 + 2 * e] = bfhi(hi[e]); }
                float ss = 0.f;
#pragma unroll
                for (int e = 0; e < 16; ++e) ss += x[e] * x[e];
                ss += __shfl_xor(ss, 1); ss += __shfl_xor(ss, 2); ss += __shfl_xor(ss, 4);
                const float r = 1.0f / sqrtf(ss * (1.f / HD) + RMS_EPS);
                float o[16];
#pragma unroll
                for (int e = 0; e < 8; ++e) { const float y0 = x[e] * r * (ten ? gk[e] : gq[e]), y1 = x[8 + e] * r * (ten ? gk[8 + e] : gq[8 + e]); const float cc = cs[2 * e], sn = cs[2 * e + 1];
                    o[e] = y0 * cc - y1 * sn; o[8 + e] = y1 * cc + y0 * sn; }
                v4u wl, wh;
#pragma unroll
                for (int e = 0; e < 4; ++e) { wl[e] = pk2(o[2 * e], o[2 * e + 1]); wh[e] = pk2(o[8 + 2 * e], o[9 + 2 * e]); }
                *(v4u*)ptr = wl; *(v4u*)(ptr + 64) = wh;
                if (ten) {
#pragma unroll
                    for (int e = 0; e < 16; ++e) ks[e] += o[e]; }
            }
        }
        __syncthreads();
#pragma unroll
        for (int e = 0; e < 4; ++e) *(LAS f32x4*)(red + (gidx * 8 + c) * 16 + 4 * e) = (f32x4){ks[4 * e], ks[4 * e + 1], ks[4 * e + 2], ks[4 * e + 3]};
        __syncthreads();
        {
            const int h2 = tid >> 7, d = tid & 127, c2 = (d & 63) >> 3, e2 = (d & 7) + ((d >> 6) << 3);
            float s = 0.f;
#pragma unroll
            for (int t2 = 0; t2 < 16; ++t2) s += red[((t2 * 4 + h2) * 8 + c2) * 16 + e2];
            s *= (1.f / BLK);
            const unsigned hb = f2bf(s); const float hf = __uint_as_float(hb << 16);
            const size_t o = ((size_t)(hg * 4 + h2) * NBLK + jb) * HD + d;
            kmh[o] = (bf16)hb; kml[o] = (bf16)f2bf(s - hf);
        }
    }
}
__device__ __forceinline__ void p2_conv(unsigned char* ws, const float* cw, int G, int wave, int lane, int nost) {
    (void)nost;
    bf16* __restrict__ CB = (bf16*)(ws + WS_CB); const bf16* __restrict__ CC = (const bf16*)(ws + WS_CC); const bf16* __restrict__ CX = (const bf16*)(ws + WS_CX);
    const int gw = blockIdx.x * NWAVES + wave, NGW = G * NWAVES;
    for (int it = gw; it < (M / 32) * 4; it += NGW) {
        const int rc = it >> 2, st = it & 3, c = st * 512 + lane * 8, t0 = rc * 32;
        float w0[8], w1[8], w2[8], p1[8], p2[8];
#pragma unroll
        for (int e = 0; e < 8; ++e) { w0[e] = cw[c + e]; w1[e] = cw[DA + c + e]; w2[e] = cw[2 * DA + c + e]; p1[e] = 0.f; p2[e] = 0.f; }
        if (t0 >= 2) {
            const v4u a2 = *(const v4u*)(CC + (size_t)(t0 - 2) * DA + c), b2 = *(const v4u*)(CX + (size_t)(t0 - 2) * DA + c);
            const v4u a1 = *(const v4u*)(CC + (size_t)(t0 - 1) * DA + c), b1 = *(const v4u*)(CX + (size_t)(t0 - 1) * DA + c);
#pragma unroll
            for (int e = 0; e < 4; ++e) { p2[2 * e] = bflo(a2[e]) * bflo(b2[e]); p2[2 * e + 1] = bfhi(a2[e]) * bfhi(b2[e]); p1[2 * e] = bflo(a1[e]) * bflo(b1[e]); p1[2 * e + 1] = bfhi(a1[e]) * bfhi(b1[e]); }
        }
#pragma unroll 1
        for (int tb = 0; tb < 32; tb += 8) {
            v4u ra[8], rb[8], rg[8];
#pragma unroll
            for (int k = 0; k < 8; ++k) { const size_t o = (size_t)(t0 + tb + k) * DA + c; ra[k] = *(const v4u*)(CC + o); rb[k] = *(const v4u*)(CX + o); rg[k] = *(const v4u*)(CB + o); }
#pragma unroll
            for (int k = 0; k < 8; ++k) {
                const size_t o = (size_t)(t0 + tb + k) * DA + c;
                float pr[8], out[8];
#pragma unroll
                for (int e = 0; e < 4; ++e) { pr[2 * e] = bflo(ra[k][e]) * bflo(rb[k][e]); pr[2 * e + 1] = bfhi(ra[k][e]) * bfhi(rb[k][e]); }
#pragma unroll
                for (int e = 0; e < 8; ++e) { const float gb = (e & 1) ? bfhi(rg[k][e >> 1]) : bflo(rg[k][e >> 1]); out[e] = gb * (w2[e] * pr[e] + w1[e] * p1[e] + w0[e] * p2[e]); p2[e] = p1[e]; p1[e] = pr[e]; }
                v4u ov; ov.x = pk2(out[0], out[1]); ov.y = pk2(out[2], out[3]); ov.z = pk2(out[4], out[5]); ov.w = pk2(out[6], out[7]);
                *(v4u*)(CB + o) = ov;
            }
        }
    }
}

typedef float f32x16g __attribute__((ext_vector_type(16)));
#define P3_BETTER(v, j, bv, bj) ((v) > (bv) || ((v) == (bv) && (j) < (bj)))
#define P3_INSERT(v, j) do { const bool b0_ = P3_BETTER(v, j, t0v, t0j), b1_ = P3_BETTER(v, j, t1v, t1j), b2_ = P3_BETTER(v, j, t2v, t2j); \
    t2v = b1_ ? t1v : (b2_ ? (v) : t2v); t2j = b1_ ? t1j : (b2_ ? (j) : t2j); t1v = b0_ ? t0v : (b1_ ? (v) : t1v); t1j = b0_ ? t0j : (b1_ ? (j) : t1j); t0v = b0_ ? (v) : t0v; t0j = b0_ ? (j) : t0j; } while (0)
__device__ __forceinline__ void p3_gate(LAS unsigned char* lds, unsigned char* ws, gu32* ctl, int G, int tid, int wave, int lane, int nost) {
    const bf16* Qb = (const bf16*)(ws + WS_Q); const bf16* kmh = (const bf16*)(ws + WS_KMH); const bf16* kml = (const bf16*)(ws + WS_KML); unsigned* list = (unsigned*)(ws + WS_LIST);
    LAS unsigned* lcnt = (LAS unsigned*)(lds + 32768); LAS unsigned* lbase = (LAS unsigned*)(lds + 32768 + 256);
    const int r = lane & 31, hi = lane >> 5;
    int koff[8];
#pragma unroll
    for (int ds = 0; ds < 8; ++ds) koff[ds] = r * 256 + (((2 * ds + hi) ^ (r & 15)) << 4);
    for (int it = blockIdx.x; it < NH * (NBLK - 1); it += G) {
        const int h = it / (NBLK - 1), qb = 1 + it % (NBLK - 1);
        __syncthreads();
#pragma unroll
        for (int i = 0; i < 2; ++i) { const int n = wave * 2 + i, p = n * 64 + lane, j = p >> 4, pc = p & 15, ck = pc ^ (j & 15);
            __builtin_amdgcn_global_load_lds((const unsigned*)(kmh + ((size_t)h * NBLK + j) * HD + ck * 8), (LAS unsigned*)(lds + n * 1024), 16, 0, 0);
            __builtin_amdgcn_global_load_lds((const unsigned*)(kml + ((size_t)h * NBLK + j) * HD + ck * 8), (LAS unsigned*)(lds + 16384 + n * 1024), 16, 0, 0); }
        if (tid < 64) lcnt[tid] = 0u;
        const int t = qb * BLK + wave * 32 + r;
        bf16x8 qf[8];
#pragma unroll
        for (int ds = 0; ds < 8; ++ds) qf[ds] = *(const bf16x8*)(Qb + (size_t)t * DA + h * HD + 16 * ds + 8 * hi);
        asm volatile("s_waitcnt vmcnt(0)" ::: "memory");
        __syncthreads();
        f32x16g g0, g1;
#pragma unroll
        for (int e = 0; e < 16; ++e) { g0[e] = 0.f; g1[e] = 0.f; }
#pragma unroll
        for (int ds = 0; ds < 8; ++ds) {
            const bf16x8 a0 = *(const LAS bf16x8*)(lds + koff[ds]), a1 = *(const LAS bf16x8*)(lds + koff[ds] + 8192);
            const bf16x8 b0 = *(const LAS bf16x8*)(lds + 16384 + koff[ds]), b1 = *(const LAS bf16x8*)(lds + 16384 + koff[ds] + 8192);
            g0 = __builtin_amdgcn_mfma_f32_32x32x16_bf16(a0, qf[ds], g0, 0, 0, 0); g1 = __builtin_amdgcn_mfma_f32_32x32x16_bf16(a1, qf[ds], g1, 0, 0, 0);
            g0 = __builtin_amdgcn_mfma_f32_32x32x16_bf16(b0, qf[ds], g0, 0, 0, 0); g1 = __builtin_amdgcn_mfma_f32_32x32x16_bf16(b1, qf[ds], g1, 0, 0, 0);
        }
        float vv[32];
#pragma unroll
        for (int e = 0; e < 16; ++e) { const int j = (e & 3) + 8 * (e >> 2) + 4 * hi; vv[e] = j < qb ? g0[e] : -INFINITY; vv[16 + e] = (32 + j) < qb ? g1[e] : -INFINITY; }
        float t0v, t1v, t2v; int t0j, t1j, t2j;
#define P3_SCAN(TV, TJ, SENT) do { TV = -INFINITY; TJ = (SENT); \
    _Pragma("unroll") for (int e = 0; e < 32; ++e) { const int j = 32 * (e >> 4) + ((e & 15) & 3) + 8 * ((e & 15) >> 2) + 4 * hi; if (vv[e] > TV) { TV = vv[e]; TJ = j; } } \
    _Pragma("unroll") for (int e = 0; e < 32; ++e) { const int j = 32 * (e >> 4) + ((e & 15) & 3) + 8 * ((e & 15) >> 2) + 4 * hi; if (j == TJ) vv[e] = -INFINITY; } } while (0)
        P3_SCAN(t0v, t0j, 64); P3_SCAN(t1v, t1j, 65); P3_SCAN(t2v, t2j, 66);
#undef P3_SCAN
        {
            const float p0v = __shfl_xor(t0v, 32), p1v = __shfl_xor(t1v, 32), p2v = __shfl_xor(t2v, 32);
            const int p0j = __shfl_xor(t0j, 32), p1j = __shfl_xor(t1j, 32), p2j = __shfl_xor(t2j, 32);
            P3_INSERT(p0v, p0j); P3_INSERT(p1v, p1j); P3_INSERT(p2v, p2j);
        }
        const int nvalid = qb < 3 ? qb : 3;
        unsigned rk0 = 0u, rk1 = 0u, rk2 = 0u;
        if (hi == 0) {
            rk0 = __hip_atomic_fetch_add(lcnt + t0j, 1u, __ATOMIC_RELAXED, __HIP_MEMORY_SCOPE_WORKGROUP);
            if (nvalid > 1) rk1 = __hip_atomic_fetch_add(lcnt + t1j, 1u, __ATOMIC_RELAXED, __HIP_MEMORY_SCOPE_WORKGROUP);
            if (nvalid > 2) rk2 = __hip_atomic_fetch_add(lcnt + t2j, 1u, __ATOMIC_RELAXED, __HIP_MEMORY_SCOPE_WORKGROUP);
        }
        __syncthreads();
        if (tid < 64) { const unsigned n = lcnt[tid]; lbase[tid] = (n && !nost) ? __hip_atomic_fetch_add((unsigned*)ctl + CW_CNT + h * NBLK + tid, n, __ATOMIC_RELAXED, __HIP_MEMORY_SCOPE_AGENT) : 0u; }
        __syncthreads();
        if (hi == 0 && !nost) {
            list[list_base(h, t0j) + lbase[t0j] + rk0] = (unsigned)t;
            if (nvalid > 1) list[list_base(h, t1j) + lbase[t1j] + rk1] = (1u << 14) | (unsigned)t;
            if (nvalid > 2) list[list_base(h, t2j) + lbase[t2j] + rk2] = (2u << 14) | (unsigned)t;
        }
    }
}

typedef float f32x16 __attribute__((ext_vector_type(16)));
typedef short s16x4 __attribute__((ext_vector_type(4)));
typedef float f32x2_t __attribute__((ext_vector_type(2)));
typedef __bf16 bf16x2_t __attribute__((ext_vector_type(2)));
__device__ __forceinline__ unsigned cvtpk(float lo, float hi) { f32x2_t v = {lo, hi}; bf16x2_t b = __builtin_convertvector(v, bf16x2_t); return __builtin_bit_cast(unsigned, b); }
__device__ __forceinline__ int crow(int r, int hi) { return (r & 3) + 8 * (r >> 2) + 4 * hi; }
constexpr int ATT_K_OFF = 0, ATT_V_OFF = 65536, ATT_PRE_OFF = 131072;
constexpr float ATT_C = ATT_SCALE * 1.4426950408889634f, LN2F = 0.6931471805599453f;

__device__ __forceinline__ void stage_kv(LAS unsigned char* lds, const bf16* Kb, const bf16* Vb, int h, int j, int wave, int lane) {
#pragma unroll
    for (int i = 0; i < 8; ++i) {
        const int n = wave * 8 + i, p = n * 64 + lane, key = p >> 4, pc = p & 15;
        const int ck = pc ^ (key & 15), cv = pc ^ ((key & 3) << 2);
        const size_t ro = (size_t)(j * BLK + key) * DA + h * HD;
        __builtin_amdgcn_global_load_lds((const unsigned*)(Kb + ro + ck * 8), (LAS unsigned*)(lds + ATT_K_OFF + n * 1024), 16, 0, 0);
        __builtin_amdgcn_global_load_lds((const unsigned*)(Vb + ro + cv * 8), (LAS unsigned*)(lds + ATT_V_OFF + n * 1024), 16, 0, 0);
    }
}
#define AT_SB() __builtin_amdgcn_sched_barrier(0)
#define AT_LOADK(HF, KF) do { _Pragma("unroll") for (int i_ = 0; i_ < 4; ++i_) { KF[2 * i_] = *(const LAS bf16x8*)(kb + koff[4 * (HF) + i_]); KF[2 * i_ + 1] = *(const LAS bf16x8*)(kb + koff[4 * (HF) + i_] + 8192); } } while (0)
#define AT_MMAK(HF, KF) do { _Pragma("unroll") for (int i_ = 0; i_ < 4; ++i_) { s0 = __builtin_amdgcn_mfma_f32_32x32x16_bf16(KF[2 * i_], qf[4 * (HF) + i_], s0, 0, 0, 0); s1 = __builtin_amdgcn_mfma_f32_32x32x16_bf16(KF[2 * i_ + 1], qf[4 * (HF) + i_], s1, 0, 0, 0); } } while (0)
#define AT_LOADV(PR, VF) do { _Pragma("unroll") for (int k_ = 0; k_ < 2; ++k_) _Pragma("unroll") for (int db_ = 0; db_ < 4; ++db_) { \
    const s16x4 lo_ = __builtin_bit_cast(s16x4, __builtin_amdgcn_ds_read_tr16_b64_v4i16((LAS s16x4*)(vb + voff[db_] + (2 * (PR) + k_) * 4096))); \
    const s16x4 hi_ = __builtin_bit_cast(s16x4, __builtin_amdgcn_ds_read_tr16_b64_v4i16((LAS s16x4*)(vb + voff[db_] + (2 * (PR) + k_) * 4096 + 2048))); \
    VF[4 * k_ + db_] = (bf16x8){lo_[0], lo_[1], lo_[2], lo_[3], hi_[0], hi_[1], hi_[2], hi_[3]}; } } while (0)
#define AT_MMAV(PR, VF) do { const f32x16& P_ = ((PR) == 0) ? s0 : s1; _Pragma("unroll") for (int k_ = 0; k_ < 2; ++k_) { \
    v4u pw_; pw_.x = cvtpk(P_[8 * k_ + 0], P_[8 * k_ + 1]); pw_.y = cvtpk(P_[8 * k_ + 2], P_[8 * k_ + 3]); pw_.z = cvtpk(P_[8 * k_ + 4], P_[8 * k_ + 5]); pw_.w = cvtpk(P_[8 * k_ + 6], P_[8 * k_ + 7]); \
    const bf16x8 pf_ = __builtin_bit_cast(bf16x8, pw_); \
    _Pragma("unroll") for (int db_ = 0; db_ < 4; ++db_) o[db_] = __builtin_amdgcn_mfma_f32_32x32x16_bf16(VF[4 * k_ + db_], pf_, o[db_], 0, 0, 0); } } while (0)
struct NoHook { __device__ __forceinline__ void operator()(bf16x8 (&)[8]) {} };
template <bool CAUSAL, class Hook>
__device__ __forceinline__ void attn_tile(LAS unsigned char* lds, bf16x8 (&qf)[8], int nsteps, int ql, int lane, float& m, float& l, f32x16 (&o)[4], Hook& hook) {
    const int r = lane & 31, hi = lane >> 5, i16 = lane & 15, g = lane >> 4, kq = i16 >> 2;
    int koff[8], voff[4];
#pragma unroll
    for (int ds = 0; ds < 8; ++ds) koff[ds] = ATT_K_OFF + r * 256 + (((2 * ds + hi) ^ (r & 15)) << 4);
#pragma unroll
    for (int db = 0; db < 4; ++db) voff[db] = ATT_V_OFF + (4 * hi + kq) * 256 + ((db ^ kq) << 6) + ((g & 1) << 5) + (((i16 & 3) >> 1) << 4) + ((i16 & 1) << 3);
    m = -INFINITY; l = 0.f;
#pragma unroll
    for (int db = 0; db < 4; ++db)
#pragma unroll
        for (int e = 0; e < 16; ++e) o[db][e] = 0.f;
#pragma unroll 1
    for (int st = 0; st < nsteps; ++st) {
        f32x16 s0, s1;
#pragma unroll
        for (int e = 0; e < 16; ++e) { s0[e] = 0.f; s1[e] = 0.f; }
        LAS unsigned char* kb = lds + st * 16384; LAS unsigned char* vb = kb;
        bf16x8 fr[8];
        AT_LOADK(0, fr); AT_SB(); AT_MMAK(0, fr); AT_SB();
        AT_LOADK(1, fr); AT_SB(); AT_MMAK(1, fr); AT_SB();
        if (st == nsteps - 1) { hook(qf); AT_SB(); }
        float mx = -INFINITY;
#pragma unroll
        for (int e = 0; e < 16; ++e) {
            if (CAUSAL) { const int key = 64 * st + crow(e, hi); if (key > ql) s0[e] = -INFINITY; if (key + 32 > ql) s1[e] = -INFINITY; }
            mx = fmaxf(mx, fmaxf(s0[e], s1[e]));
        }
        mx = fmaxf(mx, __shfl_xor(mx, 32));
        if (__any(mx > m + (8.0f / ATT_C))) {
            const float mn = fmaxf(m, mx), alpha = __builtin_amdgcn_exp2f((m - mn) * ATT_C);
            m = mn; l *= alpha;
#pragma unroll
            for (int db = 0; db < 4; ++db)
#pragma unroll
                for (int e = 0; e < 16; ++e) o[db][e] *= alpha;
        }
        const float nb = -m * ATT_C;
        float ls = 0.f;
#pragma unroll
        for (int e = 0; e < 16; ++e) { s0[e] = __builtin_amdgcn_exp2f(__builtin_fmaf(s0[e], ATT_C, nb)); s1[e] = __builtin_amdgcn_exp2f(__builtin_fmaf(s1[e], ATT_C, nb)); ls += s0[e] + s1[e]; }
        l += ls;
        AT_SB();
        AT_LOADV(0, fr); AT_SB(); AT_MMAV(0, fr); AT_SB();
        AT_LOADV(1, fr); AT_SB(); AT_MMAV(1, fr); AT_SB();
    }
    m *= ATT_C;
}
__device__ __forceinline__ void half_swap(unsigned& x, unsigned& y) { const auto r_ = __builtin_amdgcn_permlane32_swap(x, y, false, false); x = r_[0]; y = r_[1]; }
constexpr int P4_LCAP = 4096;
#define P4_FETCH(S_, T_, SL_, VALID_, QF_) do { int e_ = (S_) * 32 + r; VALID_ = e_ < n; if (!VALID_) e_ = n - 1; \
    const unsigned ent_ = e_ < P4_LCAP ? llist[e_] : list[lb + e_]; T_ = (int)(ent_ & 16383u); SL_ = (int)(ent_ >> 14); \
    _Pragma("unroll") for (int ds_ = 0; ds_ < 8; ++ds_) QF_[ds_] = *(const bf16x8*)(Qb + (size_t)T_ * DA + h * HD + 16 * ds_ + 8 * hi); } while (0)
struct P4Pref {
    LAS unsigned* lctl; LAS unsigned* llist; const unsigned* list; const bf16* Qb; int lb, n, nsub, h, r, hi, lane;
    int s_n, t_n, sl_n; bool v_n;
    __device__ __forceinline__ void operator()(bf16x8 (&qf)[8]) {
        unsigned sv = 0u; if (lane == 0) sv = __hip_atomic_fetch_add(lctl + 1, 1u, __ATOMIC_RELAXED, __HIP_MEMORY_SCOPE_WORKGROUP);
        s_n = (int)__builtin_amdgcn_readfirstlane(sv);
        if (s_n < nsub) { P4_FETCH(s_n, t_n, sl_n, v_n, qf); }
    }
};
__device__ __forceinline__ void p4_routed(LAS unsigned char* lds, unsigned char* ws, gu32* ctl, int G, int tid, int wave, int lane, int qsel, int nost = 0) {
    LAS unsigned* lctl = (LAS unsigned*)(lds + ATT_PRE_OFF); LAS unsigned* llist = (LAS unsigned*)(lds + ATT_PRE_OFF + 64);
    const bf16* Qb = (const bf16*)(ws + WS_Q); const bf16* Kb = (const bf16*)(ws + WS_K); const bf16* Vb = (const bf16*)(ws + WS_V);
    const unsigned* list = (const unsigned*)(ws + WS_LIST); float* lse = (float*)(ws + WS_LSE);
    const int r = lane & 31, hi = lane >> 5;
    LAS unsigned* lcnt = llist + P4_LCAP;
    lcnt[tid] = __hip_atomic_load((unsigned*)ctl + CW_CNT + tid, __ATOMIC_RELAXED, __HIP_MEMORY_SCOPE_AGENT); lcnt[tid + 512] = __hip_atomic_load((unsigned*)ctl + CW_CNT + tid + 512, __ATOMIC_RELAXED, __HIP_MEMORY_SCOPE_AGENT);
    for (;;) {
        __syncthreads();
        if (tid == 0) { lctl[0] = __hip_atomic_fetch_add((unsigned*)ctl + CW_QHEAD + 64 * qsel, 1u, __ATOMIC_RELAXED, __HIP_MEMORY_SCOPE_AGENT); lctl[1] = 0u; }
        __syncthreads();
        const int i = (int)lctl[0];
        if (i >= NH * (NBLK - 1)) break;
        const int j = i >> 4, h = i & 15;
        const int n = (int)lcnt[h * NBLK + j];
        if (n == 0) continue;
        stage_kv(lds, Kb, Vb, h, j, wave, lane);
        const int lb = list_base(h, j);
        {
            const int nl = n < P4_LCAP ? n : P4_LCAP; unsigned tmp[P4_LCAP / (NWAVES * 64)];
#pragma unroll
            for (int k = 0; k < P4_LCAP / (NWAVES * 64); ++k) { const int e = tid + k * NWAVES * 64; tmp[k] = e < nl ? list[lb + e] : 0u; }
#pragma unroll
            for (int k = 0; k < P4_LCAP / (NWAVES * 64); ++k) { const int e = tid + k * NWAVES * 64; if (e < nl) llist[e] = tmp[k]; }
        }
        asm volatile("s_waitcnt vmcnt(0) lgkmcnt(0)" ::: "memory");
        __syncthreads();
        const int nsub = (n + 31) >> 5;
        int s_cur; { unsigned sv = 0u; if (lane == 0) sv = __hip_atomic_fetch_add(lctl + 1, 1u, __ATOMIC_RELAXED, __HIP_MEMORY_SCOPE_WORKGROUP); s_cur = (int)__builtin_amdgcn_readfirstlane(sv); }
        int t_c = 0, sl_c = 0; bool v_c = false; bf16x8 qc[8];
#pragma unroll
        for (int ds = 0; ds < 8; ++ds) qc[ds] = (bf16x8){0, 0, 0, 0, 0, 0, 0, 0};
        if (s_cur < nsub) P4_FETCH(s_cur, t_c, sl_c, v_c, qc);
        while (s_cur < nsub) {
            P4Pref pf{lctl, llist, list, Qb, lb, n, nsub, h, r, hi, lane, nsub, 0, 0, false};
            float m, l; f32x16 o[4];
            attn_tile<false>(lds, qc, 4, 0, lane, m, l, o, pf);
            const float lt = l + __shfl_xor(l, 32), il = 1.0f / lt;
            v4u ow[4][2];
#pragma unroll
            for (int db = 0; db < 4; ++db)
#pragma unroll
                for (int p = 0; p < 2; ++p) {
                    unsigned x0 = cvtpk(o[db][8 * p] * il, o[db][8 * p + 1] * il), x1 = cvtpk(o[db][8 * p + 2] * il, o[db][8 * p + 3] * il);
                    unsigned y0 = cvtpk(o[db][8 * p + 4] * il, o[db][8 * p + 5] * il), y1 = cvtpk(o[db][8 * p + 6] * il, o[db][8 * p + 7] * il);
                    half_swap(x0, y0); half_swap(x1, y1);
                    ow[db][p] = (v4u){x0, x1, y0, y1}; }
            if (v_c) {
                bf16* So = (bf16*)(ws + (sl_c == 0 ? WS_S0 : (sl_c == 1 ? WS_S1 : WS_S2))) + (size_t)t_c * DA + h * HD + 8 * hi;
#pragma unroll
                for (int db = 0; db < 4; ++db)
#pragma unroll
                    for (int p = 0; p < 2; ++p) *(v4u*)(So + 32 * db + 16 * p) = ow[db][p];
                if (hi == 0) lse[((size_t)sl_c * NH + h) * M + t_c] = (m + __builtin_amdgcn_logf(lt)) * LN2F;
            }
            s_cur = pf.s_n; t_c = pf.t_n; sl_c = pf.sl_n; v_c = pf.v_n;
        }
    }
}
#undef P4_FETCH
__device__ __forceinline__ void p5_own(LAS unsigned char* lds, unsigned char* ws, int G, int wave, int lane, int nost) {
    bf16* Qb = (bf16*)(ws + WS_Q); const bf16* Kb = (const bf16*)(ws + WS_K); const bf16* Vb = (const bf16*)(ws + WS_V);
    const float* lse = (const float*)(ws + WS_LSE);
    const int r = lane & 31, hi = lane >> 5;
    for (int it = blockIdx.x; it < NH * NBLK; it += G) {
        const int h = it & 15, j = it >> 4;
        __syncthreads();
        stage_kv(lds, Kb, Vb, h, j, wave, lane);
        const int t = j * BLK + wave * 32 + r;
        bf16x8 qf[8];
#pragma unroll
        for (int ds = 0; ds < 8; ++ds) qf[ds] = *(const bf16x8*)(Qb + (size_t)t * DA + h * HD + 16 * ds + 8 * hi);
        asm volatile("s_waitcnt vmcnt(0)" ::: "memory");
        __syncthreads();
        float m, l; f32x16 o[4];
        NoHook nh; attn_tile<true>(lds, qf, (wave >> 1) + 1, wave * 32 + r, lane, m, l, o, nh);
        const float lt = l + __shfl_xor(l, 32);
        const int nvalid = j < 3 ? j : 3;
        const float lown = (m + __builtin_amdgcn_logf(lt)) * LN2F;
        float ls[3]; float mx = lown;
#pragma unroll
        for (int s = 0; s < 3; ++s) { ls[s] = (s < nvalid) ? lse[((size_t)s * NH + h) * M + t] : -INFINITY; mx = fmaxf(mx, ls[s]); }
        const float wown = __expf(lown - mx); float wsum = wown; float wv[3];
#pragma unroll
        for (int s = 0; s < 3; ++s) { wv[s] = (s < nvalid) ? __expf(ls[s] - mx) : 0.f; wsum += wv[s]; }
        const float iw = 1.0f / wsum, wo = wown / lt * iw;
        const size_t ro = (size_t)t * DA + h * HD + 8 * hi;
        pg8::u32x2 pq[3][4][4];
        {
            v4u lq[3][4][2];
#pragma unroll
            for (int s = 0; s < 3; ++s)
#pragma unroll
                for (int db = 0; db < 4; ++db)
#pragma unroll
                    for (int p = 0; p < 2; ++p) lq[s][db][p] = (s < nvalid) ? *(const v4u*)((const bf16*)(ws + (s == 0 ? WS_S0 : (s == 1 ? WS_S1 : WS_S2))) + ro + 32 * db + 16 * p) : (v4u){0u, 0u, 0u, 0u};
#pragma unroll
            for (int s = 0; s < 3; ++s)
#pragma unroll
                for (int db = 0; db < 4; ++db)
#pragma unroll
                    for (int p = 0; p < 2; ++p) { unsigned x0 = lq[s][db][p].x, x1 = lq[s][db][p].y, y0 = lq[s][db][p].z, y1 = lq[s][db][p].w; half_swap(x0, y0); half_swap(x1, y1);
                        pq[s][db][2 * p] = (pg8::u32x2){x0, x1}; pq[s][db][2 * p + 1] = (pg8::u32x2){y0, y1}; }
        }
        const float w0 = wv[0] * iw, w1 = wv[1] * iw, w2s = wv[2] * iw;
#pragma unroll
        for (int db = 0; db < 4; ++db)
#pragma unroll
            for (int p = 0; p < 2; ++p) {
                pg8::u32x2 wn[2];
#pragma unroll
                for (int q = 0; q < 2; ++q) { const int g4 = 2 * p + q;
                    float a0 = o[db][4 * g4] * wo, a1 = o[db][4 * g4 + 1] * wo, a2 = o[db][4 * g4 + 2] * wo, a3 = o[db][4 * g4 + 3] * wo;
                    { const pg8::u32x2 pw = pq[0][db][g4]; a0 += w0 * bflo(pw.x); a1 += w0 * bfhi(pw.x); a2 += w0 * bflo(pw.y); a3 += w0 * bfhi(pw.y); }
                    { const pg8::u32x2 pw = pq[1][db][g4]; a0 += w1 * bflo(pw.x); a1 += w1 * bfhi(pw.x); a2 += w1 * bflo(pw.y); a3 += w1 * bfhi(pw.y); }
                    { const pg8::u32x2 pw = pq[2][db][g4]; a0 += w2s * bflo(pw.x); a1 += w2s * bfhi(pw.x); a2 += w2s * bflo(pw.y); a3 += w2s * bfhi(pw.y); }
                    wn[q].x = cvtpk(a0, a1); wn[q].y = cvtpk(a2, a3); }
                unsigned x0 = wn[0].x, x1 = wn[0].y, y0 = wn[1].x, y1 = wn[1].y; half_swap(x0, y0); half_swap(x1, y1);
                *(v4u*)(Qb + ro + 32 * db + 16 * p) = (v4u){x0, x1, y0, y1};
            }
    }
}

__global__ void __launch_bounds__(NWAVES * 64, 2) block_fwd(Args args) {
    extern __shared__ __attribute__((aligned(16))) unsigned char lds_raw[];
    LAS unsigned char* lds = (LAS unsigned char*)lds_raw;
    volatile LAS unsigned* MISC = (volatile LAS unsigned*)(lds + MISC_OFF);
    const int tid = threadIdx.x, lane = tid & 63, wave = __builtin_amdgcn_readfirstlane(tid >> 6), G = gridDim.x;
    unsigned char* ws = args.ws; gu32* ctl = (gu32*)(ws + WS_CTL);
    for (int u = tid; u < (LDS_BYTES - MISC_OFF) / 4; u += NWAVES * 64) ((LAS unsigned*)(lds + MISC_OFF))[u] = 0u;
    __syncthreads();
    XcdBarrier bar; bar.bar = (unsigned*)ctl + CW_BAR + args.bar_off; bar.x = 0; bar.st = nullptr;
    if (args.use_bar) bar = xcd_barrier_post((unsigned*)ctl + CW_BAR + args.bar_off, MISC + 8);
    const int lo = args.ph_lo, hi = args.ph_hi;
#define IN(k) (lo <= (k) && (k) < hi)
#define SEAM(k) do { if (IN(k) && IN((k) + 1)) xcd_barrier(bar); } while (0)
    bf16* const XN = (bf16*)(ws + WS_XN);
    float* const out = args.out;

    if (IN(0)) { p0_prologue(lds, args, G, wave, lane); p0_rope_table(ws, (const int*)args.in[2], G, wave, lane); } SEAM(0);
    if (IN(1)) {
        pg8::Gemm g{XN, (const bf16*)(ws + WS_WIN), M, DIN, D}; pg8::StaticOrder S; S.init(M, DIN, G, (int)blockIdx.x, GEMM_WGM);
        pg8::EpiZ E{(bf16*)(ws + WS_Z), M, args.flags & 1};
        pg8::gemm_phase<pg8::EpiZ, pg8::StaticOrder, true, true>(lds + RING_OFF, g, S, E);
    } SEAM(1);
    if (IN(2)) { p2_qk(lds, ws, (const float*)args.in[5], (const float*)args.in[6], G, tid, args.flags & 2); p2_conv(ws, (const float*)args.in[7], G, wave, lane, args.flags & 2); } SEAM(2);
    if (IN(3)) { p3_gate(lds, ws, ctl, G, tid, wave, lane, args.flags & 2); } SEAM(3);
    if (IN(4)) { p4_routed(lds, ws, ctl, G, tid, wave, lane, (args.flags >> 2) & 1, args.flags & 8); } SEAM(4);
    if (IN(5)) { p5_own(lds, ws, G, wave, lane, args.flags & 2); } SEAM(5);
    if (IN(6)) {
        pg8::Gemm g{(const bf16*)(ws + WS_Q), (const bf16*)(ws + WS_WA), M, D, DA, (size_t)(WS_CB - WS_Q), (size_t)(WS_WC - WS_WA)}; pg8::DualOrder S; S.so.init(M, D, G, (int)blockIdx.x);
        pg8::EpiDual E{(const bf16*)(ws + WS_GA), (const bf16*)(ws + WS_GC), (bf16*)(ws + WS_MERGED), D};
        pg8::gemm_phase<pg8::EpiDual, pg8::DualOrder, true, true>(lds + RING_OFF, g, S, E);
    } SEAM(6);
    if (IN(8)) {
        bf16* const X1B = (bf16*)(ws + WS_X1B);
        pg8::Gemm g{(const bf16*)(ws + WS_MERGED), (const bf16*)(ws + WS_WO), M, D, D}; pg8::StaticOrder S; S.init(M, D, G, (int)blockIdx.x);
        pg8::EpiX1 E{(const float*)args.in[0], X1B, (float*)((unsigned*)ctl + CW_RSS), D};
        pg8::gemm_phase<pg8::EpiX1, pg8::StaticOrder, true, true>(lds + RING_OFF, g, S, E);
        const int gw = blockIdx.x * NWAVES + wave, NGW = G * NWAVES;
        v4u* padf = (v4u*)(X1B - 2 * D); v4u* padb = (v4u*)(X1B + (size_t)M * D);
        for (int i = gw * 64 + lane; i < 2 * D / 8; i += NGW * 64) padf[i] = (v4u){0u, 0u, 0u, 0u};
        for (int i = gw * 64 + lane; i < 128 * D / 8; i += NGW * 64) padb[i] = (v4u){0u, 0u, 0u, 0u};
    }
    if (IN(8)) {
        pg8::Gemm g{(const bf16*)(ws + WS_PB), (const bf16*)(ws + WS_WP), M, D, DPLE}; pg8::StaticOrder S; S.init(M, D, G, (int)blockIdx.x);
        pg8::EpiBf E{(bf16*)(ws + WS_PP), D};
        pg8::gemm_phase<pg8::EpiBf, pg8::StaticOrder, true, true>(lds + RING_OFF, g, S, E);
    } SEAM(8);
    if (IN(11)) {
        pg8::Gemm g{(const bf16*)(ws + WS_X1B) - 2 * D, (const bf16*)(ws + WS_WUP), 65 * 256, 2 * DFF, D, 0, 0, (size_t)254 * D * 2}; pg8::StaticOrder S; S.init(65 * 256, 2 * DFF, G, (int)blockIdx.x, GEMM_WGM);
        pg8::EpiFfn E{(bf16*)(ws + WS_ACT), (const float*)args.in[13], (LAS float*)(lds + RING_BYTES), M, DFF, (const float*)((const unsigned*)ctl + CW_RSS), 1.0f / D, RMS_EPS};
        pg8::gemm_phase<pg8::EpiFfn, pg8::StaticOrder, true, true>(lds + RING_OFF, g, S, E);
    } SEAM(11);
    if (IN(15)) {
        pg8::Gemm g{(const bf16*)(ws + WS_ACT), (const bf16*)(ws + WS_WDN), M, D, DFF}; pg8::StaticOrder S; S.init(M, D, G, (int)blockIdx.x, 4);
        pg8::EpiX2 E{(const bf16*)(ws + WS_X1B), XN, D};
        pg8::gemm_phase<pg8::EpiX2, pg8::StaticOrder, true, true>(lds + RING_OFF, g, S, E);
    } SEAM(15);
    if (IN(16)) {
        pg8::Gemm g{XN, (const bf16*)(ws + WS_WPG), M, D, D}; pg8::StaticOrder S; S.init(M, D, G, (int)blockIdx.x);
        pg8::EpiOut E{XN, (const bf16*)(ws + WS_PP), out, D};
        pg8::gemm_phase<pg8::EpiOut, pg8::StaticOrder, true, true>(lds + RING_OFF, g, S, E);
    }
#undef IN
#undef SEAM
}

extern "C" void kernel_launch(void* const* d_in, const int* in_sizes, int n_in, void* d_out, int out_size, void* d_ws, size_t ws_size, hipStream_t stream) {
    static int grid = 0;
    if (grid == 0) {
        if (n_in != 17 || in_sizes[0] != M * D || out_size != M * D || ws_size < WS_END) { fprintf(stderr, "kernel_launch: unexpected shapes / workspace (n_in %d, ws %zu, need %zu); nothing launched\n", n_in, ws_size, (size_t)WS_END); grid = -1; return; }
        int dev = 0, cus = 0, per_cu = 0;
        if (hipGetDevice(&dev) != hipSuccess || hipDeviceGetAttribute(&cus, hipDeviceAttributeMultiprocessorCount, dev) != hipSuccess) { grid = -1; return; }
        if (hipFuncSetAttribute((const void*)block_fwd, hipFuncAttributeMaxDynamicSharedMemorySize, LDS_BYTES) != hipSuccess) { fprintf(stderr, "kernel_launch: hipFuncSetAttribute failed\n"); grid = -1; return; }
        if (hipOccupancyMaxActiveBlocksPerMultiprocessor(&per_cu, (const void*)block_fwd, NWAVES * 64, LDS_BYTES) != hipSuccess || per_cu < 1) fprintf(stderr, "kernel_launch: occupancy query reports %d\n", per_cu);
        (void)hipGetLastError();
        grid = cus;
    }
    if (grid < 0) return;
    if (hipMemsetAsync((char*)d_ws + WS_CTL, 0, CTL_ZERO_BYTES, stream) != hipSuccess) return;
    Args a{};
    for (int i = 0; i < 17; ++i) a.in[i] = d_in[i];
    a.out = (float*)d_out; a.ws = (unsigned char*)d_ws; a.bar_off = 0;
#if MK_PER_PHASE
    for (int ph = 0; ph < NPH; ++ph) { a.ph_lo = ph; a.ph_hi = ph + 1; a.use_bar = 0; hipLaunchKernelGGL(block_fwd, dim3(grid), dim3(NWAVES * 64), LDS_BYTES, stream, a); }
#elif PROBE_PHASE >= 0
    a.ph_lo = 0; a.ph_hi = PROBE_PHASE + 1; a.use_bar = 1; a.bar_off = 0;
    hipLaunchKernelGGL(block_fwd, dim3(grid), dim3(NWAVES * 64), LDS_BYTES, stream, a);
    a.ph_lo = PROBE_PHASE; a.ph_hi = PROBE_PHASE + 1; a.use_bar = 0; a.flags = PROBE_FLAGS;
    hipLaunchKernelGGL(block_fwd, dim3(grid), dim3(NWAVES * 64), LDS_BYTES, stream, a);
    a.flags = 0;
    if (PROBE_PHASE + 1 < NPH) { a.ph_lo = PROBE_PHASE + 1; a.ph_hi = NPH; a.use_bar = 1; a.bar_off = XCD_BAR_WORDS;
        hipLaunchKernelGGL(block_fwd, dim3(grid), dim3(NWAVES * 64), LDS_BYTES, stream, a); }
#else
    a.ph_lo = 0; a.ph_hi = NPH; a.use_bar = 1;
    hipLaunchKernelGGL(block_fwd, dim3(grid), dim3(NWAVES * 64), LDS_BYTES, stream, a);
#endif
}
```

```cpp
#include <hip/hip_runtime.h>
#include <cstdio>
#include <cstdint>
#include <cmath>
namespace pg8 {
#define PG8_LAS __attribute__((address_space(3)))
typedef unsigned short bf16_t;
typedef short bf16x8 __attribute__((ext_vector_type(8)));
typedef float f32x4 __attribute__((ext_vector_type(4)));
typedef unsigned u32x4 __attribute__((ext_vector_type(4)));
constexpr int BM = 256, BK = 64, HALF = 128, HTB = HALF * BK * 2  , STAGE_BYTES = 8 * HTB, NXCD = 8, WGM = 8;

__host__ __device__ __forceinline__ int lds_byte(int r, int c) { const int st = (r >> 4) * 2 + (c >> 5), rr = r & 15, cc = c & 31, ob = rr * 64 + cc * 2; return st * 1024 + (ob ^ (((ob >> 9) & 1) << 5)); }
__host__ __device__ __forceinline__ void stage_rc(int b, int& R, int& C) { const int st = b / 1024, sb = b % 1024, swz = sb ^ (((sb >> 9) & 1) << 5); R = (st >> 1) * 16 + swz / 64; C = (st & 1) * 32 + (swz % 64) / 2; }
__host__ __device__ __forceinline__ int perm32(int rho) { const int n = rho >> 4, i = rho & 15; return 8 * (i >> 2) + 4 * n + (i & 3); }

struct Unit { int pm, pn, aux; };
struct Gemm { const bf16_t* A; const bf16_t* Bt; int M, N, K; size_t a_jump = 0, b_jump = 0, a_tstep = 0; };

struct StaticOrder {
    int nM, nN, nwg, G, c, wgm;
    __host__ __device__ void init(int M, int N, int G_, int c_, int wgm_ = WGM) { nM = M / BM; nN = N / BM; nwg = nM * nN; G = G_; c = c_; wgm = wgm_; }
    __host__ __device__ bool next(int i, Unit& u) const {
        const long L = (long)i * G + c; if (L >= nwg) return false;
        int wgid = (int)L; { const int q = nwg / NXCD, r = nwg % NXCD, xcd = wgid % NXCD, off = wgid / NXCD; wgid = (xcd < r ? xcd * (q + 1) : r * (q + 1) + (xcd - r) * q) + off; }
        const int nig = wgm * nN, gid = wgid / nig, fm = gid * wgm, gsz = (nM - fm) < wgm ? (nM - fm) : wgm;
        u.pm = fm + ((wgid % nig) % gsz); u.pn = (wgid % nig) / gsz; u.aux = 0; return true;
    }
    __device__ __forceinline__ void a_ready(const Unit&) const {}
    __device__ __forceinline__ void done(const Unit&) const {}
};

struct DualOrder {
    StaticOrder so;
    __host__ __device__ bool next(int i, Unit& u) const { if (!so.next(i >> 1, u)) return false; u.aux = i & 1; return true; }
    __device__ __forceinline__ void a_ready(const Unit&) const {}
    __device__ __forceinline__ void done(const Unit&) const {}
};

__device__ __forceinline__ unsigned cvt_pk_bf16(float lo, float hi) { unsigned r; asm volatile("s_nop 0\n\tv_cvt_pk_bf16_f32 %0, %1, %2" : "=v"(r) : "v"(lo), "v"(hi)); return r; }
typedef unsigned u32x2 __attribute__((ext_vector_type(2)));
__device__ __forceinline__ float bf_lo(unsigned w) { return __uint_as_float(w << 16); }
__device__ __forceinline__ float bf_hi(unsigned w) { return __uint_as_float(w & 0xffff0000u); }
__device__ __forceinline__ float sigm(float v) { return __builtin_amdgcn_rcpf(1.0f + __expf(-v)); }
__device__ __forceinline__ u32x4 pack8(const f32x4& v0, const f32x4& v1) { u32x4 w; w.x = cvt_pk_bf16(v0[0], v0[1]); w.y = cvt_pk_bf16(v0[2], v0[3]); w.z = cvt_pk_bf16(v1[0], v1[1]); w.w = cvt_pk_bf16(v1[2], v1[3]); return w; }

struct EpiZ {
    static constexpr bool PERM = true, AFTER_DRAIN = false, KEEP = false, APERM = false;
    bf16_t* Z; int M; int nostore;
    __device__ __forceinline__ void operator()(const f32x4 (&acc)[2][2][4][2], const Unit& u, int wr, int wc, int fr, int fq) const {
        const int row0 = u.pm * BM + wr * 64 + fr;
        if (u.pn < 48) {
            bf16_t* base = Z + (size_t)(u.pn >> 3) * ((size_t)M * 2048); const int col0 = (u.pn & 7) * 256 + wc * 32 + 8 * fq;
#pragma unroll
            for (int ai = 0; ai < 2; ++ai)
#pragma unroll
                for (int m = 0; m < 4; ++m) { bf16_t* rowp = base + (size_t)(row0 + ai * HALF + m * 16) * 2048 + col0;
#pragma unroll
                    for (int bj = 0; bj < 2; ++bj) *(u32x4*)(rowp + bj * HALF) = pack8(acc[ai][bj][m][0], acc[ai][bj][m][1]); }
        } else {
            bf16_t* GAb = Z + (size_t)6 * M * 2048; bf16_t* GCb = GAb + (size_t)M * 4096; const int col0 = (u.pn - 48) * 128 + wc * 32 + 8 * fq;
#pragma unroll
            for (int ai = 0; ai < 2; ++ai)
#pragma unroll
                for (int m = 0; m < 4; ++m) { const size_t o = (size_t)(row0 + ai * HALF + m * 16) * 4096 + col0;
                    f32x4 r0, r1, c0, c1;
#pragma unroll
                    for (int e = 0; e < 4; ++e) { c0[e] = fmaxf(sigm(acc[ai][1][m][0][e]), 1e-20f); c1[e] = fmaxf(sigm(acc[ai][1][m][1][e]), 1e-20f);
                        r0[e] = sigm(acc[ai][0][m][0][e]) * __builtin_amdgcn_rcpf(c0[e]); r1[e] = sigm(acc[ai][0][m][1][e]) * __builtin_amdgcn_rcpf(c1[e]); }
                    *(u32x4*)(GAb + o) = pack8(r0, r1); *(u32x4*)(GCb + o) = pack8(c0, c1); }
        }
    }
};
struct EpiBf {
    static constexpr bool PERM = true, AFTER_DRAIN = false, KEEP = false, APERM = false;
    bf16_t* O; int ldc;
    __device__ __forceinline__ void operator()(const f32x4 (&acc)[2][2][4][2], const Unit& u, int wr, int wc, int fr, int fq) const {
        const int row0 = u.pm * BM + wr * 64 + fr, col0 = u.pn * BM + wc * 32 + 8 * fq;
#pragma unroll
        for (int ai = 0; ai < 2; ++ai)
#pragma unroll
            for (int m = 0; m < 4; ++m) { bf16_t* rowp = O + (size_t)(row0 + ai * HALF + m * 16) * ldc + col0;
#pragma unroll
                for (int bj = 0; bj < 2; ++bj) *(u32x4*)(rowp + bj * HALF) = pack8(acc[ai][bj][m][0], acc[ai][bj][m][1]); }
    }
};
struct EpiDual {
    static constexpr bool PERM = true, AFTER_DRAIN = false, KEEP = true, APERM = false;
    const bf16_t* GA; const bf16_t* GC; bf16_t* O; int ldc;
    __device__ __forceinline__ void operator()(f32x4 (&acc)[2][2][4][2], const Unit& u, int wr, int wc, int fr, int fq) const {
        const int row0 = u.pm * BM + wr * 64 + fr, col0 = u.pn * BM + wc * 32 + 8 * fq;
        const bf16_t* src = u.aux == 0 ? GA : GC;
        u32x4 cq[2][4][2];
#pragma unroll
        for (int ai = 0; ai < 2; ++ai)
#pragma unroll
            for (int m = 0; m < 4; ++m)
#pragma unroll
                for (int bj = 0; bj < 2; ++bj) cq[ai][m][bj] = *(const u32x4*)(src + (size_t)(row0 + ai * HALF + m * 16) * ldc + col0 + bj * HALF);
        if (u.aux == 0) {
#pragma unroll
            for (int ai = 0; ai < 2; ++ai)
#pragma unroll
                for (int m = 0; m < 4; ++m)
#pragma unroll
                    for (int bj = 0; bj < 2; ++bj) { const u32x4 c = cq[ai][m][bj];
                        acc[ai][bj][m][0][0] *= bf_lo(c.x); acc[ai][bj][m][0][1] *= bf_hi(c.x); acc[ai][bj][m][0][2] *= bf_lo(c.y); acc[ai][bj][m][0][3] *= bf_hi(c.y);
                        acc[ai][bj][m][1][0] *= bf_lo(c.z); acc[ai][bj][m][1][1] *= bf_hi(c.z); acc[ai][bj][m][1][2] *= bf_lo(c.w); acc[ai][bj][m][1][3] *= bf_hi(c.w); }
        } else {
#pragma unroll
            for (int ai = 0; ai < 2; ++ai)
#pragma unroll
                for (int m = 0; m < 4; ++m)
#pragma unroll
                    for (int bj = 0; bj < 2; ++bj) { const size_t o = (size_t)(row0 + ai * HALF + m * 16) * ldc + col0 + bj * HALF; const u32x4 c = cq[ai][m][bj];
                        f32x4 v0 = acc[ai][bj][m][0], v1 = acc[ai][bj][m][1];
                        v0[0] *= bf_lo(c.x); v0[1] *= bf_hi(c.x); v0[2] *= bf_lo(c.y); v0[3] *= bf_hi(c.y); v1[0] *= bf_lo(c.z); v1[1] *= bf_hi(c.z); v1[2] *= bf_lo(c.w); v1[3] *= bf_hi(c.w);
                        *(u32x4*)(O + o) = pack8(v0, v1); }
        }
    }
};
#define DPP_F(OLD, SRC, CTRL) __builtin_bit_cast(float, __builtin_amdgcn_update_dpp(__builtin_bit_cast(int, (float)(OLD)), __builtin_bit_cast(int, (float)(SRC)), (CTRL), 0xf, 0xf, false))
struct EpiFfn {
    static constexpr bool PERM = true, AFTER_DRAIN = false, KEEP = false, APERM = true;
    bf16_t* ACT; const float* cw; PG8_LAS float* ex; int Mrows, DFFc; const float* rss; float inv_d, eps;
    __device__ __forceinline__ void operator()(f32x4 (&acc)[2][2][4][2], const Unit& u, int wr, int wc, int fr, int fq) const {
        const int wave = wr * 4 + wc;
#pragma unroll
        for (int ai = 0; ai < 2; ++ai)
#pragma unroll
            for (int m = 0; m < 4; ++m) { const int row = u.pm * 254 - 2 + ai * HALF + wr * 64 + 4 * fr + m;
                const int rc = row < 0 ? 0 : (row >= Mrows ? Mrows - 1 : row);
                const float rv = __builtin_amdgcn_rsqf(rss[rc] * inv_d + eps), rs = (row == rc) ? rv : 0.f;
#pragma unroll
                for (int bj = 0; bj < 2; ++bj)
#pragma unroll
                    for (int n = 0; n < 2; ++n) acc[ai][bj][m][n] *= rs; }
        if (fr == 15) {
#pragma unroll
            for (int ai = 0; ai < 2; ++ai)
#pragma unroll
                for (int bj = 0; bj < 2; ++bj)
#pragma unroll
                    for (int n = 0; n < 2; ++n)
#pragma unroll
                        for (int w = 0; w < 2; ++w) *(PG8_LAS f32x4*)(ex + ((((((wave * 2 + ai) * 2 + bj) * 2 + n) * 4 + fq) * 2 + w) << 2)) = acc[ai][bj][2 + w][n];
        }
        asm volatile("s_waitcnt lgkmcnt(0)" ::: "memory"); __builtin_amdgcn_s_barrier(); asm volatile("" ::: "memory");
        const int cg = u.pn * 128 + wc * 32 + 8 * fq;
        f32x4 wga[2][3], wva[2][3];
#pragma unroll
        for (int n = 0; n < 2; ++n)
#pragma unroll
            for (int j = 0; j < 3; ++j) { wga[n][j] = *(const f32x4*)(cw + (size_t)j * 2 * DFFc + cg + 4 * n); wva[n][j] = *(const f32x4*)(cw + (size_t)j * 2 * DFFc + DFFc + cg + 4 * n); }
#pragma unroll
        for (int n = 0; n < 2; ++n) {
            f32x4 wg[3], wv[3];
#pragma unroll
            for (int j = 0; j < 3; ++j) { wg[j] = wga[n][j]; wv[j] = wva[n][j]; }
#pragma unroll
            for (int ai = 0; ai < 2; ++ai) {
                const int sw = wr == 1 ? wave - 4 : wave + 4, sai = wr == 1 ? ai : 0; const bool has = (wr == 1) || (ai == 1);
                const int hb = (((((sw * 2 + sai) * 2 + 0) * 2 + n) * 4 + fq) * 2) << 2, hv = (((((sw * 2 + sai) * 2 + 1) * 2 + n) * 4 + fq) * 2) << 2;
                const f32x4 z4 = (f32x4){0.f, 0.f, 0.f, 0.f};
                const f32x4 g62 = has ? *(const PG8_LAS f32x4*)(ex + hb) : z4, g63 = has ? *(const PG8_LAS f32x4*)(ex + hb + 4) : z4;
                const f32x4 v62 = has ? *(const PG8_LAS f32x4*)(ex + hv) : z4, v63 = has ? *(const PG8_LAS f32x4*)(ex + hv + 4) : z4;
                f32x4 gp3, gp2, vp3, vp2;
#pragma unroll
                for (int e = 0; e < 4; ++e) { gp3[e] = DPP_F(g63[e], acc[ai][0][3][n][e], 0x111); gp2[e] = DPP_F(g62[e], acc[ai][0][2][n][e], 0x111);
                                              vp3[e] = DPP_F(v63[e], acc[ai][1][3][n][e], 0x111); vp2[e] = DPP_F(v62[e], acc[ai][1][2][n][e], 0x111); }
#pragma unroll
                for (int m = 0; m < 4; ++m) {
                    const int rl = ai * HALF + wr * 64 + 4 * fr + m, row = u.pm * 254 - 2 + rl;
                    const f32x4 g0 = acc[ai][0][m][n], v0 = acc[ai][1][m][n];
                    const f32x4 g1 = m == 0 ? gp3 : acc[ai][0][m > 0 ? m - 1 : 0][n], g2 = m == 0 ? gp2 : (m == 1 ? gp3 : acc[ai][0][m > 1 ? m - 2 : 0][n]);
                    const f32x4 v1 = m == 0 ? vp3 : acc[ai][1][m > 0 ? m - 1 : 0][n], v2 = m == 0 ? vp2 : (m == 1 ? vp3 : acc[ai][1][m > 1 ? m - 2 : 0][n]);
                    f32x4 ov;
#pragma unroll
                    for (int e = 0; e < 4; ++e) {
                        const float ug = wg[2][e] * g0[e] + wg[1][e] * g1[e] + wg[0][e] * g2[e], uv = wv[2][e] * v0[e] + wv[1][e] * v1[e] + wv[0][e] * v2[e];
                        ov[e] = ug * __builtin_amdgcn_rcpf(1.0f + __expf(-ug)) * uv;
                    }
                    const int rowc = (rl >= 2 && row < Mrows) ? row : Mrows;
                    { u32x2 w; w.x = cvt_pk_bf16(ov[0], ov[1]); w.y = cvt_pk_bf16(ov[2], ov[3]); *(u32x2*)(ACT + (size_t)rowc * DFFc + cg + 4 * n) = w; }
                }
            }
        }
    }
};
struct EpiX1 {
    static constexpr bool PERM = true, AFTER_DRAIN = false, KEEP = false, APERM = false;
    const float* X; bf16_t* X1B; float* rss; int ldc;
    __device__ __forceinline__ void operator()(f32x4 (&acc)[2][2][4][2], const Unit& u, int wr, int wc, int fr, int fq) const {
        const int row0 = u.pm * BM + wr * 64 + fr, col0 = u.pn * BM + wc * 32 + 8 * fq;
#pragma unroll
        for (int ai = 0; ai < 2; ++ai) {
            f32x4 xq[4][2][2];
#pragma unroll
            for (int m = 0; m < 4; ++m)
#pragma unroll
                for (int bj = 0; bj < 2; ++bj) { const size_t o = (size_t)(row0 + ai * HALF + m * 16) * ldc + col0 + bj * HALF; xq[m][bj][0] = *(const f32x4*)(X + o); xq[m][bj][1] = *(const f32x4*)(X + o + 4); }
#pragma unroll
            for (int m = 0; m < 4; ++m) { const int row = row0 + ai * HALF + m * 16; const size_t ro = (size_t)row * ldc + col0; float ss = 0.f;
#pragma unroll
                for (int bj = 0; bj < 2; ++bj) { const size_t o = ro + bj * HALF;
                    const f32x4 v0 = xq[m][bj][0] + acc[ai][bj][m][0], v1 = xq[m][bj][1] + acc[ai][bj][m][1];
                    ss += (v0[0] * v0[0] + v0[1] * v0[1]) + (v0[2] * v0[2] + v0[3] * v0[3]) + (v1[0] * v1[0] + v1[1] * v1[1]) + (v1[2] * v1[2] + v1[3] * v1[3]);
                    *(u32x4*)(X1B + o) = pack8(v0, v1); }
                ss += __shfl_xor(ss, 16); ss += __shfl_xor(ss, 32);
                if (fq == 0) unsafeAtomicAdd(rss + row, ss); }
        }
    }
};
struct EpiX2 {
    static constexpr bool PERM = true, AFTER_DRAIN = false, KEEP = false, APERM = false;
    const bf16_t* X1B; bf16_t* XN; int ldc;
    __device__ __forceinline__ void operator()(f32x4 (&acc)[2][2][4][2], const Unit& u, int wr, int wc, int fr, int fq) const {
        const int row0 = u.pm * BM + wr * 64 + fr, col0 = u.pn * BM + wc * 32 + 8 * fq;
        u32x4 tq[2][4][2];
#pragma unroll
        for (int ai = 0; ai < 2; ++ai)
#pragma unroll
            for (int m = 0; m < 4; ++m)
#pragma unroll
                for (int bj = 0; bj < 2; ++bj) tq[ai][m][bj] = *(const u32x4*)(X1B + (size_t)(row0 + ai * HALF + m * 16) * ldc + col0 + bj * HALF);
#pragma unroll
        for (int ai = 0; ai < 2; ++ai)
#pragma unroll
            for (int m = 0; m < 4; ++m)
#pragma unroll
                for (int bj = 0; bj < 2; ++bj) { const size_t o = (size_t)(row0 + ai * HALF + m * 16) * ldc + col0 + bj * HALF; const u32x4 t = tq[ai][m][bj];
                    f32x4 v0 = acc[ai][bj][m][0], v1 = acc[ai][bj][m][1];
                    v0[0] += bf_lo(t.x); v0[1] += bf_hi(t.x); v0[2] += bf_lo(t.y); v0[3] += bf_hi(t.y); v1[0] += bf_lo(t.z); v1[1] += bf_hi(t.z); v1[2] += bf_lo(t.w); v1[3] += bf_hi(t.w);
                    *(u32x4*)(XN + o) = pack8(v0, v1); }
    }
};
struct EpiOut {
    static constexpr bool PERM = true, AFTER_DRAIN = false, KEEP = false, APERM = false;
    const bf16_t* XN; const bf16_t* PP; float* out; int ldc;
    __device__ __forceinline__ void operator()(f32x4 (&acc)[2][2][4][2], const Unit& u, int wr, int wc, int fr, int fq) const {
        const int row0 = u.pm * BM + wr * 64 + fr, col0 = u.pn * BM + wc * 32 + 8 * fq;
#pragma unroll
        for (int ai = 0; ai < 2; ++ai) {
            u32x4 tq[4][2], pq[4][2];
#pragma unroll
            for (int m = 0; m < 4; ++m)
#pragma unroll
                for (int bj = 0; bj < 2; ++bj) { const size_t o = (size_t)(row0 + ai * HALF + m * 16) * ldc + col0 + bj * HALF; tq[m][bj] = *(const u32x4*)(XN + o); pq[m][bj] = *(const u32x4*)(PP + o); }
#pragma unroll
            for (int m = 0; m < 4; ++m)
#pragma unroll
                for (int bj = 0; bj < 2; ++bj) { const size_t o = (size_t)(row0 + ai * HALF + m * 16) * ldc + col0 + bj * HALF; const u32x4 t = tq[m][bj], p = pq[m][bj];
                    const f32x4 a0 = acc[ai][bj][m][0], a1 = acc[ai][bj][m][1]; f32x4 v0, v1;
                    v0[0] = bf_lo(t.x) + sigm(a0[0]) * bf_lo(p.x); v0[1] = bf_hi(t.x) + sigm(a0[1]) * bf_hi(p.x); v0[2] = bf_lo(t.y) + sigm(a0[2]) * bf_lo(p.y); v0[3] = bf_hi(t.y) + sigm(a0[3]) * bf_hi(p.y);
                    v1[0] = bf_lo(t.z) + sigm(a1[0]) * bf_lo(p.z); v1[1] = bf_hi(t.z) + sigm(a1[1]) * bf_hi(p.z); v1[2] = bf_lo(t.w) + sigm(a1[2]) * bf_lo(p.w); v1[3] = bf_hi(t.w) + sigm(a1[3]) * bf_hi(p.w);
                    *(f32x4*)(out + o) = v0; *(f32x4*)(out + o + 4) = v1; }
        }
    }
};

template <class Epi, class Sched, bool ALIGN_EPI = false, bool SP2 = false>
__device__ __forceinline__ void gemm_phase(PG8_LAS unsigned char* lds, const Gemm g, const Sched& S, const Epi& E) {
    const int tid = threadIdx.x, wid = __builtin_amdgcn_readfirstlane(tid >> 6), lane = tid & 63, wr = wid >> 2, wc = wid & 3, fr = lane & 15, fq = lane >> 4;
    const int K = g.K, nt = K / BK;
    unsigned voffA[2], voffB[2];
#pragma unroll
    for (int i = 0; i < 2; ++i) { int R, C; stage_rc(tid * 16 + i * 8192, R, C); const int Rb = Epi::PERM ? ((R & ~31) + perm32(R & 31)) : R;
        const int Ra = Epi::APERM ? ((R & ~63) + 4 * (R & 15) + ((R & 63) >> 4)) : R;
        voffA[i] = (unsigned)(Ra * K + C) * 2u; voffB[i] = (unsigned)(Rb * K + C) * 2u; }
    const size_t kstep = (size_t)(BK * 2);
    const size_t hstep = (size_t)HALF * K * 2;
    const size_t tstep = 2 * hstep; const size_t atstep = g.a_tstep ? g.a_tstep : tstep;
    const unsigned ldsw = (unsigned)wid * 1024u;
    const int aoff = lds_byte(wr * 64 + fr, fq * 8), boff = lds_byte(wc * 32 + fr, fq * 8);
#define PG8_SA(b, h) (((b) * 2 + (h)) * HTB)
#define PG8_SB(b, h) ((4 + (b) * 2 + (h)) * HTB)
#define PG8_STAGE(bufoff, gbase, voff) do { _Pragma("unroll") for (int _i = 0; _i < 2; ++_i) \
        __builtin_amdgcn_global_load_lds((const unsigned*)((const char*)(gbase) + (voff)[_i]), (PG8_LAS unsigned*)(lds + (bufoff) + ldsw + _i * 8192), 16, 0, 0); } while (0)
#define PG8_LDA(dst, b, h) do { _Pragma("unroll") for (int m = 0; m < 4; ++m) _Pragma("unroll") for (int k = 0; k < 2; ++k) dst[m][k] = *(const PG8_LAS bf16x8*)(lds + PG8_SA(b, h) + aoff + m * 2048 + k * 1024); } while (0)
#define PG8_LDB(dst, b, h) do { _Pragma("unroll") for (int n = 0; n < 2; ++n) _Pragma("unroll") for (int k = 0; k < 2; ++k) dst[n][k] = *(const PG8_LAS bf16x8*)(lds + PG8_SB(b, h) + boff + n * 2048 + k * 1024); } while (0)
#define PG8_MMA(ai, bj, At, Bt) do { __builtin_amdgcn_s_setprio(1); _Pragma("unroll") for (int m = 0; m < 4; ++m) _Pragma("unroll") for (int n = 0; n < 2; ++n) _Pragma("unroll") for (int k = 0; k < 2; ++k) \
        acc[ai][bj][m][n] = __builtin_amdgcn_mfma_f32_16x16x32_bf16(Bt[n][k], At[m][k], acc[ai][bj][m][n], 0, 0, 0); __builtin_amdgcn_s_setprio(0); } while (0)
#define PG8_WAIT_V(n) asm volatile("s_waitcnt vmcnt(" #n ")" ::: "memory")
#define PG8_WAIT_L(n) asm volatile("s_waitcnt lgkmcnt(" #n ")" ::: "memory")
#define PG8_BAR __builtin_amdgcn_s_barrier()
#define PG8_SCHED __builtin_amdgcn_sched_barrier(0)
    Unit cur, nxt; int ui = 0;
    if (!S.next(0, cur)) return;
    f32x4 acc[2][2][4][2];
#pragma unroll
    for (int a = 0; a < 2; ++a)
#pragma unroll
        for (int b = 0; b < 2; ++b)
#pragma unroll
            for (int m = 0; m < 4; ++m)
#pragma unroll
                for (int n = 0; n < 2; ++n) acc[a][b][m][n] = (f32x4){0.f, 0.f, 0.f, 0.f};
    bf16x8 At[4][2], B0[2][2], B1[2][2];
    const char* cA = (const char*)g.A + (size_t)cur.pm * atstep + (cur.aux ? g.a_jump : 0); const char* cB = (const char*)g.Bt + (size_t)cur.pn * tstep + (cur.aux ? g.b_jump : 0);
    S.a_ready(cur);
    if constexpr (SP2) {
        PG8_STAGE(PG8_SB(0, 0), cB, voffB); PG8_STAGE(PG8_SB(0, 1), cB + hstep, voffB); PG8_STAGE(PG8_SA(0, 0), cA, voffA); PG8_STAGE(PG8_SA(0, 1), cA + hstep, voffA);
        if (wr == 1) PG8_BAR;
        PG8_WAIT_V(2); PG8_BAR;
        PG8_STAGE(PG8_SB(1, 0), cB + kstep, voffB); PG8_STAGE(PG8_SA(1, 0), cA + kstep, voffA); PG8_STAGE(PG8_SB(1, 1), cB + hstep + kstep, voffB);
        PG8_WAIT_V(6); PG8_BAR;
    } else {
        PG8_STAGE(PG8_SB(0, 0), cB, voffB); PG8_STAGE(PG8_SA(0, 0), cA, voffA); PG8_STAGE(PG8_SB(0, 1), cB + hstep, voffB); PG8_STAGE(PG8_SA(0, 1), cA + hstep, voffA);
        if (wr == 1) PG8_BAR;
        PG8_WAIT_V(4); PG8_BAR;
        PG8_STAGE(PG8_SB(1, 0), cB + kstep, voffB); PG8_STAGE(PG8_SA(1, 0), cA + kstep, voffA); PG8_STAGE(PG8_SB(1, 1), cB + hstep + kstep, voffB);
        PG8_WAIT_V(6); PG8_BAR;
    }
    for (;;) {
        const bool has_next = S.next(ui + 1, nxt);
        const char* nA = has_next ? (const char*)g.A + (size_t)nxt.pm * atstep + (nxt.aux ? g.a_jump : 0) : cA; const char* nB = has_next ? (const char*)g.Bt + (size_t)nxt.pn * tstep + (nxt.aux ? g.b_jump : 0) : cB;
        for (int t = 0; t < nt; t += 2) {
            const bool last = (t == nt - 2);
            const char* a1 = cA + (size_t)(t + 1) * kstep;
            const char* a2 = last ? nA : cA + (size_t)(t + 2) * kstep; const char* b2 = last ? nB : cB + (size_t)(t + 2) * kstep;
            const char* a3 = a2 + kstep; const char* b3 = b2 + kstep;
            if (last && has_next) S.a_ready(nxt);
            if constexpr (SP2) {
            PG8_LDB(B0, 0, 0); PG8_LDB(B1, 0, 1); PG8_SCHED; PG8_LDA(At, 0, 0); PG8_STAGE(PG8_SA(1, 1), a1 + hstep, voffA);
            PG8_WAIT_V(8); PG8_WAIT_L(0); PG8_BAR; PG8_MMA(0, 0, At, B0); PG8_MMA(0, 1, At, B1); PG8_BAR; PG8_SCHED;
            PG8_LDA(At, 0, 1); PG8_STAGE(PG8_SB(0, 0), b2, voffB); PG8_STAGE(PG8_SB(0, 1), b2 + hstep, voffB); PG8_STAGE(PG8_SA(0, 0), a2, voffA);
            PG8_WAIT_V(8); PG8_WAIT_L(0); PG8_BAR; PG8_MMA(1, 0, At, B0); PG8_MMA(1, 1, At, B1); PG8_BAR; PG8_SCHED;
            PG8_LDB(B0, 1, 0); PG8_LDB(B1, 1, 1); PG8_SCHED; PG8_LDA(At, 1, 0); PG8_STAGE(PG8_SA(0, 1), a2 + hstep, voffA);
            PG8_WAIT_V(8); PG8_WAIT_L(0); PG8_BAR; PG8_MMA(0, 0, At, B0); PG8_MMA(0, 1, At, B1); PG8_BAR; PG8_SCHED;
            PG8_LDA(At, 1, 1); PG8_STAGE(PG8_SB(1, 0), b3, voffB); PG8_STAGE(PG8_SB(1, 1), b3 + hstep, voffB); PG8_STAGE(PG8_SA(1, 0), a3, voffA);
            PG8_WAIT_V(8); PG8_WAIT_L(0); PG8_BAR; PG8_MMA(1, 0, At, B0); PG8_MMA(1, 1, At, B1); PG8_BAR; PG8_SCHED;
            } else {
            PG8_LDB(B0, 0, 0); PG8_SCHED; PG8_LDA(At, 0, 0); PG8_STAGE(PG8_SA(1, 1), a1 + hstep, voffA);
            PG8_WAIT_L(8); PG8_BAR; PG8_WAIT_L(0); PG8_MMA(0, 0, At, B0); PG8_BAR; PG8_SCHED;
            PG8_LDB(B1, 0, 1); PG8_STAGE(PG8_SB(0, 0), b2, voffB);
            PG8_BAR; PG8_WAIT_L(0); PG8_MMA(0, 1, At, B1); PG8_BAR;
            PG8_LDA(At, 0, 1); PG8_STAGE(PG8_SA(0, 0), a2, voffA);
            PG8_BAR; PG8_WAIT_L(0); PG8_MMA(1, 0, At, B0); PG8_BAR; PG8_SCHED;
            PG8_STAGE(PG8_SB(0, 1), b2 + hstep, voffB);
            PG8_WAIT_V(6); PG8_BAR; PG8_MMA(1, 1, At, B1); PG8_BAR;
            PG8_LDB(B0, 1, 0); PG8_SCHED; PG8_LDA(At, 1, 0); PG8_STAGE(PG8_SA(0, 1), a2 + hstep, voffA);
            PG8_WAIT_L(8); PG8_BAR; PG8_WAIT_L(0); PG8_MMA(0, 0, At, B0); PG8_BAR; PG8_SCHED;
            PG8_LDB(B1, 1, 1); PG8_STAGE(PG8_SB(1, 0), b3, voffB);
            PG8_BAR; PG8_WAIT_L(0); PG8_MMA(0, 1, At, B1); PG8_BAR;
            PG8_LDA(At, 1, 1); PG8_STAGE(PG8_SA(1, 0), a3, voffA);
            PG8_BAR; PG8_WAIT_L(0); PG8_MMA(1, 0, At, B0); PG8_BAR; PG8_SCHED;
            PG8_STAGE(PG8_SB(1, 1), b3 + hstep, voffB);
            PG8_WAIT_V(6); PG8_BAR; PG8_MMA(1, 1, At, B1); PG8_BAR;
            }
        }
        if constexpr (ALIGN_EPI) { if (wr == 0) PG8_BAR; }
        asm volatile("s_nop 15\n\ts_nop 7" ::: "memory");
        if constexpr (!Epi::AFTER_DRAIN) { E(acc, cur, wr, wc, fr, fq); S.done(cur); }
        if (!has_next) break;
        if (!Epi::KEEP || cur.aux != 0) {
#pragma unroll
        for (int a = 0; a < 2; ++a)
#pragma unroll
            for (int b = 0; b < 2; ++b)
#pragma unroll
                for (int m = 0; m < 4; ++m)
#pragma unroll
                    for (int n = 0; n < 2; ++n) acc[a][b][m][n] = (f32x4){0.f, 0.f, 0.f, 0.f};
        }
        cur = nxt; cA = nA; cB = nB; ++ui;
        if constexpr (ALIGN_EPI) { if (wr == 1) PG8_BAR; }
    }
    PG8_WAIT_V(0);
    if constexpr (!ALIGN_EPI) { if (wr == 0) PG8_BAR; }
    PG8_BAR;
    if constexpr (Epi::AFTER_DRAIN) { E.fused(acc, cur, wr, wc, fr, fq, lds, wid, lane); S.done(cur); }
#undef PG8_SA
#undef PG8_SB
#undef PG8_STAGE
#undef PG8_LDA
#undef PG8_LDB
#undef PG8_MMA
#undef PG8_WAIT_V
#undef PG8_WAIT_L
#undef PG8_BAR
#undef PG8_SCHED
}
}
#define GAS __attribute__((address_space(1)))
#define LAS __attribute__((address_space(3)))
typedef unsigned short bf16;
typedef unsigned v4u __attribute__((ext_vector_type(4)));
typedef float f32x4 __attribute__((ext_vector_type(4)));
typedef short bf16x8 __attribute__((ext_vector_type(8)));
typedef GAS unsigned gu32;
typedef GAS unsigned long long gu64;
#define RLX_AGENT __ATOMIC_RELAXED, __HIP_MEMORY_SCOPE_AGENT
#define LDS_WAIT() asm volatile("s_waitcnt lgkmcnt(0)" ::: "memory")
#define VM_WAIT() asm volatile("s_waitcnt vmcnt(0)" ::: "memory")
__device__ __forceinline__ unsigned long long rt() { return __builtin_amdgcn_s_memrealtime(); }
__device__ __forceinline__ unsigned f2bf(float f) { unsigned u = __builtin_bit_cast(unsigned, f); return (u + 0x7fffu + ((u >> 16) & 1u)) >> 16; }
typedef float pk2_f32x2 __attribute__((ext_vector_type(2))); typedef __bf16 pk2_bf16x2 __attribute__((ext_vector_type(2)));
__device__ __forceinline__ unsigned pk2(float lo, float hi) { pk2_f32x2 v = {lo, hi}; pk2_bf16x2 b = __builtin_convertvector(v, pk2_bf16x2); return __builtin_bit_cast(unsigned, b); }

#define XB_TMO      128
#define XB_XCNT(j)  (256  + 64 * (j))
#define XB_XSUB(j)  (1280 + 64 * (j))
#define XB_XGEN(j)  (2304 + 64 * (j))
#define XB_TOP      3328
#define XB_TOPGEN   3392
#define XCD_BAR_WORDS 3456
#define XB_SPIN_CAP (1u << 18)

__device__ __forceinline__ unsigned xb_ld(unsigned* p)              { return __hip_atomic_load(p, __ATOMIC_RELAXED, __HIP_MEMORY_SCOPE_AGENT); }
__device__ __forceinline__ unsigned xb_add(unsigned* p, unsigned v) { return __hip_atomic_fetch_add(p, v, __ATOMIC_RELAXED, __HIP_MEMORY_SCOPE_AGENT); }
__device__ __forceinline__ unsigned xb_xcc_id() { return (unsigned)__builtin_amdgcn_s_getreg((3 << 11) | 20) & 0xFu; }
#define XB_SPIN(cond, bar) do { unsigned _sp = 0; while (cond) { __builtin_amdgcn_s_sleep(1); \
    if ((++_sp & 255u) == 0u) { if (xb_ld(&(bar)[XB_TMO])) break; if (_sp > XB_SPIN_CAP) { atomicAdd(&(bar)[XB_TMO], 1u); break; } } } } while (0)

struct XcdBarrier {
    unsigned* bar; unsigned x;
    volatile LAS unsigned* st;
};

__device__ __forceinline__ XcdBarrier xcd_barrier_post(unsigned* bar, volatile LAS unsigned* st) {
    XcdBarrier b; b.bar = bar; b.x = xb_xcc_id(); b.st = st;
    if (threadIdx.x == 0) (void)xb_add(&bar[XB_XCNT(b.x)], 1u);
    return b;
}
__device__ __forceinline__ void xcd_barrier_complete(unsigned* bar, unsigned x, unsigned& nloc, unsigned& nx) {
    const unsigned G = gridDim.x * gridDim.y * gridDim.z;
    unsigned sum, cnt, mine, sp = 0u;
    for (;;) {
        sum = 0u; cnt = 0u; mine = 0u;
#pragma unroll
        for (unsigned j = 0; j < 16; ++j) { const unsigned c = xb_ld(&bar[XB_XCNT(j)]); sum += c; cnt += (c > 0u) ? 1u : 0u; mine = (j == x) ? c : mine; }
        if (sum == G) break;
        __builtin_amdgcn_s_sleep(1);
        if ((++sp & 255u) == 0u) { if (xb_ld(&bar[XB_TMO])) break; if (sp > XB_SPIN_CAP) { atomicAdd(&bar[XB_TMO], 1u); break; } }
    }
    nloc = mine > 0u ? mine : 1u; nx = cnt > 0u ? cnt : 1u;
}

__device__ __forceinline__ void xcd_barrier(const XcdBarrier& b) {
    asm volatile("s_waitcnt vmcnt(0)" ::: "memory");
    __syncthreads();
    if (threadIdx.x == 0) {
        unsigned* bar = b.bar;
        __builtin_amdgcn_s_waitcnt(0);
        unsigned nloc = b.st[0], nx = b.st[1];
        if (nloc == 0u) { xcd_barrier_complete(bar, b.x, nloc, nx); b.st[0] = nloc; b.st[1] = nx; }
        const unsigned old = xb_add(&bar[XB_XSUB(b.x)], 1u);
        const unsigned gen = old / nloc;
        if (old + 1u == (gen + 1u) * nloc) {
            __builtin_amdgcn_fence(__ATOMIC_RELEASE, "agent");
            asm volatile("s_waitcnt vmcnt(0)" ::: "memory");
            const unsigned og = xb_add(&bar[XB_TOP], 1u);
            const unsigned tg = og / nx;
            if (og + 1u == (tg + 1u) * nx) xb_add(&bar[XB_TOPGEN], 1u);
            else XB_SPIN(xb_ld(&bar[XB_TOPGEN]) == tg, bar);
            __builtin_amdgcn_fence(__ATOMIC_ACQUIRE, "agent");
            xb_add(&bar[XB_XGEN(b.x)], 1u);
            asm volatile("s_waitcnt vmcnt(0)" ::: "memory");
        } else {
            XB_SPIN(xb_ld(&bar[XB_XGEN(b.x)]) == gen, bar);
            __builtin_amdgcn_fence(__ATOMIC_ACQUIRE, "agent");
            asm volatile("s_waitcnt vmcnt(0)" ::: "memory");
        }
    }
    __syncthreads();
}

constexpr int NWAVES = 8;
constexpr int M = 16384, D = 4096, DIN = 20480, DA = 2048, NH = 16, HD = 128, DFF = 11008, DFH = 5504, DPLE = 256, NBLK = 64, BLK = 256;
constexpr float RMS_EPS = 1e-6f;
constexpr float ATT_SCALE = 0.08838834764831845f;
#ifndef MK_PER_PHASE
#define MK_PER_PHASE 0
#endif
#ifndef PROBE_PHASE
#define PROBE_PHASE -1
#endif
#ifndef PROBE_FLAGS
#define PROBE_FLAGS 0
#endif
constexpr int NPH = 17;
#ifndef GEMM_WGM
#define GEMM_WGM 4
#endif

constexpr size_t MiB = 1u << 20;
constexpr size_t WS_CTL = 0, CTL_ZERO_BYTES = 1 * MiB;
constexpr size_t WS_KMH = 1 * MiB, WS_KML = 1 * MiB + 256 * 1024;
constexpr size_t WS_LSE = 2 * MiB;
constexpr size_t WS_PB = 8 * MiB;
constexpr size_t WS_WUP = 16 * MiB, WS_WDN = 188 * MiB, WS_WPG = 274 * MiB, WS_WP = 306 * MiB;
constexpr size_t WS_XN = 309 * MiB;
constexpr size_t WS_WO = 438 * MiB, WS_WA = 470 * MiB, WS_WC = 486 * MiB, WS_WIN = 502 * MiB;
constexpr size_t WS_Z = 662 * MiB;
constexpr size_t WS_Q = WS_Z, WS_K = WS_Z + 64 * MiB, WS_V = WS_Z + 128 * MiB, WS_CB = WS_Z + 192 * MiB, WS_CC = WS_Z + 256 * MiB, WS_CX = WS_Z + 320 * MiB, WS_GA = WS_Z + 384 * MiB, WS_GC = WS_Z + 512 * MiB;
constexpr size_t WS_LIST = 1302 * MiB;
constexpr size_t WS_TAB = 1336 * MiB;
constexpr size_t WS_END = 1344 * MiB;
constexpr size_t WS_S0 = WS_XN, WS_S1 = WS_XN + 64 * MiB, WS_S2 = WS_CC;
constexpr size_t WS_T1 = WS_XN, WS_MERGED = WS_K, WS_PP = WS_GC, WS_Y = 438 * MiB, WS_ACT = 782 * MiB;
constexpr size_t WS_X1B = 502 * MiB;
static_assert(WS_Y + (size_t)M * DFF * 2 <= WS_ACT && WS_ACT + (size_t)(M + 1) * DFF * 2 <= WS_PP && WS_LIST + (size_t)16 * 516096 * 4 <= WS_TAB && WS_GC + 128 * MiB == WS_LIST, "d_ws map");
constexpr int CW_TMO = 0, CW_CODE = 1, CW_QHEAD = 64, CW_BAR = 4096, CW_CNT = 16384, CW_RSS = 32768;
constexpr int LIST_PER_HEAD = 516096;
__host__ __device__ __forceinline__ int list_base(int h, int j) { return h * LIST_PER_HEAD + 256 * (63 * j - (j * (j - 1)) / 2); }

constexpr int RING_OFF = 0, RING_BYTES = 131072;
constexpr int MISC_OFF = 153600;
constexpr int LDS_BYTES = 155648;

struct Args { const void* in[17]; float* out; unsigned char* ws; int ph_lo, ph_hi, use_bar, bar_off, flags, pad; };

__device__ __forceinline__ float wave_sum(float v) {
#pragma unroll
    for (int o = 1; o < 64; o <<= 1) v += __shfl_xor(v, o);
    return v;
}
__device__ __forceinline__ float wave_max(float v) {
#pragma unroll
    for (int o = 1; o < 64; o <<= 1) v = fmaxf(v, __shfl_xor(v, o));
    return v;
}
__device__ __forceinline__ float bflo(unsigned w) { return __uint_as_float(w << 16); }
__device__ __forceinline__ float bfhi(unsigned w) { return __uint_as_float(w & 0xffff0000u); }

template <int RM> __device__ __forceinline__ int rowmap(int n) {
    if (RM == 0) return n;
    if (RM == 2) {
        if (n < 6 * DA) return n;
        const int g = n - 6 * DA; return g < D ? 6 * DA + (g >> 7) * 256 + (g & 127) : 6 * DA + ((g - D) >> 7) * 256 + 128 + ((g - D) & 127);
    }
    if (n < DFF) return (n >> 7) * 256 + (n & 127);
    const int n2 = n - DFF; return (n2 >> 7) * 256 + 128 + (n2 & 127);
}
template <int RM> __device__ __forceinline__ void p0_transpose_item(const float* W, int K, int N, bf16* WT, LAS float* scrf, int item, int lane, const float* kscale = nullptr) {
    LAS unsigned* scr = (LAS unsigned*)scrf;
    const int nblk = N / 64, kb = item / nblk, nb = item % nblk, k0 = 64 * kb, n0 = 64 * nb;
    const float* src = W + (size_t)k0 * N + n0 + lane;
    float v[64];
#pragma unroll
    for (int i = 0; i < 64; ++i) v[i] = __builtin_nontemporal_load(src + (size_t)i * N);
    if (kscale) {
#pragma unroll
        for (int i = 0; i < 64; ++i) v[i] *= kscale[k0 + i]; }
#pragma unroll
    for (int i = 0; i < 32; ++i) scr[i * 65 + lane] = pk2(v[2 * i], v[2 * i + 1]);
    LDS_WAIT(); asm volatile("" ::: "memory");
    const int c = lane & 7, nl = lane >> 3;
#pragma unroll
    for (int j = 0; j < 8; ++j) { const int n = nl + 8 * j; const LAS unsigned* s = scr + (4 * c) * 65 + n;
        v4u o; o.x = s[0 * 65]; o.y = s[1 * 65]; o.z = s[2 * 65]; o.w = s[3 * 65];
        *(v4u*)(WT + (size_t)rowmap<RM>(n0 + n) * K + k0 + 8 * c) = o; }
    LDS_WAIT(); asm volatile("" ::: "memory");
}
__device__ __forceinline__ void rms_row_to_bf16(const float* xrow, const f32x4 (&gv)[16], bf16* orow, int lane) {
    const f32x4* xr = (const f32x4*)xrow + lane;
    f32x4 v[16]; float s = 0.f;
#pragma unroll
    for (int j = 0; j < 16; ++j) { v[j] = __builtin_nontemporal_load(xr + 64 * j); s += (v[j].x * v[j].x + v[j].y * v[j].y) + (v[j].z * v[j].z + v[j].w * v[j].w); }
    const float r = 1.0f / sqrtf(wave_sum(s) * (1.f / D) + RMS_EPS);
    unsigned long long* o8 = (unsigned long long*)orow + lane;
#pragma unroll
    for (int j = 0; j < 16; ++j)
        o8[64 * j] = (unsigned long long)pk2(v[j].x * r * gv[j].x, v[j].y * r * gv[j].y) | ((unsigned long long)pk2(v[j].z * r * gv[j].z, v[j].w * r * gv[j].w) << 32);
}

__device__ __forceinline__ void p0_weights(LAS unsigned char* lds, const Args& a, int wave, int lane, int gw, int NGW, int part) {
    unsigned char* ws = a.ws;
    LAS float* scr = (LAS float*)lds + wave * (64 * 65);
    constexpr int I_IN = (D / 64) * (DIN / 64), I_A = (DA / 64) * (D / 64), I_O = (D / 64) * (D / 64), I_UP = (D / 64) * (2 * DFF / 64), I_DN = (DFF / 64) * (D / 64), I_P = (DPLE / 64) * (D / 64);
    if (part == 0) {
        for (int it = gw; it < I_IN + I_UP + 2 * I_A + I_O + I_P; it += NGW) {
            int r = it;
            if (r < I_IN) { p0_transpose_item<2>((const float*)a.in[4], D, DIN, (bf16*)(ws + WS_WIN), scr, r, lane); continue; } r -= I_IN;
            if (r < I_UP) { p0_transpose_item<1>((const float*)a.in[12], D, 2 * DFF, (bf16*)(ws + WS_WUP), scr, r, lane, (const float*)a.in[11]); continue; } r -= I_UP;
            if (r < I_A) { p0_transpose_item<0>((const float*)a.in[8], DA, D, (bf16*)(ws + WS_WA), scr, r, lane); continue; } r -= I_A;
            if (r < I_A) { p0_transpose_item<0>((const float*)a.in[9], DA, D, (bf16*)(ws + WS_WC), scr, r, lane); continue; } r -= I_A;
            if (r < I_O) { p0_transpose_item<0>((const float*)a.in[10], D, D, (bf16*)(ws + WS_WO), scr, r, lane); continue; } r -= I_O;
            p0_transpose_item<0>((const float*)a.in[15], DPLE, D, (bf16*)(ws + WS_WP), scr, r, lane);
        }
    } else {
        for (int it = gw; it < I_UP + I_DN + I_O; it += NGW) {
            int r = it;
            if (r < I_UP) { p0_transpose_item<1>((const float*)a.in[12], D, 2 * DFF, (bf16*)(ws + WS_WUP), scr, r, lane, (const float*)a.in[11]); continue; } r -= I_UP;
            if (r < I_DN) { p0_transpose_item<0>((const float*)a.in[14], DFF, D, (bf16*)(ws + WS_WDN), scr, r, lane); continue; } r -= I_DN;
            p0_transpose_item<0>((const float*)a.in[16], D, D, (bf16*)(ws + WS_WPG), scr, r, lane);
        }
    }
}
constexpr int CW_CONVQ = CW_QHEAD + 128;
struct P0It { const float* src; bf16* WT; int N, K, k0, n0; };
__device__ __forceinline__ P0It p0_late_resolve(const Args& a, unsigned char* ws, int it) {
    constexpr int I_DN = (DFF / 64) * (D / 64);
    P0It d; int r = it;
    if (r < I_DN) { d.N = D; d.K = DFF; d.WT = (bf16*)(ws + WS_WDN); d.src = (const float*)a.in[14]; }
    else { r -= I_DN; d.N = D; d.K = D; d.WT = (bf16*)(ws + WS_WPG); d.src = (const float*)a.in[16]; }
    const int nblk = d.N / 64, kb = r / nblk, nb = r % nblk; d.k0 = 64 * kb; d.n0 = 64 * nb;
    d.src += (size_t)d.k0 * d.N + d.n0;
    return d;
}
__device__ __forceinline__ void p0_late_load(const P0It& d, float (&v)[64], int lane) {
    const float* sp = d.src + lane;
#pragma unroll
    for (int i = 0; i < 64; ++i) v[i] = __builtin_nontemporal_load(sp + (size_t)i * d.N);
}
__device__ __forceinline__ void p0_late_finish(const P0It& d, float (&v)[64], LAS unsigned* scr, int lane) {
#pragma unroll
    for (int i = 0; i < 32; ++i) scr[i * 65 + lane] = pk2(v[2 * i], v[2 * i + 1]);
    LDS_WAIT(); asm volatile("" ::: "memory");
    const int c = lane & 7, nl = lane >> 3;
#pragma unroll
    for (int j = 0; j < 8; ++j) { const int n = nl + 8 * j; const LAS unsigned* s = scr + (4 * c) * 65 + n;
        v4u o; o.x = s[0 * 65]; o.y = s[1 * 65]; o.z = s[2 * 65]; o.w = s[3 * 65];
        *(v4u*)(d.WT + (size_t)(d.n0 + n) * d.K + d.k0 + 8 * c) = o; }
    LDS_WAIT(); asm volatile("" ::: "memory");
}
__device__ __forceinline__ void p0_late_weights_queue(LAS unsigned char* lds, const Args& a, gu32* ctl) {
    int tl_ = threadIdx.x; asm volatile("" : "+v"(tl_)); int lane = tl_ & 63; const int wave = __builtin_amdgcn_readfirstlane(tl_ >> 6);
    asm volatile("" : "+v"(lane));
    unsigned char* ws = a.ws;
    LAS unsigned* scr = (LAS unsigned*)((LAS float*)lds + wave * (64 * 65));
    constexpr int I_O = (D / 64) * (D / 64), I_DN = (DFF / 64) * (D / 64), NIT = I_DN + I_O, CH = 8, NCH = NIT / CH;
    static_assert(NIT % CH == 0, "whole chunks");
    for (;;) {
        unsigned c = 0u; if (lane == 0) c = __hip_atomic_fetch_add((unsigned*)ctl + CW_CONVQ, 1u, __ATOMIC_RELAXED, __HIP_MEMORY_SCOPE_AGENT);
        c = (unsigned)__builtin_amdgcn_readfirstlane((int)c);
        if (c >= (unsigned)NCH) break;
        const int i0 = (int)c * CH;
        float va[64], vb[64];
        P0It da = p0_late_resolve(a, ws, i0), db = da; p0_late_load(da, va, lane);
#pragma unroll 1
        for (int q = 0; q < CH; q += 2) {
            db = p0_late_resolve(a, ws, i0 + q + 1); p0_late_load(db, vb, lane);
            p0_late_finish(da, va, scr, lane);
            if (q + 2 < CH) { da = p0_late_resolve(a, ws, i0 + q + 2); p0_late_load(da, va, lane); }
            p0_late_finish(db, vb, scr, lane);
        }
    }
}
__device__ __forceinline__ void p0_prologue(LAS unsigned char* lds, const Args& a, int G, int wave, int lane) {
    unsigned char* ws = a.ws;
    const int gw = blockIdx.x * NWAVES + wave, NGW = G * NWAVES;
    p0_weights(lds, a, wave, lane, gw, NGW, 0);
    const float* x = (const float*)a.in[0]; const float* g1 = (const float*)a.in[3]; bf16* XN = (bf16*)(ws + WS_XN);
    f32x4 gv[16];
#pragma unroll
    for (int j = 0; j < 16; ++j) gv[j] = ((const f32x4*)g1)[lane + 64 * j];
    for (int m = gw; m < M; m += NGW) rms_row_to_bf16(x + (size_t)m * D, gv, XN + (size_t)m * D, lane);
    const f32x4* p4 = (const f32x4*)a.in[1]; v4u* pb = (v4u*)(ws + WS_PB);
    for (int i = gw * 64 + lane; i < M * DPLE / 8; i += NGW * 64) { const f32x4 u0 = p4[2 * i], u1 = p4[2 * i + 1]; v4u o; o.x = pk2(u0.x, u0.y); o.y = pk2(u0.z, u0.w); o.z = pk2(u1.x, u1.y); o.w = pk2(u1.z, u1.w); pb[i] = o; }
}

__device__ __forceinline__ void p0_rope_table(unsigned char* ws, const int* pos, int G, int wave, int lane) {
    typedef float f32x2v __attribute__((ext_vector_type(2)));
    f32x2v* tab = (f32x2v*)(ws + WS_TAB);
    const float ifr = (float)pow(10000.0, -(double)lane / 64.0);
    const int gw = blockIdx.x * NWAVES + wave, NGW = G * NWAVES;
    for (int t = gw; t < M; t += NGW) { const float a = (float)pos[t] * ifr; tab[(size_t)t * 64 + lane] = (f32x2v){cosf(a), sinf(a)}; }
}
__device__ __forceinline__ void p2_qk(LAS unsigned char* lds, unsigned char* ws, const float* qn, const float* kn, int G, int tid, int nost) {
    (void)nost;
    LAS float* red = (LAS float*)lds;
    bf16* __restrict__ Qb = (bf16*)(ws + WS_Q); bf16* __restrict__ Kb = (bf16*)(ws + WS_K);
    const f32x4* tab = (const f32x4*)(ws + WS_TAB);
    bf16* kmh = (bf16*)(ws + WS_KMH); bf16* kml = (bf16*)(ws + WS_KML);
    const int gidx = tid >> 3, c = tid & 7, hl = gidx & 3, ts = gidx >> 2;
    float gq[16], gk[16];
#pragma unroll
    for (int e = 0; e < 8; ++e) { gq[e] = qn[8 * c + e]; gq[8 + e] = qn[64 + 8 * c + e]; gk[e] = kn[8 * c + e]; gk[8 + e] = kn[64 + 8 * c + e]; }
    for (int it = blockIdx.x; it < NBLK * 4; it += G) {
        const int jb = it >> 2, hg = it & 3, head = hg * 4 + hl;
        float ks[16];
#pragma unroll
        for (int e = 0; e < 16; ++e) ks[e] = 0.f;
#pragma unroll 2
        for (int i = 0; i < 16; ++i) {
            const int t = jb * BLK + 16 * i + ts;
            const f32x4* tp = tab + (size_t)t * 32 + 4 * c;
            const f32x4 cs0 = tp[0], cs1 = tp[1], cs2 = tp[2], cs3 = tp[3];
            const float cs[16] = {cs0.x, cs0.y, cs0.z, cs0.w, cs1.x, cs1.y, cs1.z, cs1.w, cs2.x, cs2.y, cs2.z, cs2.w, cs3.x, cs3.y, cs3.z, cs3.w};
#pragma unroll
            for (int ten = 0; ten < 2; ++ten) {
                bf16* ptr = (ten ? Kb : Qb) + (size_t)t * DA + head * HD + 8 * c;
                const v4u lo = *(const v4u*)ptr, hi = *(const v4u*)(ptr + 64);
                float x[16];
#pragma unroll
                for (int e = 0; e < 4; ++e) { x[2 * e] = bflo(lo[e]); x[2 * e + 1] = bfhi(lo[e]); x[8 + 2 * e] = bflo(hi[e]); x[9 + 2 * e] = bfhi(hi[e]); }
                float ss = 0.f;
#pragma unroll
                for (int e = 0; e < 16; ++e) ss += x[e] * x[e];
                ss += __shfl_xor(ss, 1); ss += __shfl_xor(ss, 2); ss += __shfl_xor(ss, 4);
                const float r = 1.0f / sqrtf(ss * (1.f / HD) + RMS_EPS);
                float o[16];
#pragma unroll
                for (int e = 0; e < 8; ++e) { const float y0 = x[e] * r * (ten ? gk[e] : gq[e]), y1 = x[8 + e] * r * (ten ? gk[8 + e] : gq[8 + e]); const float cc = cs[2 * e], sn = cs[2 * e + 1];
                    o[e] = y0 * cc - y1 * sn; o[8 + e] = y1 * cc + y0 * sn; }
                v4u wl, wh;
#pragma unroll
                for (int e = 0; e < 4; ++e) { wl[e] = pk2(o[2 * e], o[2 * e + 1]); wh[e] = pk2(o[8 + 2 * e], o[9 + 2 * e]); }
                *(v4u*)ptr = wl; *(v4u*)(ptr + 64) = wh;
                if (ten) {
#pragma unroll
                    for (int e = 0; e < 16; ++e) ks[e] += o[e]; }
            }
        }
        __syncthreads();
#pragma unroll
        for (int e = 0; e < 4; ++e) *(LAS f32x4*)(red + (gidx * 8 + c) * 16 + 4 * e) = (f32x4){ks[4 * e], ks[4 * e + 1], ks[4 * e + 2], ks[4 * e + 3]};
        __syncthreads();
        {
            const int h2 = tid >> 7, d = tid & 127, c2 = (d & 63) >> 3, e2 = (d & 7) + ((d >> 6) << 3);
            float s = 0.f;
#pragma unroll
            for (int t2 = 0; t2 < 16; ++t2) s += red[((t2 * 4 + h2) * 8 + c2) * 16 + e2];
            s *= (1.f / BLK);
            const unsigned hb = f2bf(s); const float hf = __uint_as_float(hb << 16);
            const size_t o = ((size_t)(hg * 4 + h2) * NBLK + jb) * HD + d;
            kmh[o] = (bf16)hb; kml[o] = (bf16)f2bf(s - hf);
        }
    }
}
__device__ __forceinline__ void p2_conv(unsigned char* ws, const float* cw, int G, int wave, int lane, int nost) {
    (void)nost;
    bf16* __restrict__ CB = (bf16*)(ws + WS_CB); const bf16* __restrict__ CC = (const bf16*)(ws + WS_CC); const bf16* __restrict__ CX = (const bf16*)(ws + WS_CX);
    const int gw = blockIdx.x * NWAVES + wave, NGW = G * NWAVES;
    for (int it = gw; it < (M / 32) * 4; it += NGW) {
        const int rc = it >> 2, st = it & 3, c = st * 512 + lane * 8, t0 = rc * 32;
        float w0[8], w1[8], w2[8], p1[8], p2[8];
#pragma unroll
        for (int e = 0; e < 8; ++e) { w0[e] = cw[c + e]; w1[e] = cw[DA + c + e]; w2[e] = cw[2 * DA + c + e]; p1[e] = 0.f; p2[e] = 0.f; }
        if (t0 >= 2) {
            const v4u a2 = *(const v4u*)(CC + (size_t)(t0 - 2) * DA + c), b2 = *(const v4u*)(CX + (size_t)(t0 - 2) * DA + c);
            const v4u a1 = *(const v4u*)(CC + (size_t)(t0 - 1) * DA + c), b1 = *(const v4u*)(CX + (size_t)(t0 - 1) * DA + c);
#pragma unroll
            for (int e = 0; e < 4; ++e) { p2[2 * e] = bflo(a2[e]) * bflo(b2[e]); p2[2 * e + 1] = bfhi(a2[e]) * bfhi(b2[e]); p1[2 * e] = bflo(a1[e]) * bflo(b1[e]); p1[2 * e + 1] = bfhi(a1[e]) * bfhi(b1[e]); }
        }
#pragma unroll 1
        for (int tb = 0; tb < 32; tb += 8) {
            v4u ra[8], rb[8], rg[8];
#pragma unroll
            for (int k = 0; k < 8; ++k) { const size_t o = (size_t)(t0 + tb + k) * DA + c; ra[k] = *(const v4u*)(CC + o); rb[k] = *(const v4u*)(CX + o); rg[k] = *(const v4u*)(CB + o); }
#pragma unroll
            for (int k = 0; k < 8; ++k) {
                const size_t o = (size_t)(t0 + tb + k) * DA + c;
                float pr[8], out[8];
#pragma unroll
                for (int e = 0; e < 4; ++e) { pr[2 * e] = bflo(ra[k][e]) * bflo(rb[k][e]); pr[2 * e + 1] = bfhi(ra[k][e]) * bfhi(rb[k][e]); }
#pragma unroll
                for (int e = 0; e < 8; ++e) { const float gb = (e & 1) ? bfhi(rg[k][e >> 1]) : bflo(rg[k][e >> 1]); out[e] = gb * (w2[e] * pr[e] + w1[e] * p1[e] + w0[e] * p2[e]); p2[e] = p1[e]; p1[e] = pr[e]; }
                v4u ov; ov.x = pk2(out[0], out[1]); ov.y = pk2(out[2], out[3]); ov.z = pk2(out[4], out[5]); ov.w = pk2(out[6], out[7]);
                *(v4u*)(CB + o) = ov;
            }
        }
    }
}

typedef float f32x16g __attribute__((ext_vector_type(16)));
#define P3_BETTER(v, j, bv, bj) ((v) > (bv) || ((v) == (bv) && (j) < (bj)))
#define P3_INSERT(v, j) do { const bool b0_ = P3_BETTER(v, j, t0v, t0j), b1_ = P3_BETTER(v, j, t1v, t1j), b2_ = P3_BETTER(v, j, t2v, t2j); \
    t2v = b1_ ? t1v : (b2_ ? (v) : t2v); t2j = b1_ ? t1j : (b2_ ? (j) : t2j); t1v = b0_ ? t0v : (b1_ ? (v) : t1v); t1j = b0_ ? t0j : (b1_ ? (j) : t1j); t0v = b0_ ? (v) : t0v; t0j = b0_ ? (j) : t0j; } while (0)
__device__ __forceinline__ void p3_gate(LAS unsigned char* lds, unsigned char* ws, gu32* ctl, int G, int tid, int wave, int lane, int nost) {
    const bf16* Qb = (const bf16*)(ws + WS_Q); const bf16* kmh = (const bf16*)(ws + WS_KMH); const bf16* kml = (const bf16*)(ws + WS_KML); unsigned* list = (unsigned*)(ws + WS_LIST);
    LAS unsigned* lcnt = (LAS unsigned*)(lds + 32768); LAS unsigned* lbase = (LAS unsigned*)(lds + 32768 + 256);
    const int r = lane & 31, hi = lane >> 5;
    int koff[8];
#pragma unroll
    for (int ds = 0; ds < 8; ++ds) koff[ds] = r * 256 + (((2 * ds + hi) ^ (r & 15)) << 4);
    for (int it = blockIdx.x; it < NH * (NBLK - 1); it += G) {
        const int h = it / (NBLK - 1), qb = 1 + it % (NBLK - 1);
        __syncthreads();
#pragma unroll
        for (int i = 0; i < 2; ++i) { const int n = wave * 2 + i, p = n * 64 + lane, j = p >> 4, pc = p & 15, ck = pc ^ (j & 15);
            __builtin_amdgcn_global_load_lds((const unsigned*)(kmh + ((size_t)h * NBLK + j) * HD + ck * 8), (LAS unsigned*)(lds + n * 1024), 16, 0, 0);
            __builtin_amdgcn_global_load_lds((const unsigned*)(kml + ((size_t)h * NBLK + j) * HD + ck * 8), (LAS unsigned*)(lds + 16384 + n * 1024), 16, 0, 0); }
        if (tid < 64) lcnt[tid] = 0u;
        const int t = qb * BLK + wave * 32 + r;
        bf16x8 qf[8];
#pragma unroll
        for (int ds = 0; ds < 8; ++ds) qf[ds] = *(const bf16x8*)(Qb + (size_t)t * DA + h * HD + 16 * ds + 8 * hi);
        asm volatile("s_waitcnt vmcnt(0)" ::: "memory");
        __syncthreads();
        f32x16g g0, g1;
#pragma unroll
        for (int e = 0; e < 16; ++e) { g0[e] = 0.f; g1[e] = 0.f; }
#pragma unroll
        for (int ds = 0; ds < 8; ++ds) {
            const bf16x8 a0 = *(const LAS bf16x8*)(lds + koff[ds]), a1 = *(const LAS bf16x8*)(lds + koff[ds] + 8192);
            const bf16x8 b0 = *(const LAS bf16x8*)(lds + 16384 + koff[ds]), b1 = *(const LAS bf16x8*)(lds + 16384 + koff[ds] + 8192);
            g0 = __builtin_amdgcn_mfma_f32_32x32x16_bf16(a0, qf[ds], g0, 0, 0, 0); g1 = __builtin_amdgcn_mfma_f32_32x32x16_bf16(a1, qf[ds], g1, 0, 0, 0);
            g0 = __builtin_amdgcn_mfma_f32_32x32x16_bf16(b0, qf[ds], g0, 0, 0, 0); g1 = __builtin_amdgcn_mfma_f32_32x32x16_bf16(b1, qf[ds], g1, 0, 0, 0);
        }
        float vv[32];
#pragma unroll
        for (int e = 0; e < 16; ++e) { const int j = (e & 3) + 8 * (e >> 2) + 4 * hi; vv[e] = j < qb ? g0[e] : -INFINITY; vv[16 + e] = (32 + j) < qb ? g1[e] : -INFINITY; }
        float t0v, t1v, t2v; int t0j, t1j, t2j;
#define P3_SCAN(TV, TJ, SENT) do { TV = -INFINITY; TJ = (SENT); \
    _Pragma("unroll") for (int e = 0; e < 32; ++e) { const int j = 32 * (e >> 4) + ((e & 15) & 3) + 8 * ((e & 15) >> 2) + 4 * hi; if (vv[e] > TV) { TV = vv[e]; TJ = j; } } \
    _Pragma("unroll") for (int e = 0; e < 32; ++e) { const int j = 32 * (e >> 4) + ((e & 15) & 3) + 8 * ((e & 15) >> 2) + 4 * hi; if (j == TJ) vv[e] = -INFINITY; } } while (0)
        P3_SCAN(t0v, t0j, 64); P3_SCAN(t1v, t1j, 65); P3_SCAN(t2v, t2j, 66);
#undef P3_SCAN
        {
            const float p0v = __shfl_xor(t0v, 32), p1v = __shfl_xor(t1v, 32), p2v = __shfl_xor(t2v, 32);
            const int p0j = __shfl_xor(t0j, 32), p1j = __shfl_xor(t1j, 32), p2j = __shfl_xor(t2j, 32);
            P3_INSERT(p0v, p0j); P3_INSERT(p1v, p1j); P3_INSERT(p2v, p2j);
        }
        const int nvalid = qb < 3 ? qb : 3;
        unsigned rk0 = 0u, rk1 = 0u, rk2 = 0u;
        if (hi == 0) {
            rk0 = __hip_atomic_fetch_add(lcnt + t0j, 1u, __ATOMIC_RELAXED, __HIP_MEMORY_SCOPE_WORKGROUP);
            if (nvalid > 1) rk1 = __hip_atomic_fetch_add(lcnt + t1j, 1u, __ATOMIC_RELAXED, __HIP_MEMORY_SCOPE_WORKGROUP);
            if (nvalid > 2) rk2 = __hip_atomic_fetch_add(lcnt + t2j, 1u, __ATOMIC_RELAXED, __HIP_MEMORY_SCOPE_WORKGROUP);
        }
        __syncthreads();
        if (tid < 64) { const unsigned n = lcnt[tid]; lbase[tid] = (n && !nost) ? __hip_atomic_fetch_add((unsigned*)ctl + CW_CNT + h * NBLK + tid, n, __ATOMIC_RELAXED, __HIP_MEMORY_SCOPE_AGENT) : 0u; }
        __syncthreads();
        if (hi == 0 && !nost) {
            list[list_base(h, t0j) + lbase[t0j] + rk0] = (unsigned)t;
            if (nvalid > 1) list[list_base(h, t1j) + lbase[t1j] + rk1] = (1u << 14) | (unsigned)t;
            if (nvalid > 2) list[list_base(h, t2j) + lbase[t2j] + rk2] = (2u << 14) | (unsigned)t;
        }
    }
}

typedef float f32x16 __attribute__((ext_vector_type(16)));
typedef short s16x4 __attribute__((ext_vector_type(4)));
typedef float f32x2_t __attribute__((ext_vector_type(2)));
typedef __bf16 bf16x2_t __attribute__((ext_vector_type(2)));
__device__ __forceinline__ unsigned cvtpk(float lo, float hi) { f32x2_t v = {lo, hi}; bf16x2_t b = __builtin_convertvector(v, bf16x2_t); return __builtin_bit_cast(unsigned, b); }
__device__ __forceinline__ int crow(int r, int hi) { return (r & 3) + 8 * (r >> 2) + 4 * hi; }
constexpr int ATT_K_OFF = 0, ATT_V_OFF = 65536, ATT_PRE_OFF = 131072;
constexpr float ATT_C = ATT_SCALE * 1.4426950408889634f, LN2F = 0.6931471805599453f;

__device__ __forceinline__ void stage_kv(LAS unsigned char* lds, const bf16* Kb, const bf16* Vb, int h, int j, int wave, int lane) {
#pragma unroll
    for (int i = 0; i < 8; ++i) {
        const int n = wave * 8 + i, p = n * 64 + lane, key = p >> 4, pc = p & 15;
        const int ck = pc ^ (key & 15), cv = pc ^ ((key & 3) << 2);
        const size_t ro = (size_t)(j * BLK + key) * DA + h * HD;
        __builtin_amdgcn_global_load_lds((const unsigned*)(Kb + ro + ck * 8), (LAS unsigned*)(lds + ATT_K_OFF + n * 1024), 16, 0, 0);
        __builtin_amdgcn_global_load_lds((const unsigned*)(Vb + ro + cv * 8), (LAS unsigned*)(lds + ATT_V_OFF + n * 1024), 16, 0, 0);
    }
}
#define AT_SB() __builtin_amdgcn_sched_barrier(0)
#define AT_LOADK(HF, KF) do { _Pragma("unroll") for (int i_ = 0; i_ < 4; ++i_) { KF[2 * i_] = *(const LAS bf16x8*)(kb + koff[4 * (HF) + i_]); KF[2 * i_ + 1] = *(const LAS bf16x8*)(kb + koff[4 * (HF) + i_] + 8192); } } while (0)
#define AT_MMAK(HF, KF) do { _Pragma("unroll") for (int i_ = 0; i_ < 4; ++i_) { s0 = __builtin_amdgcn_mfma_f32_32x32x16_bf16(KF[2 * i_], qf[4 * (HF) + i_], s0, 0, 0, 0); s1 = __builtin_amdgcn_mfma_f32_32x32x16_bf16(KF[2 * i_ + 1], qf[4 * (HF) + i_], s1, 0, 0, 0); } } while (0)
#define AT_LOADV(PR, VF) do { _Pragma("unroll") for (int k_ = 0; k_ < 2; ++k_) _Pragma("unroll") for (int db_ = 0; db_ < 4; ++db_) { \
    const s16x4 lo_ = __builtin_bit_cast(s16x4, __builtin_amdgcn_ds_read_tr16_b64_v4i16((LAS s16x4*)(vb + voff[db_] + (2 * (PR) + k_) * 4096))); \
    const s16x4 hi_ = __builtin_bit_cast(s16x4, __builtin_amdgcn_ds_read_tr16_b64_v4i16((LAS s16x4*)(vb + voff[db_] + (2 * (PR) + k_) * 4096 + 2048))); \
    VF[4 * k_ + db_] = (bf16x8){lo_[0], lo_[1], lo_[2], lo_[3], hi_[0], hi_[1], hi_[2], hi_[3]}; } } while (0)
#define AT_MMAV(PR, VF) do { const f32x16& P_ = ((PR) == 0) ? s0 : s1; _Pragma("unroll") for (int k_ = 0; k_ < 2; ++k_) { \
    v4u pw_; pw_.x = cvtpk(P_[8 * k_ + 0], P_[8 * k_ + 1]); pw_.y = cvtpk(P_[8 * k_ + 2], P_[8 * k_ + 3]); pw_.z = cvtpk(P_[8 * k_ + 4], P_[8 * k_ + 5]); pw_.w = cvtpk(P_[8 * k_ + 6], P_[8 * k_ + 7]); \
    const bf16x8 pf_ = __builtin_bit_cast(bf16x8, pw_); \
    _Pragma("unroll") for (int db_ = 0; db_ < 4; ++db_) o[db_] = __builtin_amdgcn_mfma_f32_32x32x16_bf16(VF[4 * k_ + db_], pf_, o[db_], 0, 0, 0); } } while (0)
struct NoHook { __device__ __forceinline__ void operator()(bf16x8 (&)[8]) {} };
template <bool CAUSAL, class Hook>
__device__ __forceinline__ void attn_tile(LAS unsigned char* lds, bf16x8 (&qf)[8], int nsteps, int ql, int lane, float& m, float& l, f32x16 (&o)[4], Hook& hook) {
    const int r = lane & 31, hi = lane >> 5, i16 = lane & 15, g = lane >> 4, kq = i16 >> 2;
    int koff[8], voff[4];
#pragma unroll
    for (int ds = 0; ds < 8; ++ds) koff[ds] = ATT_K_OFF + r * 256 + (((2 * ds + hi) ^ (r & 15)) << 4);
#pragma unroll
    for (int db = 0; db < 4; ++db) voff[db] = ATT_V_OFF + (4 * hi + kq) * 256 + ((db ^ kq) << 6) + ((g & 1) << 5) + (((i16 & 3) >> 1) << 4) + ((i16 & 1) << 3);
    m = -INFINITY; l = 0.f;
#pragma unroll
    for (int db = 0; db < 4; ++db)
#pragma unroll
        for (int e = 0; e < 16; ++e) o[db][e] = 0.f;
#pragma unroll 1
    for (int st = 0; st < nsteps; ++st) {
        f32x16 s0, s1;
#pragma unroll
        for (int e = 0; e < 16; ++e) { s0[e] = 0.f; s1[e] = 0.f; }
        LAS unsigned char* kb = lds + st * 16384; LAS unsigned char* vb = kb;
        bf16x8 fr[8];
        AT_LOADK(0, fr); AT_SB(); AT_MMAK(0, fr); AT_SB();
        AT_LOADK(1, fr); AT_SB(); AT_MMAK(1, fr); AT_SB();
        if (st == nsteps - 1) { hook(qf); AT_SB(); }
        float mx = -INFINITY;
#pragma unroll
        for (int e = 0; e < 16; ++e) {
            if (CAUSAL) { const int key = 64 * st + crow(e, hi); if (key > ql) s0[e] = -INFINITY; if (key + 32 > ql) s1[e] = -INFINITY; }
            mx = fmaxf(mx, fmaxf(s0[e], s1[e]));
        }
        mx = fmaxf(mx, __shfl_xor(mx, 32));
        if (__any(mx > m + (8.0f / ATT_C))) {
            const float mn = fmaxf(m, mx), alpha = __builtin_amdgcn_exp2f((m - mn) * ATT_C);
            m = mn; l *= alpha;
#pragma unroll
            for (int db = 0; db < 4; ++db)
#pragma unroll
                for (int e = 0; e < 16; ++e) o[db][e] *= alpha;
        }
        const float nb = -m * ATT_C;
        float ls = 0.f;
#pragma unroll
        for (int e = 0; e < 16; ++e) { s0[e] = __builtin_amdgcn_exp2f(__builtin_fmaf(s0[e], ATT_C, nb)); s1[e] = __builtin_amdgcn_exp2f(__builtin_fmaf(s1[e], ATT_C, nb)); ls += s0[e] + s1[e]; }
        l += ls;
        AT_SB();
        AT_LOADV(0, fr); AT_SB(); AT_MMAV(0, fr); AT_SB();
        AT_LOADV(1, fr); AT_SB(); AT_MMAV(1, fr); AT_SB();
    }
    m *= ATT_C;
}
constexpr int P4_LCAP = 5120;
#define P4_FETCH(S_, T_, SL_, VALID_, QF_) do { int e_ = (S_) * 32 + r; VALID_ = e_ < n; if (!VALID_) e_ = n - 1; \
    const unsigned ent_ = e_ < P4_LCAP ? llist[e_] : list[lb + e_]; T_ = (int)(ent_ & 16383u); SL_ = (int)(ent_ >> 14); \
    _Pragma("unroll") for (int ds_ = 0; ds_ < 8; ++ds_) QF_[ds_] = *(const bf16x8*)(Qb + (size_t)T_ * DA + h * HD + 16 * ds_ + 8 * hi); } while (0)
struct P4Pref {
    LAS unsigned* lctl; LAS unsigned* llist; const unsigned* list; const bf16* Qb; int lb, n, nsub, h, r, hi, lane;
    int s_n, t_n, sl_n; bool v_n;
    __device__ __forceinline__ void operator()(bf16x8 (&qf)[8]) {
        unsigned sv = 0u; if (lane == 0) sv = __hip_atomic_fetch_add(lctl + 1, 1u, __ATOMIC_RELAXED, __HIP_MEMORY_SCOPE_WORKGROUP);
        s_n = (int)__builtin_amdgcn_readfirstlane(sv);
        if (s_n < nsub) { P4_FETCH(s_n, t_n, sl_n, v_n, qf); }
    }
};
__device__ __forceinline__ void p4_routed(LAS unsigned char* lds, unsigned char* ws, gu32* ctl, int G, int tid, int wave, int lane, int qsel, int nost = 0) {
    LAS unsigned* lctl = (LAS unsigned*)(lds + ATT_PRE_OFF); LAS unsigned* llist = (LAS unsigned*)(lds + ATT_PRE_OFF + 64);
    const bf16* Qb = (const bf16*)(ws + WS_Q); const bf16* Kb = (const bf16*)(ws + WS_K); const bf16* Vb = (const bf16*)(ws + WS_V);
    const unsigned* list = (const unsigned*)(ws + WS_LIST); float* lse = (float*)(ws + WS_LSE);
    const int r = lane & 31, hi = lane >> 5;
    for (;;) {
        __syncthreads();
        if (tid == 0) { lctl[0] = __hip_atomic_fetch_add((unsigned*)ctl + CW_QHEAD + 64 * qsel, 1u, __ATOMIC_RELAXED, __HIP_MEMORY_SCOPE_AGENT); lctl[1] = 0u; }
        __syncthreads();
        const int i = (int)lctl[0];
        if (i >= NH * (NBLK - 1)) break;
        const int j = i >> 4, h = i & 15;
        const int n = (int)__hip_atomic_load((unsigned*)ctl + CW_CNT + h * NBLK + j, __ATOMIC_RELAXED, __HIP_MEMORY_SCOPE_AGENT);
        if (n == 0) continue;
        stage_kv(lds, Kb, Vb, h, j, wave, lane);
        const int lb = list_base(h, j);
        for (int e = tid; e < n && e < P4_LCAP; e += NWAVES * 64) llist[e] = list[lb + e];
        asm volatile("s_waitcnt vmcnt(0) lgkmcnt(0)" ::: "memory");
        __syncthreads();
        const int nsub = (n + 31) >> 5;
        int s_cur; { unsigned sv = 0u; if (lane == 0) sv = __hip_atomic_fetch_add(lctl + 1, 1u, __ATOMIC_RELAXED, __HIP_MEMORY_SCOPE_WORKGROUP); s_cur = (int)__builtin_amdgcn_readfirstlane(sv); }
        int t_c = 0, sl_c = 0; bool v_c = false; bf16x8 qc[8];
#pragma unroll
        for (int ds = 0; ds < 8; ++ds) qc[ds] = (bf16x8){0, 0, 0, 0, 0, 0, 0, 0};
        if (s_cur < nsub) P4_FETCH(s_cur, t_c, sl_c, v_c, qc);
        while (s_cur < nsub) {
            P4Pref pf{lctl, llist, list, Qb, lb, n, nsub, h, r, hi, lane, nsub, 0, 0, false};
            float m, l; f32x16 o[4];
            attn_tile<false>(lds, qc, 4, 0, lane, m, l, o, pf);
            const float lt = l + __shfl_xor(l, 32), il = 1.0f / lt;
            if (v_c) {
                bf16* So = (bf16*)(ws + (sl_c == 0 ? WS_S0 : (sl_c == 1 ? WS_S1 : WS_S2))) + (size_t)t_c * DA + h * HD + 4 * hi;
#pragma unroll
                for (int db = 0; db < 4; ++db)
#pragma unroll
                    for (int g4 = 0; g4 < 4; ++g4) { pg8::u32x2 w; w.x = cvtpk(o[db][4 * g4] * il, o[db][4 * g4 + 1] * il); w.y = cvtpk(o[db][4 * g4 + 2] * il, o[db][4 * g4 + 3] * il);
                        *(pg8::u32x2*)(So + 32 * db + 8 * g4) = w; }
                if (hi == 0) lse[((size_t)sl_c * NH + h) * M + t_c] = (m + __builtin_amdgcn_logf(lt)) * LN2F;
            }
            s_cur = pf.s_n; t_c = pf.t_n; sl_c = pf.sl_n; v_c = pf.v_n;
        }
    }
}
#undef P4_FETCH
__device__ __forceinline__ void p5_own(LAS unsigned char* lds, unsigned char* ws, int G, int wave, int lane, int nost) {
    bf16* Qb = (bf16*)(ws + WS_Q); const bf16* Kb = (const bf16*)(ws + WS_K); const bf16* Vb = (const bf16*)(ws + WS_V);
    const float* lse = (const float*)(ws + WS_LSE);
    const int r = lane & 31, hi = lane >> 5;
    for (int it = blockIdx.x; it < NH * NBLK; it += G) {
        const int h = it & 15, j = it >> 4;
        __syncthreads();
        stage_kv(lds, Kb, Vb, h, j, wave, lane);
        const int t = j * BLK + wave * 32 + r;
        bf16x8 qf[8];
#pragma unroll
        for (int ds = 0; ds < 8; ++ds) qf[ds] = *(const bf16x8*)(Qb + (size_t)t * DA + h * HD + 16 * ds + 8 * hi);
        asm volatile("s_waitcnt vmcnt(0)" ::: "memory");
        __syncthreads();
        float m, l; f32x16 o[4];
        NoHook nh; attn_tile<true>(lds, qf, (wave >> 1) + 1, wave * 32 + r, lane, m, l, o, nh);
        const float lt = l + __shfl_xor(l, 32);
        const int nvalid = j < 3 ? j : 3;
        const float lown = (m + __builtin_amdgcn_logf(lt)) * LN2F;
        float ls[3]; float mx = lown;
#pragma unroll
        for (int s = 0; s < 3; ++s) { ls[s] = (s < nvalid) ? lse[((size_t)s * NH + h) * M + t] : -INFINITY; mx = fmaxf(mx, ls[s]); }
        const float wown = __expf(lown - mx); float wsum = wown; float wv[3];
#pragma unroll
        for (int s = 0; s < 3; ++s) { wv[s] = (s < nvalid) ? __expf(ls[s] - mx) : 0.f; wsum += wv[s]; }
        const float iw = 1.0f / wsum, wo = wown / lt * iw;
        const size_t ro = (size_t)t * DA + h * HD + 4 * hi;
        pg8::u32x2 pq[3][4][4];
#pragma unroll
        for (int s = 0; s < 3; ++s)
#pragma unroll
            for (int db = 0; db < 4; ++db)
#pragma unroll
                for (int g4 = 0; g4 < 4; ++g4) pq[s][db][g4] = (s < nvalid) ? *(const pg8::u32x2*)((const bf16*)(ws + (s == 0 ? WS_S0 : (s == 1 ? WS_S1 : WS_S2))) + ro + 32 * db + 8 * g4) : (pg8::u32x2){0u, 0u};
        const float w0 = wv[0] * iw, w1 = wv[1] * iw, w2s = wv[2] * iw;
#pragma unroll
        for (int db = 0; db < 4; ++db)
#pragma unroll
            for (int g4 = 0; g4 < 4; ++g4) {
                float a0 = o[db][4 * g4] * wo, a1 = o[db][4 * g4 + 1] * wo, a2 = o[db][4 * g4 + 2] * wo, a3 = o[db][4 * g4 + 3] * wo;
                { const pg8::u32x2 pw = pq[0][db][g4]; a0 += w0 * bflo(pw.x); a1 += w0 * bfhi(pw.x); a2 += w0 * bflo(pw.y); a3 += w0 * bfhi(pw.y); }
                { const pg8::u32x2 pw = pq[1][db][g4]; a0 += w1 * bflo(pw.x); a1 += w1 * bfhi(pw.x); a2 += w1 * bflo(pw.y); a3 += w1 * bfhi(pw.y); }
                { const pg8::u32x2 pw = pq[2][db][g4]; a0 += w2s * bflo(pw.x); a1 += w2s * bfhi(pw.x); a2 += w2s * bflo(pw.y); a3 += w2s * bfhi(pw.y); }
                pg8::u32x2 w2; w2.x = cvtpk(a0, a1); w2.y = cvtpk(a2, a3);
                *(pg8::u32x2*)(Qb + ro + 32 * db + 8 * g4) = w2;
            }
    }
}

__global__ void __launch_bounds__(NWAVES * 64, 2) block_fwd(Args args) {
    extern __shared__ __attribute__((aligned(16))) unsigned char lds_raw[];
    LAS unsigned char* lds = (LAS unsigned char*)lds_raw;
    volatile LAS unsigned* MISC = (volatile LAS unsigned*)(lds + MISC_OFF);
    const int tid = threadIdx.x, lane = tid & 63, wave = __builtin_amdgcn_readfirstlane(tid >> 6), G = gridDim.x;
    unsigned char* ws = args.ws; gu32* ctl = (gu32*)(ws + WS_CTL);
    for (int u = tid; u < (LDS_BYTES - MISC_OFF) / 4; u += NWAVES * 64) ((LAS unsigned*)(lds + MISC_OFF))[u] = 0u;
    __syncthreads();
    XcdBarrier bar; bar.bar = (unsigned*)ctl + CW_BAR + args.bar_off; bar.x = 0; bar.st = nullptr;
    if (args.use_bar) bar = xcd_barrier_post((unsigned*)ctl + CW_BAR + args.bar_off, MISC + 8);
    const int lo = args.ph_lo, hi = args.ph_hi;
#define IN(k) (lo <= (k) && (k) < hi)
#define SEAM(k) do { if (IN(k) && IN((k) + 1)) xcd_barrier(bar); } while (0)
    bf16* const XN = (bf16*)(ws + WS_XN);
    float* const out = args.out;

    if (IN(0)) { p0_prologue(lds, args, G, wave, lane); p0_rope_table(ws, (const int*)args.in[2], G, wave, lane); } SEAM(0);
    if (IN(1)) {
        pg8::Gemm g{XN, (const bf16*)(ws + WS_WIN), M, DIN, D}; pg8::StaticOrder S; S.init(M, DIN, G, (int)blockIdx.x, GEMM_WGM);
        pg8::EpiZ E{(bf16*)(ws + WS_Z), M, args.flags & 1};
        pg8::gemm_phase<pg8::EpiZ, pg8::StaticOrder, true, true>(lds + RING_OFF, g, S, E);
    } SEAM(1);
    if (IN(2)) { p2_qk(lds, ws, (const float*)args.in[5], (const float*)args.in[6], G, tid, args.flags & 2); p2_conv(ws, (const float*)args.in[7], G, wave, lane, args.flags & 2); } SEAM(2);
    if (IN(3)) { p3_gate(lds, ws, ctl, G, tid, wave, lane, args.flags & 2); } SEAM(3);
    if (IN(4)) { p4_routed(lds, ws, ctl, G, tid, wave, lane, (args.flags >> 2) & 1, args.flags & 8); } SEAM(4);
    if (IN(5)) { p5_own(lds, ws, G, wave, lane, args.flags & 2); } SEAM(5);
    if (IN(6)) {
        pg8::Gemm g{(const bf16*)(ws + WS_Q), (const bf16*)(ws + WS_WA), M, D, DA, (size_t)(WS_CB - WS_Q), (size_t)(WS_WC - WS_WA)}; pg8::DualOrder S; S.so.init(M, D, G, (int)blockIdx.x);
        pg8::EpiDual E{(const bf16*)(ws + WS_GA), (const bf16*)(ws + WS_GC), (bf16*)(ws + WS_MERGED), D};
        pg8::gemm_phase<pg8::EpiDual, pg8::DualOrder, true, true>(lds + RING_OFF, g, S, E);
    } SEAM(6);
    if (IN(8)) {
        bf16* const X1B = (bf16*)(ws + WS_X1B);
        pg8::Gemm g{(const bf16*)(ws + WS_MERGED), (const bf16*)(ws + WS_WO), M, D, D}; pg8::StaticOrder S; S.init(M, D, G, (int)blockIdx.x);
        pg8::EpiX1 E{(const float*)args.in[0], X1B, (float*)((unsigned*)ctl + CW_RSS), D};
        pg8::gemm_phase<pg8::EpiX1, pg8::StaticOrder, true, true>(lds + RING_OFF, g, S, E);
        const int gw = blockIdx.x * NWAVES + wave, NGW = G * NWAVES;
        v4u* padf = (v4u*)(X1B - 2 * D); v4u* padb = (v4u*)(X1B + (size_t)M * D);
        for (int i = gw * 64 + lane; i < 2 * D / 8; i += NGW * 64) padf[i] = (v4u){0u, 0u, 0u, 0u};
        for (int i = gw * 64 + lane; i < 128 * D / 8; i += NGW * 64) padb[i] = (v4u){0u, 0u, 0u, 0u};
    }
    if (IN(8)) {
        pg8::Gemm g{(const bf16*)(ws + WS_PB), (const bf16*)(ws + WS_WP), M, D, DPLE}; pg8::StaticOrder S; S.init(M, D, G, (int)blockIdx.x);
        pg8::EpiBf E{(bf16*)(ws + WS_PP), D};
        pg8::gemm_phase<pg8::EpiBf, pg8::StaticOrder, true, true>(lds + RING_OFF, g, S, E);
    } SEAM(8);
    if (IN(11)) {
        pg8::Gemm g{(const bf16*)(ws + WS_X1B) - 2 * D, (const bf16*)(ws + WS_WUP), 65 * 256, 2 * DFF, D, 0, 0, (size_t)254 * D * 2}; pg8::StaticOrder S; S.init(65 * 256, 2 * DFF, G, (int)blockIdx.x, GEMM_WGM);
        pg8::EpiFfn E{(bf16*)(ws + WS_ACT), (const float*)args.in[13], (LAS float*)(lds + RING_BYTES), M, DFF, (const float*)((const unsigned*)ctl + CW_RSS), 1.0f / D, RMS_EPS};
        pg8::gemm_phase<pg8::EpiFfn, pg8::StaticOrder, true, true>(lds + RING_OFF, g, S, E);
        p0_late_weights_queue(lds, args, ctl);
    } SEAM(11);
    if (IN(15)) {
        pg8::Gemm g{(const bf16*)(ws + WS_ACT), (const bf16*)(ws + WS_WDN), M, D, DFF}; pg8::StaticOrder S; S.init(M, D, G, (int)blockIdx.x, 4);
        pg8::EpiX2 E{(const bf16*)(ws + WS_X1B), XN, D};
        pg8::gemm_phase<pg8::EpiX2, pg8::StaticOrder, true, true>(lds + RING_OFF, g, S, E);
    } SEAM(15);
    if (IN(16)) {
        pg8::Gemm g{XN, (const bf16*)(ws + WS_WPG), M, D, D}; pg8::StaticOrder S; S.init(M, D, G, (int)blockIdx.x);
        pg8::EpiOut E{XN, (const bf16*)(ws + WS_PP), out, D};
        pg8::gemm_phase<pg8::EpiOut, pg8::StaticOrder, true, true>(lds + RING_OFF, g, S, E);
    }
#undef IN
#undef SEAM
}

extern "C" void kernel_launch(void* const* d_in, const int* in_sizes, int n_in, void* d_out, int out_size, void* d_ws, size_t ws_size, hipStream_t stream) {
    static int grid = 0;
    if (grid == 0) {
        if (n_in != 17 || in_sizes[0] != M * D || out_size != M * D || ws_size < WS_END) { fprintf(stderr, "kernel_launch: unexpected shapes / workspace (n_in %d, ws %zu, need %zu); nothing launched\n", n_in, ws_size, (size_t)WS_END); grid = -1; return; }
        int dev = 0, cus = 0, per_cu = 0;
        if (hipGetDevice(&dev) != hipSuccess || hipDeviceGetAttribute(&cus, hipDeviceAttributeMultiprocessorCount, dev) != hipSuccess) { grid = -1; return; }
        if (hipFuncSetAttribute((const void*)block_fwd, hipFuncAttributeMaxDynamicSharedMemorySize, LDS_BYTES) != hipSuccess) { fprintf(stderr, "kernel_launch: hipFuncSetAttribute failed\n"); grid = -1; return; }
        if (hipOccupancyMaxActiveBlocksPerMultiprocessor(&per_cu, (const void*)block_fwd, NWAVES * 64, LDS_BYTES) != hipSuccess || per_cu < 1) fprintf(stderr, "kernel_launch: occupancy query reports %d\n", per_cu);
        (void)hipGetLastError();
        grid = cus;
    }
    if (grid < 0) return;
    if (hipMemsetAsync((char*)d_ws + WS_CTL, 0, CTL_ZERO_BYTES, stream) != hipSuccess) return;
    Args a{};
    for (int i = 0; i < 17; ++i) a.in[i] = d_in[i];
    a.out = (float*)d_out; a.ws = (unsigned char*)d_ws; a.bar_off = 0;
#if MK_PER_PHASE
    for (int ph = 0; ph < NPH; ++ph) { a.ph_lo = ph; a.ph_hi = ph + 1; a.use_bar = 0; hipLaunchKernelGGL(block_fwd, dim3(grid), dim3(NWAVES * 64), LDS_BYTES, stream, a); }
#elif PROBE_PHASE >= 0
    a.ph_lo = 0; a.ph_hi = PROBE_PHASE + 1; a.use_bar = 1; a.bar_off = 0;
    hipLaunchKernelGGL(block_fwd, dim3(grid), dim3(NWAVES * 64), LDS_BYTES, stream, a);
    a.ph_lo = PROBE_PHASE; a.ph_hi = PROBE_PHASE + 1; a.use_bar = 0; a.flags = PROBE_FLAGS;
    hipLaunchKernelGGL(block_fwd, dim3(grid), dim3(NWAVES * 64), LDS_BYTES, stream, a);
    a.flags = 0;
    if (PROBE_PHASE + 1 < NPH) { a.ph_lo = PROBE_PHASE + 1; a.ph_hi = NPH; a.use_bar = 1; a.bar_off = XCD_BAR_WORDS;
        hipLaunchKernelGGL(block_fwd, dim3(grid), dim3(NWAVES * 64), LDS_BYTES, stream, a); }
#else
    a.ph_lo = 0; a.ph_hi = NPH; a.use_bar = 1;
    hipLaunchKernelGGL(block_fwd, dim3(grid), dim3(NWAVES * 64), LDS_BYTES, stream, a);
#endif
}
```

```cpp
#include <hip/hip_runtime.h>
#include <cstdio>
#include <cstdint>
#include <cmath>
namespace pg8 {
#define PG8_LAS __attribute__((address_space(3)))
typedef unsigned short bf16_t;
typedef short bf16x8 __attribute__((ext_vector_type(8)));
typedef float f32x4 __attribute__((ext_vector_type(4)));
typedef unsigned u32x4 __attribute__((ext_vector_type(4)));
constexpr int BM = 256, BK = 64, HALF = 128, HTB = HALF * BK * 2  , STAGE_BYTES = 8 * HTB, NXCD = 8, WGM = 8;

__host__ __device__ __forceinline__ int lds_byte(int r, int c) { const int st = (r >> 4) * 2 + (c >> 5), rr = r & 15, cc = c & 31, ob = rr * 64 + cc * 2; return st * 1024 + (ob ^ (((ob >> 9) & 1) << 5)); }
__host__ __device__ __forceinline__ void stage_rc(int b, int& R, int& C) { const int st = b / 1024, sb = b % 1024, swz = sb ^ (((sb >> 9) & 1) << 5); R = (st >> 1) * 16 + swz / 64; C = (st & 1) * 32 + (swz % 64) / 2; }
__host__ __device__ __forceinline__ int perm32(int rho) { const int n = rho >> 4, i = rho & 15; return 8 * (i >> 2) + 4 * n + (i & 3); }

struct Unit { int pm, pn, aux; };
struct Gemm { const bf16_t* A; const bf16_t* Bt; int M, N, K; size_t a_jump = 0, b_jump = 0, a_tstep = 0; };

struct StaticOrder {
    int nM, nN, nwg, G, c, wgm;
    __host__ __device__ void init(int M, int N, int G_, int c_, int wgm_ = WGM) { nM = M / BM; nN = N / BM; nwg = nM * nN; G = G_; c = c_; wgm = wgm_; }
    __host__ __device__ bool next(int i, Unit& u) const {
        const long L = (long)i * G + c; if (L >= nwg) return false;
        int wgid = (int)L; { const int q = nwg / NXCD, r = nwg % NXCD, xcd = wgid % NXCD, off = wgid / NXCD; wgid = (xcd < r ? xcd * (q + 1) : r * (q + 1) + (xcd - r) * q) + off; }
        const int nig = wgm * nN, gid = wgid / nig, fm = gid * wgm, gsz = (nM - fm) < wgm ? (nM - fm) : wgm;
        u.pm = fm + ((wgid % nig) % gsz); u.pn = (wgid % nig) / gsz; u.aux = 0; return true;
    }
    __device__ __forceinline__ void a_ready(const Unit&) const {}
    __device__ __forceinline__ void done(const Unit&) const {}
};

struct DualOrder {
    StaticOrder so;
    __host__ __device__ bool next(int i, Unit& u) const { if (!so.next(i >> 1, u)) return false; u.aux = i & 1; return true; }
    __device__ __forceinline__ void a_ready(const Unit&) const {}
    __device__ __forceinline__ void done(const Unit&) const {}
};

__device__ __forceinline__ unsigned cvt_pk_bf16(float lo, float hi) { unsigned r; asm volatile("s_nop 0\n\tv_cvt_pk_bf16_f32 %0, %1, %2" : "=v"(r) : "v"(lo), "v"(hi)); return r; }
typedef unsigned u32x2 __attribute__((ext_vector_type(2)));
__device__ __forceinline__ float bf_lo(unsigned w) { return __uint_as_float(w << 16); }
__device__ __forceinline__ float bf_hi(unsigned w) { return __uint_as_float(w & 0xffff0000u); }
__device__ __forceinline__ float sigm(float v) { return __builtin_amdgcn_rcpf(1.0f + __expf(-v)); }
__device__ __forceinline__ u32x4 pack8(const f32x4& v0, const f32x4& v1) { u32x4 w; w.x = cvt_pk_bf16(v0[0], v0[1]); w.y = cvt_pk_bf16(v0[2], v0[3]); w.z = cvt_pk_bf16(v1[0], v1[1]); w.w = cvt_pk_bf16(v1[2], v1[3]); return w; }

struct EpiZ {
    static constexpr bool PERM = true, AFTER_DRAIN = false, KEEP = false, APERM = false;
    bf16_t* Z; int M; int nostore;
    __device__ __forceinline__ void operator()(const f32x4 (&acc)[2][2][4][2], const Unit& u, int wr, int wc, int fr, int fq) const {
        const int row0 = u.pm * BM + wr * 64 + fr;
        if (u.pn < 48) {
            bf16_t* base = Z + (size_t)(u.pn >> 3) * ((size_t)M * 2048); const int col0 = (u.pn & 7) * 256 + wc * 32 + 8 * fq;
#pragma unroll
            for (int ai = 0; ai < 2; ++ai)
#pragma unroll
                for (int m = 0; m < 4; ++m) { bf16_t* rowp = base + (size_t)(row0 + ai * HALF + m * 16) * 2048 + col0;
#pragma unroll
                    for (int bj = 0; bj < 2; ++bj) *(u32x4*)(rowp + bj * HALF) = pack8(acc[ai][bj][m][0], acc[ai][bj][m][1]); }
        } else {
            bf16_t* GAb = Z + (size_t)6 * M * 2048; bf16_t* GCb = GAb + (size_t)M * 4096; const int col0 = (u.pn - 48) * 128 + wc * 32 + 8 * fq;
#pragma unroll
            for (int ai = 0; ai < 2; ++ai)
#pragma unroll
                for (int m = 0; m < 4; ++m) { const size_t o = (size_t)(row0 + ai * HALF + m * 16) * 4096 + col0;
                    f32x4 r0, r1, c0, c1;
#pragma unroll
                    for (int e = 0; e < 4; ++e) { c0[e] = fmaxf(sigm(acc[ai][1][m][0][e]), 1e-20f); c1[e] = fmaxf(sigm(acc[ai][1][m][1][e]), 1e-20f);
                        r0[e] = sigm(acc[ai][0][m][0][e]) * __builtin_amdgcn_rcpf(c0[e]); r1[e] = sigm(acc[ai][0][m][1][e]) * __builtin_amdgcn_rcpf(c1[e]); }
                    *(u32x4*)(GAb + o) = pack8(r0, r1); *(u32x4*)(GCb + o) = pack8(c0, c1); }
        }
    }
};
struct EpiBf {
    static constexpr bool PERM = true, AFTER_DRAIN = false, KEEP = false, APERM = false;
    bf16_t* O; int ldc;
    __device__ __forceinline__ void operator()(const f32x4 (&acc)[2][2][4][2], const Unit& u, int wr, int wc, int fr, int fq) const {
        const int row0 = u.pm * BM + wr * 64 + fr, col0 = u.pn * BM + wc * 32 + 8 * fq;
#pragma unroll
        for (int ai = 0; ai < 2; ++ai)
#pragma unroll
            for (int m = 0; m < 4; ++m) { bf16_t* rowp = O + (size_t)(row0 + ai * HALF + m * 16) * ldc + col0;
#pragma unroll
                for (int bj = 0; bj < 2; ++bj) *(u32x4*)(rowp + bj * HALF) = pack8(acc[ai][bj][m][0], acc[ai][bj][m][1]); }
    }
};
struct EpiDual {
    static constexpr bool PERM = true, AFTER_DRAIN = false, KEEP = true, APERM = false;
    const bf16_t* GA; const bf16_t* GC; bf16_t* O; int ldc;
    __device__ __forceinline__ void operator()(f32x4 (&acc)[2][2][4][2], const Unit& u, int wr, int wc, int fr, int fq) const {
        const int row0 = u.pm * BM + wr * 64 + fr, col0 = u.pn * BM + wc * 32 + 8 * fq;
        const bf16_t* src = u.aux == 0 ? GA : GC;
        u32x4 cq[2][4][2];
#pragma unroll
        for (int ai = 0; ai < 2; ++ai)
#pragma unroll
            for (int m = 0; m < 4; ++m)
#pragma unroll
                for (int bj = 0; bj < 2; ++bj) cq[ai][m][bj] = *(const u32x4*)(src + (size_t)(row0 + ai * HALF + m * 16) * ldc + col0 + bj * HALF);
        if (u.aux == 0) {
#pragma unroll
            for (int ai = 0; ai < 2; ++ai)
#pragma unroll
                for (int m = 0; m < 4; ++m)
#pragma unroll
                    for (int bj = 0; bj < 2; ++bj) { const u32x4 c = cq[ai][m][bj];
                        acc[ai][bj][m][0][0] *= bf_lo(c.x); acc[ai][bj][m][0][1] *= bf_hi(c.x); acc[ai][bj][m][0][2] *= bf_lo(c.y); acc[ai][bj][m][0][3] *= bf_hi(c.y);
                        acc[ai][bj][m][1][0] *= bf_lo(c.z); acc[ai][bj][m][1][1] *= bf_hi(c.z); acc[ai][bj][m][1][2] *= bf_lo(c.w); acc[ai][bj][m][1][3] *= bf_hi(c.w); }
        } else {
#pragma unroll
            for (int ai = 0; ai < 2; ++ai)
#pragma unroll
                for (int m = 0; m < 4; ++m)
#pragma unroll
                    for (int bj = 0; bj < 2; ++bj) { const size_t o = (size_t)(row0 + ai * HALF + m * 16) * ldc + col0 + bj * HALF; const u32x4 c = cq[ai][m][bj];
                        f32x4 v0 = acc[ai][bj][m][0], v1 = acc[ai][bj][m][1];
                        v0[0] *= bf_lo(c.x); v0[1] *= bf_hi(c.x); v0[2] *= bf_lo(c.y); v0[3] *= bf_hi(c.y); v1[0] *= bf_lo(c.z); v1[1] *= bf_hi(c.z); v1[2] *= bf_lo(c.w); v1[3] *= bf_hi(c.w);
                        *(u32x4*)(O + o) = pack8(v0, v1); }
        }
    }
};
#define DPP_F(OLD, SRC, CTRL) __builtin_bit_cast(float, __builtin_amdgcn_update_dpp(__builtin_bit_cast(int, (float)(OLD)), __builtin_bit_cast(int, (float)(SRC)), (CTRL), 0xf, 0xf, false))
struct EpiFfn {
    static constexpr bool PERM = true, AFTER_DRAIN = false, KEEP = false, APERM = true;
    bf16_t* ACT; const float* cw; PG8_LAS float* ex; int Mrows, DFFc; const float* rss; float inv_d, eps;
    __device__ __forceinline__ void operator()(f32x4 (&acc)[2][2][4][2], const Unit& u, int wr, int wc, int fr, int fq) const {
        const int wave = wr * 4 + wc;
#pragma unroll
        for (int ai = 0; ai < 2; ++ai)
#pragma unroll
            for (int m = 0; m < 4; ++m) { const int row = u.pm * 254 - 2 + ai * HALF + wr * 64 + 4 * fr + m;
                const int rc = row < 0 ? 0 : (row >= Mrows ? Mrows - 1 : row);
                const float rv = __builtin_amdgcn_rsqf(rss[rc] * inv_d + eps), rs = (row == rc) ? rv : 0.f;
#pragma unroll
                for (int bj = 0; bj < 2; ++bj)
#pragma unroll
                    for (int n = 0; n < 2; ++n) acc[ai][bj][m][n] *= rs; }
        if (fr == 15) {
#pragma unroll
            for (int ai = 0; ai < 2; ++ai)
#pragma unroll
                for (int bj = 0; bj < 2; ++bj)
#pragma unroll
                    for (int n = 0; n < 2; ++n)
#pragma unroll
                        for (int w = 0; w < 2; ++w) *(PG8_LAS f32x4*)(ex + ((((((wave * 2 + ai) * 2 + bj) * 2 + n) * 4 + fq) * 2 + w) << 2)) = acc[ai][bj][2 + w][n];
        }
        asm volatile("s_waitcnt lgkmcnt(0)" ::: "memory"); __builtin_amdgcn_s_barrier(); asm volatile("" ::: "memory");
        const int cg = u.pn * 128 + wc * 32 + 8 * fq;
        f32x4 wga[2][3], wva[2][3];
#pragma unroll
        for (int n = 0; n < 2; ++n)
#pragma unroll
            for (int j = 0; j < 3; ++j) { wga[n][j] = *(const f32x4*)(cw + (size_t)j * 2 * DFFc + cg + 4 * n); wva[n][j] = *(const f32x4*)(cw + (size_t)j * 2 * DFFc + DFFc + cg + 4 * n); }
#pragma unroll
        for (int n = 0; n < 2; ++n) {
            f32x4 wg[3], wv[3];
#pragma unroll
            for (int j = 0; j < 3; ++j) { wg[j] = wga[n][j]; wv[j] = wva[n][j]; }
#pragma unroll
            for (int ai = 0; ai < 2; ++ai) {
                const int sw = wr == 1 ? wave - 4 : wave + 4, sai = wr == 1 ? ai : 0; const bool has = (wr == 1) || (ai == 1);
                const int hb = (((((sw * 2 + sai) * 2 + 0) * 2 + n) * 4 + fq) * 2) << 2, hv = (((((sw * 2 + sai) * 2 + 1) * 2 + n) * 4 + fq) * 2) << 2;
                const f32x4 z4 = (f32x4){0.f, 0.f, 0.f, 0.f};
                const f32x4 g62 = has ? *(const PG8_LAS f32x4*)(ex + hb) : z4, g63 = has ? *(const PG8_LAS f32x4*)(ex + hb + 4) : z4;
                const f32x4 v62 = has ? *(const PG8_LAS f32x4*)(ex + hv) : z4, v63 = has ? *(const PG8_LAS f32x4*)(ex + hv + 4) : z4;
                f32x4 gp3, gp2, vp3, vp2;
#pragma unroll
                for (int e = 0; e < 4; ++e) { gp3[e] = DPP_F(g63[e], acc[ai][0][3][n][e], 0x111); gp2[e] = DPP_F(g62[e], acc[ai][0][2][n][e], 0x111);
                                              vp3[e] = DPP_F(v63[e], acc[ai][1][3][n][e], 0x111); vp2[e] = DPP_F(v62[e], acc[ai][1][2][n][e], 0x111); }
#pragma unroll
                for (int m = 0; m < 4; ++m) {
                    const int rl = ai * HALF + wr * 64 + 4 * fr + m, row = u.pm * 254 - 2 + rl;
                    const f32x4 g0 = acc[ai][0][m][n], v0 = acc[ai][1][m][n];
                    const f32x4 g1 = m == 0 ? gp3 : acc[ai][0][m > 0 ? m - 1 : 0][n], g2 = m == 0 ? gp2 : (m == 1 ? gp3 : acc[ai][0][m > 1 ? m - 2 : 0][n]);
                    const f32x4 v1 = m == 0 ? vp3 : acc[ai][1][m > 0 ? m - 1 : 0][n], v2 = m == 0 ? vp2 : (m == 1 ? vp3 : acc[ai][1][m > 1 ? m - 2 : 0][n]);
                    f32x4 ov;
#pragma unroll
                    for (int e = 0; e < 4; ++e) {
                        const float ug = wg[2][e] * g0[e] + wg[1][e] * g1[e] + wg[0][e] * g2[e], uv = wv[2][e] * v0[e] + wv[1][e] * v1[e] + wv[0][e] * v2[e];
                        ov[e] = ug * __builtin_amdgcn_rcpf(1.0f + __expf(-ug)) * uv;
                    }
                    const int rowc = (rl >= 2 && row < Mrows) ? row : Mrows;
                    { u32x2 w; w.x = cvt_pk_bf16(ov[0], ov[1]); w.y = cvt_pk_bf16(ov[2], ov[3]); *(u32x2*)(ACT + (size_t)rowc * DFFc + cg + 4 * n) = w; }
                }
            }
        }
    }
};
struct EpiX1 {
    static constexpr bool PERM = true, AFTER_DRAIN = false, KEEP = false, APERM = false;
    const float* X; bf16_t* X1B; float* rss; int ldc;
    __device__ __forceinline__ void operator()(f32x4 (&acc)[2][2][4][2], const Unit& u, int wr, int wc, int fr, int fq) const {
        const int row0 = u.pm * BM + wr * 64 + fr, col0 = u.pn * BM + wc * 32 + 8 * fq;
#pragma unroll
        for (int ai = 0; ai < 2; ++ai) {
            f32x4 xq[4][2][2];
#pragma unroll
            for (int m = 0; m < 4; ++m)
#pragma unroll
                for (int bj = 0; bj < 2; ++bj) { const size_t o = (size_t)(row0 + ai * HALF + m * 16) * ldc + col0 + bj * HALF; xq[m][bj][0] = *(const f32x4*)(X + o); xq[m][bj][1] = *(const f32x4*)(X + o + 4); }
#pragma unroll
            for (int m = 0; m < 4; ++m) { const int row = row0 + ai * HALF + m * 16; const size_t ro = (size_t)row * ldc + col0; float ss = 0.f;
#pragma unroll
                for (int bj = 0; bj < 2; ++bj) { const size_t o = ro + bj * HALF;
                    const f32x4 v0 = xq[m][bj][0] + acc[ai][bj][m][0], v1 = xq[m][bj][1] + acc[ai][bj][m][1];
                    ss += (v0[0] * v0[0] + v0[1] * v0[1]) + (v0[2] * v0[2] + v0[3] * v0[3]) + (v1[0] * v1[0] + v1[1] * v1[1]) + (v1[2] * v1[2] + v1[3] * v1[3]);
                    *(u32x4*)(X1B + o) = pack8(v0, v1); }
                ss += __shfl_xor(ss, 16); ss += __shfl_xor(ss, 32);
                if (fq == 0) unsafeAtomicAdd(rss + row, ss); }
        }
    }
};
struct EpiX2 {
    static constexpr bool PERM = true, AFTER_DRAIN = false, KEEP = false, APERM = false;
    const bf16_t* X1B; bf16_t* XN; int ldc;
    __device__ __forceinline__ void operator()(f32x4 (&acc)[2][2][4][2], const Unit& u, int wr, int wc, int fr, int fq) const {
        const int row0 = u.pm * BM + wr * 64 + fr, col0 = u.pn * BM + wc * 32 + 8 * fq;
        u32x4 tq[2][4][2];
#pragma unroll
        for (int ai = 0; ai < 2; ++ai)
#pragma unroll
            for (int m = 0; m < 4; ++m)
#pragma unroll
                for (int bj = 0; bj < 2; ++bj) tq[ai][m][bj] = *(const u32x4*)(X1B + (size_t)(row0 + ai * HALF + m * 16) * ldc + col0 + bj * HALF);
#pragma unroll
        for (int ai = 0; ai < 2; ++ai)
#pragma unroll
            for (int m = 0; m < 4; ++m)
#pragma unroll
                for (int bj = 0; bj < 2; ++bj) { const size_t o = (size_t)(row0 + ai * HALF + m * 16) * ldc + col0 + bj * HALF; const u32x4 t = tq[ai][m][bj];
                    f32x4 v0 = acc[ai][bj][m][0], v1 = acc[ai][bj][m][1];
                    v0[0] += bf_lo(t.x); v0[1] += bf_hi(t.x); v0[2] += bf_lo(t.y); v0[3] += bf_hi(t.y); v1[0] += bf_lo(t.z); v1[1] += bf_hi(t.z); v1[2] += bf_lo(t.w); v1[3] += bf_hi(t.w);
                    *(u32x4*)(XN + o) = pack8(v0, v1); }
    }
};
struct EpiOut {
    static constexpr bool PERM = true, AFTER_DRAIN = false, KEEP = false, APERM = false;
    const bf16_t* XN; const bf16_t* PP; float* out; int ldc;
    __device__ __forceinline__ void operator()(f32x4 (&acc)[2][2][4][2], const Unit& u, int wr, int wc, int fr, int fq) const {
        const int row0 = u.pm * BM + wr * 64 + fr, col0 = u.pn * BM + wc * 32 + 8 * fq;
#pragma unroll
        for (int ai = 0; ai < 2; ++ai) {
            u32x4 tq[4][2], pq[4][2];
#pragma unroll
            for (int m = 0; m < 4; ++m)
#pragma unroll
                for (int bj = 0; bj < 2; ++bj) { const size_t o = (size_t)(row0 + ai * HALF + m * 16) * ldc + col0 + bj * HALF; tq[m][bj] = *(const u32x4*)(XN + o); pq[m][bj] = *(const u32x4*)(PP + o); }
#pragma unroll
            for (int m = 0; m < 4; ++m)
#pragma unroll
                for (int bj = 0; bj < 2; ++bj) { const size_t o = (size_t)(row0 + ai * HALF + m * 16) * ldc + col0 + bj * HALF; const u32x4 t = tq[m][bj], p = pq[m][bj];
                    const f32x4 a0 = acc[ai][bj][m][0], a1 = acc[ai][bj][m][1]; f32x4 v0, v1;
                    v0[0] = bf_lo(t.x) + sigm(a0[0]) * bf_lo(p.x); v0[1] = bf_hi(t.x) + sigm(a0[1]) * bf_hi(p.x); v0[2] = bf_lo(t.y) + sigm(a0[2]) * bf_lo(p.y); v0[3] = bf_hi(t.y) + sigm(a0[3]) * bf_hi(p.y);
                    v1[0] = bf_lo(t.z) + sigm(a1[0]) * bf_lo(p.z); v1[1] = bf_hi(t.z) + sigm(a1[1]) * bf_hi(p.z); v1[2] = bf_lo(t.w) + sigm(a1[2]) * bf_lo(p.w); v1[3] = bf_hi(t.w) + sigm(a1[3]) * bf_hi(p.w);
                    *(f32x4*)(out + o) = v0; *(f32x4*)(out + o + 4) = v1; }
        }
    }
};

template <class Epi, class Sched, bool ALIGN_EPI = false, bool SP2 = false>
__device__ __forceinline__ void gemm_phase(PG8_LAS unsigned char* lds, const Gemm g, const Sched& S, const Epi& E) {
    const int tid = threadIdx.x, wid = __builtin_amdgcn_readfirstlane(tid >> 6), lane = tid & 63, wr = wid >> 2, wc = wid & 3, fr = lane & 15, fq = lane >> 4;
    const int K = g.K, nt = K / BK;
    unsigned voffA[2], voffB[2];
#pragma unroll
    for (int i = 0; i < 2; ++i) { int R, C; stage_rc(tid * 16 + i * 8192, R, C); const int Rb = Epi::PERM ? ((R & ~31) + perm32(R & 31)) : R;
        const int Ra = Epi::APERM ? ((R & ~63) + 4 * (R & 15) + ((R & 63) >> 4)) : R;
        voffA[i] = (unsigned)(Ra * K + C) * 2u; voffB[i] = (unsigned)(Rb * K + C) * 2u; }
    const size_t kstep = (size_t)(BK * 2);
    const size_t hstep = (size_t)HALF * K * 2;
    const size_t tstep = 2 * hstep; const size_t atstep = g.a_tstep ? g.a_tstep : tstep;
    const unsigned ldsw = (unsigned)wid * 1024u;
    const int aoff = lds_byte(wr * 64 + fr, fq * 8), boff = lds_byte(wc * 32 + fr, fq * 8);
#define PG8_SA(b, h) (((b) * 2 + (h)) * HTB)
#define PG8_SB(b, h) ((4 + (b) * 2 + (h)) * HTB)
#define PG8_STAGE(bufoff, gbase, voff) do { _Pragma("unroll") for (int _i = 0; _i < 2; ++_i) \
        __builtin_amdgcn_global_load_lds((const unsigned*)((const char*)(gbase) + (voff)[_i]), (PG8_LAS unsigned*)(lds + (bufoff) + ldsw + _i * 8192), 16, 0, 0); } while (0)
#define PG8_LDA(dst, b, h) do { _Pragma("unroll") for (int m = 0; m < 4; ++m) _Pragma("unroll") for (int k = 0; k < 2; ++k) dst[m][k] = *(const PG8_LAS bf16x8*)(lds + PG8_SA(b, h) + aoff + m * 2048 + k * 1024); } while (0)
#define PG8_LDB(dst, b, h) do { _Pragma("unroll") for (int n = 0; n < 2; ++n) _Pragma("unroll") for (int k = 0; k < 2; ++k) dst[n][k] = *(const PG8_LAS bf16x8*)(lds + PG8_SB(b, h) + boff + n * 2048 + k * 1024); } while (0)
#define PG8_MMA(ai, bj, At, Bt) do { __builtin_amdgcn_s_setprio(1); _Pragma("unroll") for (int m = 0; m < 4; ++m) _Pragma("unroll") for (int n = 0; n < 2; ++n) _Pragma("unroll") for (int k = 0; k < 2; ++k) \
        acc[ai][bj][m][n] = __builtin_amdgcn_mfma_f32_16x16x32_bf16(Bt[n][k], At[m][k], acc[ai][bj][m][n], 0, 0, 0); __builtin_amdgcn_s_setprio(0); } while (0)
#define PG8_WAIT_V(n) asm volatile("s_waitcnt vmcnt(" #n ")" ::: "memory")
#define PG8_WAIT_L(n) asm volatile("s_waitcnt lgkmcnt(" #n ")" ::: "memory")
#define PG8_BAR __builtin_amdgcn_s_barrier()
#define PG8_SCHED __builtin_amdgcn_sched_barrier(0)
    Unit cur, nxt; int ui = 0;
    if (!S.next(0, cur)) return;
    f32x4 acc[2][2][4][2];
#pragma unroll
    for (int a = 0; a < 2; ++a)
#pragma unroll
        for (int b = 0; b < 2; ++b)
#pragma unroll
            for (int m = 0; m < 4; ++m)
#pragma unroll
                for (int n = 0; n < 2; ++n) acc[a][b][m][n] = (f32x4){0.f, 0.f, 0.f, 0.f};
    bf16x8 At[4][2], B0[2][2], B1[2][2];
    const char* cA = (const char*)g.A + (size_t)cur.pm * atstep + (cur.aux ? g.a_jump : 0); const char* cB = (const char*)g.Bt + (size_t)cur.pn * tstep + (cur.aux ? g.b_jump : 0);
    S.a_ready(cur);
    if constexpr (SP2) {
        PG8_STAGE(PG8_SB(0, 0), cB, voffB); PG8_STAGE(PG8_SB(0, 1), cB + hstep, voffB); PG8_STAGE(PG8_SA(0, 0), cA, voffA); PG8_STAGE(PG8_SA(0, 1), cA + hstep, voffA);
        if (wr == 1) PG8_BAR;
        PG8_WAIT_V(2); PG8_BAR;
        PG8_STAGE(PG8_SB(1, 0), cB + kstep, voffB); PG8_STAGE(PG8_SA(1, 0), cA + kstep, voffA); PG8_STAGE(PG8_SB(1, 1), cB + hstep + kstep, voffB);
        PG8_WAIT_V(6); PG8_BAR;
    } else {
        PG8_STAGE(PG8_SB(0, 0), cB, voffB); PG8_STAGE(PG8_SA(0, 0), cA, voffA); PG8_STAGE(PG8_SB(0, 1), cB + hstep, voffB); PG8_STAGE(PG8_SA(0, 1), cA + hstep, voffA);
        if (wr == 1) PG8_BAR;
        PG8_WAIT_V(4); PG8_BAR;
        PG8_STAGE(PG8_SB(1, 0), cB + kstep, voffB); PG8_STAGE(PG8_SA(1, 0), cA + kstep, voffA); PG8_STAGE(PG8_SB(1, 1), cB + hstep + kstep, voffB);
        PG8_WAIT_V(6); PG8_BAR;
    }
    for (;;) {
        const bool has_next = S.next(ui + 1, nxt);
        const char* nA = has_next ? (const char*)g.A + (size_t)nxt.pm * atstep + (nxt.aux ? g.a_jump : 0) : cA; const char* nB = has_next ? (const char*)g.Bt + (size_t)nxt.pn * tstep + (nxt.aux ? g.b_jump : 0) : cB;
        for (int t = 0; t < nt; t += 2) {
            const bool last = (t == nt - 2);
            const char* a1 = cA + (size_t)(t + 1) * kstep;
            const char* a2 = last ? nA : cA + (size_t)(t + 2) * kstep; const char* b2 = last ? nB : cB + (size_t)(t + 2) * kstep;
            const char* a3 = a2 + kstep; const char* b3 = b2 + kstep;
            if (last && has_next) S.a_ready(nxt);
            if constexpr (SP2) {
            PG8_LDB(B0, 0, 0); PG8_LDB(B1, 0, 1); PG8_SCHED; PG8_LDA(At, 0, 0); PG8_STAGE(PG8_SA(1, 1), a1 + hstep, voffA);
            PG8_WAIT_V(8); PG8_WAIT_L(0); PG8_BAR; PG8_MMA(0, 0, At, B0); PG8_MMA(0, 1, At, B1); PG8_BAR; PG8_SCHED;
            PG8_LDA(At, 0, 1); PG8_STAGE(PG8_SB(0, 0), b2, voffB); PG8_STAGE(PG8_SB(0, 1), b2 + hstep, voffB); PG8_STAGE(PG8_SA(0, 0), a2, voffA);
            PG8_WAIT_V(8); PG8_WAIT_L(0); PG8_BAR; PG8_MMA(1, 0, At, B0); PG8_MMA(1, 1, At, B1); PG8_BAR; PG8_SCHED;
            PG8_LDB(B0, 1, 0); PG8_LDB(B1, 1, 1); PG8_SCHED; PG8_LDA(At, 1, 0); PG8_STAGE(PG8_SA(0, 1), a2 + hstep, voffA);
            PG8_WAIT_V(8); PG8_WAIT_L(0); PG8_BAR; PG8_MMA(0, 0, At, B0); PG8_MMA(0, 1, At, B1); PG8_BAR; PG8_SCHED;
            PG8_LDA(At, 1, 1); PG8_STAGE(PG8_SB(1, 0), b3, voffB); PG8_STAGE(PG8_SB(1, 1), b3 + hstep, voffB); PG8_STAGE(PG8_SA(1, 0), a3, voffA);
            PG8_WAIT_V(8); PG8_WAIT_L(0); PG8_BAR; PG8_MMA(1, 0, At, B0); PG8_MMA(1, 1, At, B1); PG8_BAR; PG8_SCHED;
            } else {
            PG8_LDB(B0, 0, 0); PG8_SCHED; PG8_LDA(At, 0, 0); PG8_STAGE(PG8_SA(1, 1), a1 + hstep, voffA);
            PG8_WAIT_L(8); PG8_BAR; PG8_WAIT_L(0); PG8_MMA(0, 0, At, B0); PG8_BAR; PG8_SCHED;
            PG8_LDB(B1, 0, 1); PG8_STAGE(PG8_SB(0, 0), b2, voffB);
            PG8_BAR; PG8_WAIT_L(0); PG8_MMA(0, 1, At, B1); PG8_BAR;
            PG8_LDA(At, 0, 1); PG8_STAGE(PG8_SA(0, 0), a2, voffA);
            PG8_BAR; PG8_WAIT_L(0); PG8_MMA(1, 0, At, B0); PG8_BAR; PG8_SCHED;
            PG8_STAGE(PG8_SB(0, 1), b2 + hstep, voffB);
            PG8_WAIT_V(6); PG8_BAR; PG8_MMA(1, 1, At, B1); PG8_BAR;
            PG8_LDB(B0, 1, 0); PG8_SCHED; PG8_LDA(At, 1, 0); PG8_STAGE(PG8_SA(0, 1), a2 + hstep, voffA);
            PG8_WAIT_L(8); PG8_BAR; PG8_WAIT_L(0); PG8_MMA(0, 0, At, B0); PG8_BAR; PG8_SCHED;
            PG8_LDB(B1, 1, 1); PG8_STAGE(PG8_SB(1, 0), b3, voffB);
            PG8_BAR; PG8_WAIT_L(0); PG8_MMA(0, 1, At, B1); PG8_BAR;
            PG8_LDA(At, 1, 1); PG8_STAGE(PG8_SA(1, 0), a3, voffA);
            PG8_BAR; PG8_WAIT_L(0); PG8_MMA(1, 0, At, B0); PG8_BAR; PG8_SCHED;
            PG8_STAGE(PG8_SB(1, 1), b3 + hstep, voffB);
            PG8_WAIT_V(6); PG8_BAR; PG8_MMA(1, 1, At, B1); PG8_BAR;
            }
        }
        if constexpr (ALIGN_EPI) { if (wr == 0) PG8_BAR; }
        asm volatile("s_nop 15\n\ts_nop 7" ::: "memory");
        if constexpr (!Epi::AFTER_DRAIN) { E(acc, cur, wr, wc, fr, fq); S.done(cur); }
        if (!has_next) break;
        if (!Epi::KEEP || cur.aux != 0) {
#pragma unroll
        for (int a = 0; a < 2; ++a)
#pragma unroll
            for (int b = 0; b < 2; ++b)
#pragma unroll
                for (int m = 0; m < 4; ++m)
#pragma unroll
                    for (int n = 0; n < 2; ++n) acc[a][b][m][n] = (f32x4){0.f, 0.f, 0.f, 0.f};
        }
        cur = nxt; cA = nA; cB = nB; ++ui;
        if constexpr (ALIGN_EPI) { if (wr == 1) PG8_BAR; }
    }
    PG8_WAIT_V(0);
    if constexpr (!ALIGN_EPI) { if (wr == 0) PG8_BAR; }
    PG8_BAR;
    if constexpr (Epi::AFTER_DRAIN) { E.fused(acc, cur, wr, wc, fr, fq, lds, wid, lane); S.done(cur); }
#undef PG8_SA
#undef PG8_SB
#undef PG8_STAGE
#undef PG8_LDA
#undef PG8_LDB
#undef PG8_MMA
#undef PG8_WAIT_V
#undef PG8_WAIT_L
#undef PG8_BAR
#undef PG8_SCHED
}
}
#define GAS __attribute__((address_space(1)))
#define LAS __attribute__((address_space(3)))
typedef unsigned short bf16;
typedef unsigned v4u __attribute__((ext_vector_type(4)));
typedef float f32x4 __attribute__((ext_vector_type(4)));
typedef short bf16x8 __attribute__((ext_vector_type(8)));
typedef GAS unsigned gu32;
typedef GAS unsigned long long gu64;
#define RLX_AGENT __ATOMIC_RELAXED, __HIP_MEMORY_SCOPE_AGENT
#define LDS_WAIT() asm volatile("s_waitcnt lgkmcnt(0)" ::: "memory")
#define VM_WAIT() asm volatile("s_waitcnt vmcnt(0)" ::: "memory")
__device__ __forceinline__ unsigned long long rt() { return __builtin_amdgcn_s_memrealtime(); }
__device__ __forceinline__ unsigned f2bf(float f) { unsigned u = __builtin_bit_cast(unsigned, f); return (u + 0x7fffu + ((u >> 16) & 1u)) >> 16; }
typedef float pk2_f32x2 __attribute__((ext_vector_type(2))); typedef __bf16 pk2_bf16x2 __attribute__((ext_vector_type(2)));
__device__ __forceinline__ unsigned pk2(float lo, float hi) { pk2_f32x2 v = {lo, hi}; pk2_bf16x2 b = __builtin_convertvector(v, pk2_bf16x2); return __builtin_bit_cast(unsigned, b); }

#define XB_TMO      128
#define XB_XCNT(j)  (256  + 64 * (j))
#define XB_XSUB(j)  (1280 + 64 * (j))
#define XB_XGEN(j)  (2304 + 64 * (j))
#define XB_TOP      3328
#define XB_TOPGEN   3392
#define XCD_BAR_WORDS 3456
#define XB_SPIN_CAP (1u << 18)

__device__ __forceinline__ unsigned xb_ld(unsigned* p)              { return __hip_atomic_load(p, __ATOMIC_RELAXED, __HIP_MEMORY_SCOPE_AGENT); }
__device__ __forceinline__ unsigned xb_add(unsigned* p, unsigned v) { return __hip_atomic_fetch_add(p, v, __ATOMIC_RELAXED, __HIP_MEMORY_SCOPE_AGENT); }
__device__ __forceinline__ unsigned xb_xcc_id() { return (unsigned)__builtin_amdgcn_s_getreg((3 << 11) | 20) & 0xFu; }
#define XB_SPIN(cond, bar) do { unsigned _sp = 0; while (cond) { __builtin_amdgcn_s_sleep(1); \
    if ((++_sp & 255u) == 0u) { if (xb_ld(&(bar)[XB_TMO])) break; if (_sp > XB_SPIN_CAP) { atomicAdd(&(bar)[XB_TMO], 1u); break; } } } } while (0)

struct XcdBarrier {
    unsigned* bar; unsigned x;
    volatile LAS unsigned* st;
};

__device__ __forceinline__ XcdBarrier xcd_barrier_post(unsigned* bar, volatile LAS unsigned* st) {
    XcdBarrier b; b.bar = bar; b.x = xb_xcc_id(); b.st = st;
    if (threadIdx.x == 0) (void)xb_add(&bar[XB_XCNT(b.x)], 1u);
    return b;
}
__device__ __forceinline__ void xcd_barrier_complete(unsigned* bar, unsigned x, unsigned& nloc, unsigned& nx) {
    const unsigned G = gridDim.x * gridDim.y * gridDim.z;
    unsigned sum, cnt, mine, sp = 0u;
    for (;;) {
        sum = 0u; cnt = 0u; mine = 0u;
#pragma unroll
        for (unsigned j = 0; j < 16; ++j) { const unsigned c = xb_ld(&bar[XB_XCNT(j)]); sum += c; cnt += (c > 0u) ? 1u : 0u; mine = (j == x) ? c : mine; }
        if (sum == G) break;
        __builtin_amdgcn_s_sleep(1);
        if ((++sp & 255u) == 0u) { if (xb_ld(&bar[XB_TMO])) break; if (sp > XB_SPIN_CAP) { atomicAdd(&bar[XB_TMO], 1u); break; } }
    }
    nloc = mine > 0u ? mine : 1u; nx = cnt > 0u ? cnt : 1u;
}

__device__ __forceinline__ void xcd_barrier(const XcdBarrier& b) {
    asm volatile("s_waitcnt vmcnt(0)" ::: "memory");
    __syncthreads();
    if (threadIdx.x == 0) {
        unsigned* bar = b.bar;
        __builtin_amdgcn_s_waitcnt(0);
        unsigned nloc = b.st[0], nx = b.st[1];
        if (nloc == 0u) { xcd_barrier_complete(bar, b.x, nloc, nx); b.st[0] = nloc; b.st[1] = nx; }
        const unsigned old = xb_add(&bar[XB_XSUB(b.x)], 1u);
        const unsigned gen = old / nloc;
        if (old + 1u == (gen + 1u) * nloc) {
            __builtin_amdgcn_fence(__ATOMIC_RELEASE, "agent");
            asm volatile("s_waitcnt vmcnt(0)" ::: "memory");
            const unsigned og = xb_add(&bar[XB_TOP], 1u);
            const unsigned tg = og / nx;
            if (og + 1u == (tg + 1u) * nx) xb_add(&bar[XB_TOPGEN], 1u);
            else XB_SPIN(xb_ld(&bar[XB_TOPGEN]) == tg, bar);
            __builtin_amdgcn_fence(__ATOMIC_ACQUIRE, "agent");
            xb_add(&bar[XB_XGEN(b.x)], 1u);
            asm volatile("s_waitcnt vmcnt(0)" ::: "memory");
        } else {
            XB_SPIN(xb_ld(&bar[XB_XGEN(b.x)]) == gen, bar);
            __builtin_amdgcn_fence(__ATOMIC_ACQUIRE, "agent");
            asm volatile("s_waitcnt vmcnt(0)" ::: "memory");
        }
    }
    __syncthreads();
}

constexpr int NWAVES = 8;
constexpr int M = 16384, D = 4096, DIN = 20480, DA = 2048, NH = 16, HD = 128, DFF = 11008, DFH = 5504, DPLE = 256, NBLK = 64, BLK = 256;
constexpr float RMS_EPS = 1e-6f;
constexpr float ATT_SCALE = 0.08838834764831845f;
#ifndef MK_PER_PHASE
#define MK_PER_PHASE 0
#endif
#ifndef PROBE_PHASE
#define PROBE_PHASE -1
#endif
#ifndef PROBE_FLAGS
#define PROBE_FLAGS 0
#endif
constexpr int NPH = 17;
#ifndef GEMM_WGM
#define GEMM_WGM 4
#endif

constexpr size_t MiB = 1u << 20;
constexpr size_t WS_CTL = 0, CTL_ZERO_BYTES = 1 * MiB;
constexpr size_t WS_KMH = 1 * MiB, WS_KML = 1 * MiB + 256 * 1024;
constexpr size_t WS_LSE = 2 * MiB;
constexpr size_t WS_PB = 8 * MiB;
constexpr size_t WS_WUP = 16 * MiB, WS_WDN = 188 * MiB, WS_WPG = 274 * MiB, WS_WP = 306 * MiB;
constexpr size_t WS_XN = 309 * MiB;
constexpr size_t WS_WO = 438 * MiB, WS_WA = 470 * MiB, WS_WC = 486 * MiB, WS_WIN = 502 * MiB;
constexpr size_t WS_Z = 662 * MiB;
constexpr size_t WS_Q = WS_Z, WS_K = WS_Z + 64 * MiB, WS_V = WS_Z + 128 * MiB, WS_CB = WS_Z + 192 * MiB, WS_CC = WS_Z + 256 * MiB, WS_CX = WS_Z + 320 * MiB, WS_GA = WS_Z + 384 * MiB, WS_GC = WS_Z + 512 * MiB;
constexpr size_t WS_LIST = 1302 * MiB;
constexpr size_t WS_TAB = 1336 * MiB;
constexpr size_t WS_END = 1344 * MiB;
constexpr size_t WS_S0 = WS_XN, WS_S1 = WS_XN + 64 * MiB, WS_S2 = WS_CC;
constexpr size_t WS_T1 = WS_XN, WS_MERGED = WS_K, WS_PP = WS_GC, WS_Y = 438 * MiB, WS_ACT = 782 * MiB;
constexpr size_t WS_X1B = 502 * MiB;
static_assert(WS_Y + (size_t)M * DFF * 2 <= WS_ACT && WS_ACT + (size_t)(M + 1) * DFF * 2 <= WS_PP && WS_LIST + (size_t)16 * 516096 * 4 <= WS_TAB && WS_GC + 128 * MiB == WS_LIST, "d_ws map");
constexpr int CW_TMO = 0, CW_CODE = 1, CW_QHEAD = 64, CW_BAR = 4096, CW_CNT = 16384, CW_RSS = 32768;
constexpr int LIST_PER_HEAD = 516096;
__host__ __device__ __forceinline__ int list_base(int h, int j) { return h * LIST_PER_HEAD + 256 * (63 * j - (j * (j - 1)) / 2); }

constexpr int RING_OFF = 0, RING_BYTES = 131072;
constexpr int MISC_OFF = 153600;
constexpr int LDS_BYTES = 155648;

struct Args { const void* in[17]; float* out; unsigned char* ws; int ph_lo, ph_hi, use_bar, bar_off, flags, pad; };

__device__ __forceinline__ float wave_sum(float v) {
#pragma unroll
    for (int o = 1; o < 64; o <<= 1) v += __shfl_xor(v, o);
    return v;
}
__device__ __forceinline__ float wave_max(float v) {
#pragma unroll
    for (int o = 1; o < 64; o <<= 1) v = fmaxf(v, __shfl_xor(v, o));
    return v;
}
__device__ __forceinline__ float bflo(unsigned w) { return __uint_as_float(w << 16); }
__device__ __forceinline__ float bfhi(unsigned w) { return __uint_as_float(w & 0xffff0000u); }

template <int RM> __device__ __forceinline__ int rowmap(int n) {
    if (RM == 0) return n;
    if (RM == 2) {
        if (n < 6 * DA) return n;
        const int g = n - 6 * DA; return g < D ? 6 * DA + (g >> 7) * 256 + (g & 127) : 6 * DA + ((g - D) >> 7) * 256 + 128 + ((g - D) & 127);
    }
    if (n < DFF) return (n >> 7) * 256 + (n & 127);
    const int n2 = n - DFF; return (n2 >> 7) * 256 + 128 + (n2 & 127);
}
template <int RM> __device__ __forceinline__ void p0_transpose_item(const float* W, int K, int N, bf16* WT, LAS float* scrf, int item, int lane, const float* kscale = nullptr) {
    LAS unsigned* scr = (LAS unsigned*)scrf;
    const int nblk = N / 64, kb = item / nblk, nb = item % nblk, k0 = 64 * kb, n0 = 64 * nb;
    const float* src = W + (size_t)k0 * N + n0 + lane;
    float v[64];
#pragma unroll
    for (int i = 0; i < 64; ++i) v[i] = __builtin_nontemporal_load(src + (size_t)i * N);
    if (kscale) {
#pragma unroll
        for (int i = 0; i < 64; ++i) v[i] *= kscale[k0 + i]; }
#pragma unroll
    for (int i = 0; i < 32; ++i) scr[i * 65 + lane] = pk2(v[2 * i], v[2 * i + 1]);
    LDS_WAIT(); asm volatile("" ::: "memory");
    const int c = lane & 7, nl = lane >> 3;
#pragma unroll
    for (int j = 0; j < 8; ++j) { const int n = nl + 8 * j; const LAS unsigned* s = scr + (4 * c) * 65 + n;
        v4u o; o.x = s[0 * 65]; o.y = s[1 * 65]; o.z = s[2 * 65]; o.w = s[3 * 65];
        *(v4u*)(WT + (size_t)rowmap<RM>(n0 + n) * K + k0 + 8 * c) = o; }
    LDS_WAIT(); asm volatile("" ::: "memory");
}
__device__ __forceinline__ void rms_row_to_bf16(const float* xrow, const f32x4 (&gv)[16], bf16* orow, int lane) {
    const f32x4* xr = (const f32x4*)xrow + lane;
    f32x4 v[16]; float s = 0.f;
#pragma unroll
    for (int j = 0; j < 16; ++j) { v[j] = __builtin_nontemporal_load(xr + 64 * j); s += (v[j].x * v[j].x + v[j].y * v[j].y) + (v[j].z * v[j].z + v[j].w * v[j].w); }
    const float r = 1.0f / sqrtf(wave_sum(s) * (1.f / D) + RMS_EPS);
    unsigned long long* o8 = (unsigned long long*)orow + lane;
#pragma unroll
    for (int j = 0; j < 16; ++j)
        o8[64 * j] = (unsigned long long)pk2(v[j].x * r * gv[j].x, v[j].y * r * gv[j].y) | ((unsigned long long)pk2(v[j].z * r * gv[j].z, v[j].w * r * gv[j].w) << 32);
}

__device__ __forceinline__ void p0_weights(LAS unsigned char* lds, const Args& a, int wave, int lane, int gw, int NGW, int part) {
    unsigned char* ws = a.ws;
    LAS float* scr = (LAS float*)lds + wave * (64 * 65);
    constexpr int I_IN = (D / 64) * (DIN / 64), I_A = (DA / 64) * (D / 64), I_O = (D / 64) * (D / 64), I_UP = (D / 64) * (2 * DFF / 64), I_DN = (DFF / 64) * (D / 64), I_P = (DPLE / 64) * (D / 64);
    if (part == 0) {
        for (int it = gw; it < I_IN + I_UP + 2 * I_A + I_O + I_P; it += NGW) {
            int r = it;
            if (r < I_IN) { p0_transpose_item<2>((const float*)a.in[4], D, DIN, (bf16*)(ws + WS_WIN), scr, r, lane); continue; } r -= I_IN;
            if (r < I_UP) { p0_transpose_item<1>((const float*)a.in[12], D, 2 * DFF, (bf16*)(ws + WS_WUP), scr, r, lane, (const float*)a.in[11]); continue; } r -= I_UP;
            if (r < I_A) { p0_transpose_item<0>((const float*)a.in[8], DA, D, (bf16*)(ws + WS_WA), scr, r, lane); continue; } r -= I_A;
            if (r < I_A) { p0_transpose_item<0>((const float*)a.in[9], DA, D, (bf16*)(ws + WS_WC), scr, r, lane); continue; } r -= I_A;
            if (r < I_O) { p0_transpose_item<0>((const float*)a.in[10], D, D, (bf16*)(ws + WS_WO), scr, r, lane); continue; } r -= I_O;
            p0_transpose_item<0>((const float*)a.in[15], DPLE, D, (bf16*)(ws + WS_WP), scr, r, lane);
        }
    } else {
        for (int it = gw; it < I_UP + I_DN + I_O; it += NGW) {
            int r = it;
            if (r < I_UP) { p0_transpose_item<1>((const float*)a.in[12], D, 2 * DFF, (bf16*)(ws + WS_WUP), scr, r, lane, (const float*)a.in[11]); continue; } r -= I_UP;
            if (r < I_DN) { p0_transpose_item<0>((const float*)a.in[14], DFF, D, (bf16*)(ws + WS_WDN), scr, r, lane); continue; } r -= I_DN;
            p0_transpose_item<0>((const float*)a.in[16], D, D, (bf16*)(ws + WS_WPG), scr, r, lane);
        }
    }
}
constexpr int CW_CONVQ = CW_QHEAD + 128;
struct P0It { const float* src; bf16* WT; int N, K, k0, n0; };
__device__ __forceinline__ P0It p0_late_resolve(const Args& a, unsigned char* ws, int it) {
    constexpr int I_DN = (DFF / 64) * (D / 64);
    P0It d; int r = it;
    if (r < I_DN) { d.N = D; d.K = DFF; d.WT = (bf16*)(ws + WS_WDN); d.src = (const float*)a.in[14]; }
    else { r -= I_DN; d.N = D; d.K = D; d.WT = (bf16*)(ws + WS_WPG); d.src = (const float*)a.in[16]; }
    const int nblk = d.N / 64, kb = r / nblk, nb = r % nblk; d.k0 = 64 * kb; d.n0 = 64 * nb;
    d.src += (size_t)d.k0 * d.N + d.n0;
    return d;
}
__device__ __forceinline__ void p0_late_load(const P0It& d, float (&v)[64], int lane) {
    const float* sp = d.src + lane;
#pragma unroll
    for (int i = 0; i < 64; ++i) v[i] = __builtin_nontemporal_load(sp + (size_t)i * d.N);
}
__device__ __forceinline__ void p0_late_finish(const P0It& d, float (&v)[64], LAS unsigned* scr, int lane) {
#pragma unroll
    for (int i = 0; i < 32; ++i) scr[i * 65 + lane] = pk2(v[2 * i], v[2 * i + 1]);
    LDS_WAIT(); asm volatile("" ::: "memory");
    const int c = lane & 7, nl = lane >> 3;
#pragma unroll
    for (int j = 0; j < 8; ++j) { const int n = nl + 8 * j; const LAS unsigned* s = scr + (4 * c) * 65 + n;
        v4u o; o.x = s[0 * 65]; o.y = s[1 * 65]; o.z = s[2 * 65]; o.w = s[3 * 65];
        *(v4u*)(d.WT + (size_t)(d.n0 + n) * d.K + d.k0 + 8 * c) = o; }
    LDS_WAIT(); asm volatile("" ::: "memory");
}
__device__ __forceinline__ void p0_late_weights_queue(LAS unsigned char* lds, const Args& a, gu32* ctl) {
    int tl_ = threadIdx.x; asm volatile("" : "+v"(tl_)); int lane = tl_ & 63; const int wave = __builtin_amdgcn_readfirstlane(tl_ >> 6);
    asm volatile("" : "+v"(lane));
    unsigned char* ws = a.ws;
    LAS unsigned* scr = (LAS unsigned*)((LAS float*)lds + wave * (64 * 65));
    constexpr int I_O = (D / 64) * (D / 64), I_DN = (DFF / 64) * (D / 64), NIT = I_DN + I_O, CH = 16, NCH = NIT / CH;
    static_assert(NIT % CH == 0, "whole chunks");
    unsigned c = 0u; if (lane == 0) c = __hip_atomic_fetch_add((unsigned*)ctl + CW_CONVQ, 1u, __ATOMIC_RELAXED, __HIP_MEMORY_SCOPE_AGENT);
    c = (unsigned)__builtin_amdgcn_readfirstlane((int)c);
    while (c < (unsigned)NCH) {
        unsigned cn = 0u; if (lane == 0) cn = __hip_atomic_fetch_add((unsigned*)ctl + CW_CONVQ, 1u, __ATOMIC_RELAXED, __HIP_MEMORY_SCOPE_AGENT);
        const int i0 = (int)c * CH;
        float va[64], vb[64];
        P0It da = p0_late_resolve(a, ws, i0), db = da; p0_late_load(da, va, lane);
#pragma unroll 1
        for (int q = 0; q < CH; q += 2) {
            db = p0_late_resolve(a, ws, i0 + q + 1); p0_late_load(db, vb, lane);
            p0_late_finish(da, va, scr, lane);
            if (q + 2 < CH) { da = p0_late_resolve(a, ws, i0 + q + 2); p0_late_load(da, va, lane); }
            p0_late_finish(db, vb, scr, lane);
        }
        c = (unsigned)__builtin_amdgcn_readfirstlane((int)cn);
    }
}
__device__ __forceinline__ void p0_prologue(LAS unsigned char* lds, const Args& a, int G, int wave, int lane) {
    unsigned char* ws = a.ws;
    const int gw = blockIdx.x * NWAVES + wave, NGW = G * NWAVES;
    p0_weights(lds, a, wave, lane, gw, NGW, 0);
    const float* x = (const float*)a.in[0]; const float* g1 = (const float*)a.in[3]; bf16* XN = (bf16*)(ws + WS_XN);
    f32x4 gv[16];
#pragma unroll
    for (int j = 0; j < 16; ++j) gv[j] = ((const f32x4*)g1)[lane + 64 * j];
    for (int m = gw; m < M; m += NGW) rms_row_to_bf16(x + (size_t)m * D, gv, XN + (size_t)m * D, lane);
    const f32x4* p4 = (const f32x4*)a.in[1]; v4u* pb = (v4u*)(ws + WS_PB);
    for (int i = gw * 64 + lane; i < M * DPLE / 8; i += NGW * 64) { const f32x4 u0 = p4[2 * i], u1 = p4[2 * i + 1]; v4u o; o.x = pk2(u0.x, u0.y); o.y = pk2(u0.z, u0.w); o.z = pk2(u1.x, u1.y); o.w = pk2(u1.z, u1.w); pb[i] = o; }
}

__device__ __forceinline__ void p0_rope_table(unsigned char* ws, const int* pos, int G, int wave, int lane) {
    typedef float f32x2v __attribute__((ext_vector_type(2)));
    f32x2v* tab = (f32x2v*)(ws + WS_TAB);
    const float ifr = (float)pow(10000.0, -(double)lane / 64.0);
    const int gw = blockIdx.x * NWAVES + wave, NGW = G * NWAVES;
    for (int t = gw; t < M; t += NGW) { const float a = (float)pos[t] * ifr; tab[(size_t)t * 64 + lane] = (f32x2v){cosf(a), sinf(a)}; }
}
__device__ __forceinline__ void p2_qk(LAS unsigned char* lds, unsigned char* ws, const float* qn, const float* kn, int G, int tid, int nost) {
    (void)nost;
    LAS float* red = (LAS float*)lds;
    bf16* __restrict__ Qb = (bf16*)(ws + WS_Q); bf16* __restrict__ Kb = (bf16*)(ws + WS_K);
    const f32x4* tab = (const f32x4*)(ws + WS_TAB);
    bf16* kmh = (bf16*)(ws + WS_KMH); bf16* kml = (bf16*)(ws + WS_KML);
    const int gidx = tid >> 3, c = tid & 7, hl = gidx & 3, ts = gidx >> 2;
    float gq[16], gk[16];
#pragma unroll
    for (int e = 0; e < 8; ++e) { gq[e] = qn[8 * c + e]; gq[8 + e] = qn[64 + 8 * c + e]; gk[e] = kn[8 * c + e]; gk[8 + e] = kn[64 + 8 * c + e]; }
    for (int it = blockIdx.x; it < NBLK * 4; it += G) {
        const int jb = it >> 2, hg = it & 3, head = hg * 4 + hl;
        float ks[16];
#pragma unroll
        for (int e = 0; e < 16; ++e) ks[e] = 0.f;
#pragma unroll 2
        for (int i = 0; i < 16; ++i) {
            const int t = jb * BLK + 16 * i + ts;
            const f32x4* tp = tab + (size_t)t * 32 + 4 * c;
            const f32x4 cs0 = tp[0], cs1 = tp[1], cs2 = tp[2], cs3 = tp[3];
            const float cs[16] = {cs0.x, cs0.y, cs0.z, cs0.w, cs1.x, cs1.y, cs1.z, cs1.w, cs2.x, cs2.y, cs2.z, cs2.w, cs3.x, cs3.y, cs3.z, cs3.w};
#pragma unroll
            for (int ten = 0; ten < 2; ++ten) {
                bf16* ptr = (ten ? Kb : Qb) + (size_t)t * DA + head * HD + 8 * c;
                const v4u lo = *(const v4u*)ptr, hi = *(const v4u*)(ptr + 64);
                float x[16];
#pragma unroll
                for (int e = 0; e < 4; ++e) { x[2 * e] = bflo(lo[e]); x[2 * e + 1] = bfhi(lo[e]); x[8 + 2 * e] = bflo(hi[e]); x[9 + 2 * e] = bfhi(hi[e]); }
                float ss = 0.f;
#pragma unroll
                for (int e = 0; e < 16; ++e) ss += x[e] * x[e];
                ss += __shfl_xor(ss, 1); ss += __shfl_xor(ss, 2); ss += __shfl_xor(ss, 4);
                const float r = 1.0f / sqrtf(ss * (1.f / HD) + RMS_EPS);
                float o[16];
#pragma unroll
                for (int e = 0; e < 8; ++e) { const float y0 = x[e] * r * (ten ? gk[e] : gq[e]), y1 = x[8 + e] * r * (ten ? gk[8 + e] : gq[8 + e]); const float cc = cs[2 * e], sn = cs[2 * e + 1];
                    o[e] = y0 * cc - y1 * sn; o[8 + e] = y1 * cc + y0 * sn; }
                v4u wl, wh;
#pragma unroll
                for (int e = 0; e < 4; ++e) { wl[e] = pk2(o[2 * e], o[2 * e + 1]); wh[e] = pk2(o[8 + 2 * e], o[9 + 2 * e]); }
                *(v4u*)ptr = wl; *(v4u*)(ptr + 64) = wh;
                if (ten) {
#pragma unroll
                    for (int e = 0; e < 16; ++e) ks[e] += o[e]; }
            }
        }
        __syncthreads();
#pragma unroll
        for (int e = 0; e < 4; ++e) *(LAS f32x4*)(red + (gidx * 8 + c) * 16 + 4 * e) = (f32x4){ks[4 * e], ks[4 * e + 1], ks[4 * e + 2], ks[4 * e + 3]};
        __syncthreads();
        {
            const int h2 = tid >> 7, d = tid & 127, c2 = (d & 63) >> 3, e2 = (d & 7) + ((d >> 6) << 3);
            float s = 0.f;
#pragma unroll
            for (int t2 = 0; t2 < 16; ++t2) s += red[((t2 * 4 + h2) * 8 + c2) * 16 + e2];
            s *= (1.f / BLK);
            const unsigned hb = f2bf(s); const float hf = __uint_as_float(hb << 16);
            const size_t o = ((size_t)(hg * 4 + h2) * NBLK + jb) * HD + d;
            kmh[o] = (bf16)hb; kml[o] = (bf16)f2bf(s - hf);
        }
    }
}
__device__ __forceinline__ void p2_conv(unsigned char* ws, const float* cw, int G, int wave, int lane, int nost) {
    (void)nost;
    bf16* __restrict__ CB = (bf16*)(ws + WS_CB); const bf16* __restrict__ CC = (const bf16*)(ws + WS_CC); const bf16* __restrict__ CX = (const bf16*)(ws + WS_CX);
    const int gw = blockIdx.x * NWAVES + wave, NGW = G * NWAVES;
    for (int it = gw; it < (M / 32) * 4; it += NGW) {
        const int rc = it >> 2, st = it & 3, c = st * 512 + lane * 8, t0 = rc * 32;
        float w0[8], w1[8], w2[8], p1[8], p2[8];
#pragma unroll
        for (int e = 0; e < 8; ++e) { w0[e] = cw[c + e]; w1[e] = cw[DA + c + e]; w2[e] = cw[2 * DA + c + e]; p1[e] = 0.f; p2[e] = 0.f; }
        if (t0 >= 2) {
            const v4u a2 = *(const v4u*)(CC + (size_t)(t0 - 2) * DA + c), b2 = *(const v4u*)(CX + (size_t)(t0 - 2) * DA + c);
            const v4u a1 = *(const v4u*)(CC + (size_t)(t0 - 1) * DA + c), b1 = *(const v4u*)(CX + (size_t)(t0 - 1) * DA + c);
#pragma unroll
            for (int e = 0; e < 4; ++e) { p2[2 * e] = bflo(a2[e]) * bflo(b2[e]); p2[2 * e + 1] = bfhi(a2[e]) * bfhi(b2[e]); p1[2 * e] = bflo(a1[e]) * bflo(b1[e]); p1[2 * e + 1] = bfhi(a1[e]) * bfhi(b1[e]); }
        }
#pragma unroll 1
        for (int tb = 0; tb < 32; tb += 8) {
            v4u ra[8], rb[8], rg[8];
#pragma unroll
            for (int k = 0; k < 8; ++k) { const size_t o = (size_t)(t0 + tb + k) * DA + c; ra[k] = *(const v4u*)(CC + o); rb[k] = *(const v4u*)(CX + o); rg[k] = *(const v4u*)(CB + o); }
#pragma unroll
            for (int k = 0; k < 8; ++k) {
                const size_t o = (size_t)(t0 + tb + k) * DA + c;
                float pr[8], out[8];
#pragma unroll
                for (int e = 0; e < 4; ++e) { pr[2 * e] = bflo(ra[k][e]) * bflo(rb[k][e]); pr[2 * e + 1] = bfhi(ra[k][e]) * bfhi(rb[k][e]); }
#pragma unroll
                for (int e = 0; e < 8; ++e) { const float gb = (e & 1) ? bfhi(rg[k][e >> 1]) : bflo(rg[k][e >> 1]); out[e] = gb * (w2[e] * pr[e] + w1[e] * p1[e] + w0[e] * p2[e]); p2[e] = p1[e]; p1[e] = pr[e]; }
                v4u ov; ov.x = pk2(out[0], out[1]); ov.y = pk2(out[2], out[3]); ov.z = pk2(out[4], out[5]); ov.w = pk2(out[6], out[7]);
                *(v4u*)(CB + o) = ov;
            }
        }
    }
}

typedef float f32x16g __attribute__((ext_vector_type(16)));
#define P3_BETTER(v, j, bv, bj) ((v) > (bv) || ((v) == (bv) && (j) < (bj)))
#define P3_INSERT(v, j) do { const bool b0_ = P3_BETTER(v, j, t0v, t0j), b1_ = P3_BETTER(v, j, t1v, t1j), b2_ = P3_BETTER(v, j, t2v, t2j); \
    t2v = b1_ ? t1v : (b2_ ? (v) : t2v); t2j = b1_ ? t1j : (b2_ ? (j) : t2j); t1v = b0_ ? t0v : (b1_ ? (v) : t1v); t1j = b0_ ? t0j : (b1_ ? (j) : t1j); t0v = b0_ ? (v) : t0v; t0j = b0_ ? (j) : t0j; } while (0)
__device__ __forceinline__ void p3_gate(LAS unsigned char* lds, unsigned char* ws, gu32* ctl, int G, int tid, int wave, int lane, int nost) {
    const bf16* Qb = (const bf16*)(ws + WS_Q); const bf16* kmh = (const bf16*)(ws + WS_KMH); const bf16* kml = (const bf16*)(ws + WS_KML); unsigned* list = (unsigned*)(ws + WS_LIST);
    LAS unsigned* lcnt = (LAS unsigned*)(lds + 32768); LAS unsigned* lbase = (LAS unsigned*)(lds + 32768 + 256);
    const int r = lane & 31, hi = lane >> 5;
    int koff[8];
#pragma unroll
    for (int ds = 0; ds < 8; ++ds) koff[ds] = r * 256 + (((2 * ds + hi) ^ (r & 15)) << 4);
    for (int it = blockIdx.x; it < NH * (NBLK - 1); it += G) {
        const int h = it / (NBLK - 1), qb = 1 + it % (NBLK - 1);
        __syncthreads();
#pragma unroll
        for (int i = 0; i < 2; ++i) { const int n = wave * 2 + i, p = n * 64 + lane, j = p >> 4, pc = p & 15, ck = pc ^ (j & 15);
            __builtin_amdgcn_global_load_lds((const unsigned*)(kmh + ((size_t)h * NBLK + j) * HD + ck * 8), (LAS unsigned*)(lds + n * 1024), 16, 0, 0);
            __builtin_amdgcn_global_load_lds((const unsigned*)(kml + ((size_t)h * NBLK + j) * HD + ck * 8), (LAS unsigned*)(lds + 16384 + n * 1024), 16, 0, 0); }
        if (tid < 64) lcnt[tid] = 0u;
        const int t = qb * BLK + wave * 32 + r;
        bf16x8 qf[8];
#pragma unroll
        for (int ds = 0; ds < 8; ++ds) qf[ds] = *(const bf16x8*)(Qb + (size_t)t * DA + h * HD + 16 * ds + 8 * hi);
        asm volatile("s_waitcnt vmcnt(0)" ::: "memory");
        __syncthreads();
        f32x16g g0, g1;
#pragma unroll
        for (int e = 0; e < 16; ++e) { g0[e] = 0.f; g1[e] = 0.f; }
#pragma unroll
        for (int ds = 0; ds < 8; ++ds) {
            const bf16x8 a0 = *(const LAS bf16x8*)(lds + koff[ds]), a1 = *(const LAS bf16x8*)(lds + koff[ds] + 8192);
            const bf16x8 b0 = *(const LAS bf16x8*)(lds + 16384 + koff[ds]), b1 = *(const LAS bf16x8*)(lds + 16384 + koff[ds] + 8192);
            g0 = __builtin_amdgcn_mfma_f32_32x32x16_bf16(a0, qf[ds], g0, 0, 0, 0); g1 = __builtin_amdgcn_mfma_f32_32x32x16_bf16(a1, qf[ds], g1, 0, 0, 0);
            g0 = __builtin_amdgcn_mfma_f32_32x32x16_bf16(b0, qf[ds], g0, 0, 0, 0); g1 = __builtin_amdgcn_mfma_f32_32x32x16_bf16(b1, qf[ds], g1, 0, 0, 0);
        }
        float vv[32];
#pragma unroll
        for (int e = 0; e < 16; ++e) { const int j = (e & 3) + 8 * (e >> 2) + 4 * hi; vv[e] = j < qb ? g0[e] : -INFINITY; vv[16 + e] = (32 + j) < qb ? g1[e] : -INFINITY; }
        float t0v, t1v, t2v; int t0j, t1j, t2j;
#define P3_SCAN(TV, TJ, SENT) do { TV = -INFINITY; TJ = (SENT); \
    _Pragma("unroll") for (int e = 0; e < 32; ++e) { const int j = 32 * (e >> 4) + ((e & 15) & 3) + 8 * ((e & 15) >> 2) + 4 * hi; if (vv[e] > TV) { TV = vv[e]; TJ = j; } } \
    _Pragma("unroll") for (int e = 0; e < 32; ++e) { const int j = 32 * (e >> 4) + ((e & 15) & 3) + 8 * ((e & 15) >> 2) + 4 * hi; if (j == TJ) vv[e] = -INFINITY; } } while (0)
        P3_SCAN(t0v, t0j, 64); P3_SCAN(t1v, t1j, 65); P3_SCAN(t2v, t2j, 66);
#undef P3_SCAN
        {
            const float p0v = __shfl_xor(t0v, 32), p1v = __shfl_xor(t1v, 32), p2v = __shfl_xor(t2v, 32);
            const int p0j = __shfl_xor(t0j, 32), p1j = __shfl_xor(t1j, 32), p2j = __shfl_xor(t2j, 32);
            P3_INSERT(p0v, p0j); P3_INSERT(p1v, p1j); P3_INSERT(p2v, p2j);
        }
        const int nvalid = qb < 3 ? qb : 3;
        unsigned rk0 = 0u, rk1 = 0u, rk2 = 0u;
        if (hi == 0) {
            rk0 = __hip_atomic_fetch_add(lcnt + t0j, 1u, __ATOMIC_RELAXED, __HIP_MEMORY_SCOPE_WORKGROUP);
            if (nvalid > 1) rk1 = __hip_atomic_fetch_add(lcnt + t1j, 1u, __ATOMIC_RELAXED, __HIP_MEMORY_SCOPE_WORKGROUP);
            if (nvalid > 2) rk2 = __hip_atomic_fetch_add(lcnt + t2j, 1u, __ATOMIC_RELAXED, __HIP_MEMORY_SCOPE_WORKGROUP);
        }
        __syncthreads();
        if (tid < 64) { const unsigned n = lcnt[tid]; lbase[tid] = (n && !nost) ? __hip_atomic_fetch_add((unsigned*)ctl + CW_CNT + h * NBLK + tid, n, __ATOMIC_RELAXED, __HIP_MEMORY_SCOPE_AGENT) : 0u; }
        __syncthreads();
        if (hi == 0 && !nost) {
            list[list_base(h, t0j) + lbase[t0j] + rk0] = (unsigned)t;
            if (nvalid > 1) list[list_base(h, t1j) + lbase[t1j] + rk1] = (1u << 14) | (unsigned)t;
            if (nvalid > 2) list[list_base(h, t2j) + lbase[t2j] + rk2] = (2u << 14) | (unsigned)t;
        }
    }
}

typedef float f32x16 __attribute__((ext_vector_type(16)));
typedef short s16x4 __attribute__((ext_vector_type(4)));
typedef float f32x2_t __attribute__((ext_vector_type(2)));
typedef __bf16 bf16x2_t __attribute__((ext_vector_type(2)));
__device__ __forceinline__ unsigned cvtpk(float lo, float hi) { f32x2_t v = {lo, hi}; bf16x2_t b = __builtin_convertvector(v, bf16x2_t); return __builtin_bit_cast(unsigned, b); }
__device__ __forceinline__ int crow(int r, int hi) { return (r & 3) + 8 * (r >> 2) + 4 * hi; }
constexpr int ATT_K_OFF = 0, ATT_V_OFF = 65536, ATT_PRE_OFF = 131072;
constexpr float ATT_C = ATT_SCALE * 1.4426950408889634f, LN2F = 0.6931471805599453f;

__device__ __forceinline__ void stage_kv(LAS unsigned char* lds, const bf16* Kb, const bf16* Vb, int h, int j, int wave, int lane) {
#pragma unroll
    for (int i = 0; i < 8; ++i) {
        const int n = wave * 8 + i, p = n * 64 + lane, key = p >> 4, pc = p & 15;
        const int ck = pc ^ (key & 15), cv = pc ^ ((key & 3) << 2);
        const size_t ro = (size_t)(j * BLK + key) * DA + h * HD;
        __builtin_amdgcn_global_load_lds((const unsigned*)(Kb + ro + ck * 8), (LAS unsigned*)(lds + ATT_K_OFF + n * 1024), 16, 0, 0);
        __builtin_amdgcn_global_load_lds((const unsigned*)(Vb + ro + cv * 8), (LAS unsigned*)(lds + ATT_V_OFF + n * 1024), 16, 0, 0);
    }
}
#define AT_SB() __builtin_amdgcn_sched_barrier(0)
#define AT_LOADK(HF, KF) do { _Pragma("unroll") for (int i_ = 0; i_ < 4; ++i_) { KF[2 * i_] = *(const LAS bf16x8*)(kb + koff[4 * (HF) + i_]); KF[2 * i_ + 1] = *(const LAS bf16x8*)(kb + koff[4 * (HF) + i_] + 8192); } } while (0)
#define AT_MMAK(HF, KF) do { _Pragma("unroll") for (int i_ = 0; i_ < 4; ++i_) { s0 = __builtin_amdgcn_mfma_f32_32x32x16_bf16(KF[2 * i_], qf[4 * (HF) + i_], s0, 0, 0, 0); s1 = __builtin_amdgcn_mfma_f32_32x32x16_bf16(KF[2 * i_ + 1], qf[4 * (HF) + i_], s1, 0, 0, 0); } } while (0)
#define AT_LOADV(PR, VF) do { _Pragma("unroll") for (int k_ = 0; k_ < 2; ++k_) _Pragma("unroll") for (int db_ = 0; db_ < 4; ++db_) { \
    const s16x4 lo_ = __builtin_bit_cast(s16x4, __builtin_amdgcn_ds_read_tr16_b64_v4i16((LAS s16x4*)(vb + voff[db_] + (2 * (PR) + k_) * 4096))); \
    const s16x4 hi_ = __builtin_bit_cast(s16x4, __builtin_amdgcn_ds_read_tr16_b64_v4i16((LAS s16x4*)(vb + voff[db_] + (2 * (PR) + k_) * 4096 + 2048))); \
    VF[4 * k_ + db_] = (bf16x8){lo_[0], lo_[1], lo_[2], lo_[3], hi_[0], hi_[1], hi_[2], hi_[3]}; } } while (0)
#define AT_MMAV(PR, VF) do { const f32x16& P_ = ((PR) == 0) ? s0 : s1; _Pragma("unroll") for (int k_ = 0; k_ < 2; ++k_) { \
    v4u pw_; pw_.x = cvtpk(P_[8 * k_ + 0], P_[8 * k_ + 1]); pw_.y = cvtpk(P_[8 * k_ + 2], P_[8 * k_ + 3]); pw_.z = cvtpk(P_[8 * k_ + 4], P_[8 * k_ + 5]); pw_.w = cvtpk(P_[8 * k_ + 6], P_[8 * k_ + 7]); \
    const bf16x8 pf_ = __builtin_bit_cast(bf16x8, pw_); \
    _Pragma("unroll") for (int db_ = 0; db_ < 4; ++db_) o[db_] = __builtin_amdgcn_mfma_f32_32x32x16_bf16(VF[4 * k_ + db_], pf_, o[db_], 0, 0, 0); } } while (0)
struct NoHook { __device__ __forceinline__ void operator()(bf16x8 (&)[8]) {} };
template <bool CAUSAL, class Hook>
__device__ __forceinline__ void attn_tile(LAS unsigned char* lds, bf16x8 (&qf)[8], int nsteps, int ql, int lane, float& m, float& l, f32x16 (&o)[4], Hook& hook) {
    const int r = lane & 31, hi = lane >> 5, i16 = lane & 15, g = lane >> 4, kq = i16 >> 2;
    int koff[8], voff[4];
#pragma unroll
    for (int ds = 0; ds < 8; ++ds) koff[ds] = ATT_K_OFF + r * 256 + (((2 * ds + hi) ^ (r & 15)) << 4);
#pragma unroll
    for (int db = 0; db < 4; ++db) voff[db] = ATT_V_OFF + (4 * hi + kq) * 256 + ((db ^ kq) << 6) + ((g & 1) << 5) + (((i16 & 3) >> 1) << 4) + ((i16 & 1) << 3);
    m = -INFINITY; l = 0.f;
#pragma unroll
    for (int db = 0; db < 4; ++db)
#pragma unroll
        for (int e = 0; e < 16; ++e) o[db][e] = 0.f;
#pragma unroll 1
    for (int st = 0; st < nsteps; ++st) {
        f32x16 s0, s1;
#pragma unroll
        for (int e = 0; e < 16; ++e) { s0[e] = 0.f; s1[e] = 0.f; }
        LAS unsigned char* kb = lds + st * 16384; LAS unsigned char* vb = kb;
        bf16x8 fr[8];
        AT_LOADK(0, fr); AT_SB(); AT_MMAK(0, fr); AT_SB();
        AT_LOADK(1, fr); AT_SB(); AT_MMAK(1, fr); AT_SB();
        if (st == nsteps - 1) { hook(qf); AT_SB(); }
        float mx = -INFINITY;
#pragma unroll
        for (int e = 0; e < 16; ++e) {
            if (CAUSAL) { const int key = 64 * st + crow(e, hi); if (key > ql) s0[e] = -INFINITY; if (key + 32 > ql) s1[e] = -INFINITY; }
            mx = fmaxf(mx, fmaxf(s0[e], s1[e]));
        }
        mx = fmaxf(mx, __shfl_xor(mx, 32));
        if (__any(mx > m + (8.0f / ATT_C))) {
            const float mn = fmaxf(m, mx), alpha = __builtin_amdgcn_exp2f((m - mn) * ATT_C);
            m = mn; l *= alpha;
#pragma unroll
            for (int db = 0; db < 4; ++db)
#pragma unroll
                for (int e = 0; e < 16; ++e) o[db][e] *= alpha;
        }
        const float nb = -m * ATT_C;
        float ls = 0.f;
#pragma unroll
        for (int e = 0; e < 16; ++e) { s0[e] = __builtin_amdgcn_exp2f(__builtin_fmaf(s0[e], ATT_C, nb)); s1[e] = __builtin_amdgcn_exp2f(__builtin_fmaf(s1[e], ATT_C, nb)); ls += s0[e] + s1[e]; }
        l += ls;
        AT_SB();
        AT_LOADV(0, fr); AT_SB(); AT_MMAV(0, fr); AT_SB();
        AT_LOADV(1, fr); AT_SB(); AT_MMAV(1, fr); AT_SB();
    }
    m *= ATT_C;
}
constexpr int P4_LCAP = 5120;
#define P4_FETCH(S_, T_, SL_, VALID_, QF_) do { int e_ = (S_) * 32 + r; VALID_ = e_ < n; if (!VALID_) e_ = n - 1; \
    const unsigned ent_ = e_ < P4_LCAP ? llist[e_] : list[lb + e_]; T_ = (int)(ent_ & 16383u); SL_ = (int)(ent_ >> 14); \
    _Pragma("unroll") for (int ds_ = 0; ds_ < 8; ++ds_) QF_[ds_] = *(const bf16x8*)(Qb + (size_t)T_ * DA + h * HD + 16 * ds_ + 8 * hi); } while (0)
struct P4Pref {
    LAS unsigned* lctl; LAS unsigned* llist; const unsigned* list; const bf16* Qb; int lb, n, nsub, h, r, hi, lane;
    int s_n, t_n, sl_n; bool v_n;
    __device__ __forceinline__ void operator()(bf16x8 (&qf)[8]) {
        unsigned sv = 0u; if (lane == 0) sv = __hip_atomic_fetch_add(lctl + 1, 1u, __ATOMIC_RELAXED, __HIP_MEMORY_SCOPE_WORKGROUP);
        s_n = (int)__builtin_amdgcn_readfirstlane(sv);
        if (s_n < nsub) { P4_FETCH(s_n, t_n, sl_n, v_n, qf); }
    }
};
__device__ __forceinline__ void p4_routed(LAS unsigned char* lds, unsigned char* ws, gu32* ctl, int G, int tid, int wave, int lane, int qsel, int nost = 0) {
    LAS unsigned* lctl = (LAS unsigned*)(lds + ATT_PRE_OFF); LAS unsigned* llist = (LAS unsigned*)(lds + ATT_PRE_OFF + 64);
    const bf16* Qb = (const bf16*)(ws + WS_Q); const bf16* Kb = (const bf16*)(ws + WS_K); const bf16* Vb = (const bf16*)(ws + WS_V);
    const unsigned* list = (const unsigned*)(ws + WS_LIST); float* lse = (float*)(ws + WS_LSE);
    const int r = lane & 31, hi = lane >> 5;
    for (;;) {
        __syncthreads();
        if (tid == 0) { lctl[0] = __hip_atomic_fetch_add((unsigned*)ctl + CW_QHEAD + 64 * qsel, 1u, __ATOMIC_RELAXED, __HIP_MEMORY_SCOPE_AGENT); lctl[1] = 0u; }
        __syncthreads();
        const int i = (int)lctl[0];
        if (i >= NH * (NBLK - 1)) break;
        const int j = i >> 4, h = i & 15;
        const int n = (int)__hip_atomic_load((unsigned*)ctl + CW_CNT + h * NBLK + j, __ATOMIC_RELAXED, __HIP_MEMORY_SCOPE_AGENT);
        if (n == 0) continue;
        stage_kv(lds, Kb, Vb, h, j, wave, lane);
        const int lb = list_base(h, j);
        for (int e = tid; e < n && e < P4_LCAP; e += NWAVES * 64) llist[e] = list[lb + e];
        asm volatile("s_waitcnt vmcnt(0) lgkmcnt(0)" ::: "memory");
        __syncthreads();
        const int nsub = (n + 31) >> 5;
        int s_cur; { unsigned sv = 0u; if (lane == 0) sv = __hip_atomic_fetch_add(lctl + 1, 1u, __ATOMIC_RELAXED, __HIP_MEMORY_SCOPE_WORKGROUP); s_cur = (int)__builtin_amdgcn_readfirstlane(sv); }
        int t_c = 0, sl_c = 0; bool v_c = false; bf16x8 qc[8];
#pragma unroll
        for (int ds = 0; ds < 8; ++ds) qc[ds] = (bf16x8){0, 0, 0, 0, 0, 0, 0, 0};
        if (s_cur < nsub) P4_FETCH(s_cur, t_c, sl_c, v_c, qc);
        while (s_cur < nsub) {
            P4Pref pf{lctl, llist, list, Qb, lb, n, nsub, h, r, hi, lane, nsub, 0, 0, false};
            float m, l; f32x16 o[4];
            attn_tile<false>(lds, qc, 4, 0, lane, m, l, o, pf);
            const float lt = l + __shfl_xor(l, 32), il = 1.0f / lt;
            if (v_c) {
                bf16* So = (bf16*)(ws + (sl_c == 0 ? WS_S0 : (sl_c == 1 ? WS_S1 : WS_S2))) + (size_t)t_c * DA + h * HD + 4 * hi;
#pragma unroll
                for (int db = 0; db < 4; ++db)
#pragma unroll
                    for (int g4 = 0; g4 < 4; ++g4) { pg8::u32x2 w; w.x = cvtpk(o[db][4 * g4] * il, o[db][4 * g4 + 1] * il); w.y = cvtpk(o[db][4 * g4 + 2] * il, o[db][4 * g4 + 3] * il);
                        *(pg8::u32x2*)(So + 32 * db + 8 * g4) = w; }
                if (hi == 0) lse[((size_t)sl_c * NH + h) * M + t_c] = (m + __builtin_amdgcn_logf(lt)) * LN2F;
            }
            s_cur = pf.s_n; t_c = pf.t_n; sl_c = pf.sl_n; v_c = pf.v_n;
        }
    }
}
#undef P4_FETCH
__device__ __forceinline__ void p5_own(LAS unsigned char* lds, unsigned char* ws, int G, int wave, int lane, int nost) {
    bf16* Qb = (bf16*)(ws + WS_Q); const bf16* Kb = (const bf16*)(ws + WS_K); const bf16* Vb = (const bf16*)(ws + WS_V);
    const float* lse = (const float*)(ws + WS_LSE);
    const int r = lane & 31, hi = lane >> 5;
    for (int it = blockIdx.x; it < NH * NBLK; it += G) {
        const int h = it & 15, j = it >> 4;
        __syncthreads();
        stage_kv(lds, Kb, Vb, h, j, wave, lane);
        const int t = j * BLK + wave * 32 + r;
        bf16x8 qf[8];
#pragma unroll
        for (int ds = 0; ds < 8; ++ds) qf[ds] = *(const bf16x8*)(Qb + (size_t)t * DA + h * HD + 16 * ds + 8 * hi);
        asm volatile("s_waitcnt vmcnt(0)" ::: "memory");
        __syncthreads();
        float m, l; f32x16 o[4];
        NoHook nh; attn_tile<true>(lds, qf, (wave >> 1) + 1, wave * 32 + r, lane, m, l, o, nh);
        const float lt = l + __shfl_xor(l, 32);
        const int nvalid = j < 3 ? j : 3;
        const float lown = (m + __builtin_amdgcn_logf(lt)) * LN2F;
        float ls[3]; float mx = lown;
#pragma unroll
        for (int s = 0; s < 3; ++s) { ls[s] = (s < nvalid) ? lse[((size_t)s * NH + h) * M + t] : -INFINITY; mx = fmaxf(mx, ls[s]); }
        const float wown = __expf(lown - mx); float wsum = wown; float wv[3];
#pragma unroll
        for (int s = 0; s < 3; ++s) { wv[s] = (s < nvalid) ? __expf(ls[s] - mx) : 0.f; wsum += wv[s]; }
        const float iw = 1.0f / wsum, wo = wown / lt * iw;
        const size_t ro = (size_t)t * DA + h * HD + 4 * hi;
        pg8::u32x2 pq[3][4][4];
#pragma unroll
        for (int s = 0; s < 3; ++s)
#pragma unroll
            for (int db = 0; db < 4; ++db)
#pragma unroll
                for (int g4 = 0; g4 < 4; ++g4) pq[s][db][g4] = (s < nvalid) ? *(const pg8::u32x2*)((const bf16*)(ws + (s == 0 ? WS_S0 : (s == 1 ? WS_S1 : WS_S2))) + ro + 32 * db + 8 * g4) : (pg8::u32x2){0u, 0u};
        const float w0 = wv[0] * iw, w1 = wv[1] * iw, w2s = wv[2] * iw;
#pragma unroll
        for (int db = 0; db < 4; ++db)
#pragma unroll
            for (int g4 = 0; g4 < 4; ++g4) {
                float a0 = o[db][4 * g4] * wo, a1 = o[db][4 * g4 + 1] * wo, a2 = o[db][4 * g4 + 2] * wo, a3 = o[db][4 * g4 + 3] * wo;
                { const pg8::u32x2 pw = pq[0][db][g4]; a0 += w0 * bflo(pw.x); a1 += w0 * bfhi(pw.x); a2 += w0 * bflo(pw.y); a3 += w0 * bfhi(pw.y); }
                { const pg8::u32x2 pw = pq[1][db][g4]; a0 += w1 * bflo(pw.x); a1 += w1 * bfhi(pw.x); a2 += w1 * bflo(pw.y); a3 += w1 * bfhi(pw.y); }
                { const pg8::u32x2 pw = pq[2][db][g4]; a0 += w2s * bflo(pw.x); a1 += w2s * bfhi(pw.x); a2 += w2s * bflo(pw.y); a3 += w2s * bfhi(pw.y); }
                pg8::u32x2 w2; w2.x = cvtpk(a0, a1); w2.y = cvtpk(a2, a3);
                *(pg8::u32x2*)(Qb + ro + 32 * db + 8 * g4) = w2;
            }
    }
}

__global__ void __launch_bounds__(NWAVES * 64, 2) block_fwd(Args args) {
    extern __shared__ __attribute__((aligned(16))) unsigned char lds_raw[];
    LAS unsigned char* lds = (LAS unsigned char*)lds_raw;
    volatile LAS unsigned* MISC = (volatile LAS unsigned*)(lds + MISC_OFF);
    const int tid = threadIdx.x, lane = tid & 63, wave = __builtin_amdgcn_readfirstlane(tid >> 6), G = gridDim.x;
    unsigned char* ws = args.ws; gu32* ctl = (gu32*)(ws + WS_CTL);
    for (int u = tid; u < (LDS_BYTES - MISC_OFF) / 4; u += NWAVES * 64) ((LAS unsigned*)(lds + MISC_OFF))[u] = 0u;
    __syncthreads();
    XcdBarrier bar; bar.bar = (unsigned*)ctl + CW_BAR + args.bar_off; bar.x = 0; bar.st = nullptr;
    if (args.use_bar) bar = xcd_barrier_post((unsigned*)ctl + CW_BAR + args.bar_off, MISC + 8);
    const int lo = args.ph_lo, hi = args.ph_hi;
#define IN(k) (lo <= (k) && (k) < hi)
#define SEAM(k) do { if (IN(k) && IN((k) + 1)) xcd_barrier(bar); } while (0)
    bf16* const XN = (bf16*)(ws + WS_XN);
    float* const out = args.out;

    if (IN(0)) { p0_prologue(lds, args, G, wave, lane); p0_rope_table(ws, (const int*)args.in[2], G, wave, lane); } SEAM(0);
    if (IN(1)) {
        pg8::Gemm g{XN, (const bf16*)(ws + WS_WIN), M, DIN, D}; pg8::StaticOrder S; S.init(M, DIN, G, (int)blockIdx.x, GEMM_WGM);
        pg8::EpiZ E{(bf16*)(ws + WS_Z), M, args.flags & 1};
        pg8::gemm_phase<pg8::EpiZ, pg8::StaticOrder, true, true>(lds + RING_OFF, g, S, E);
    } SEAM(1);
    if (IN(2)) { p2_qk(lds, ws, (const float*)args.in[5], (const float*)args.in[6], G, tid, args.flags & 2); p2_conv(ws, (const float*)args.in[7], G, wave, lane, args.flags & 2); } SEAM(2);
    if (IN(3)) { p3_gate(lds, ws, ctl, G, tid, wave, lane, args.flags & 2); } SEAM(3);
    if (IN(4)) { p4_routed(lds, ws, ctl, G, tid, wave, lane, (args.flags >> 2) & 1, args.flags & 8); } SEAM(4);
    if (IN(5)) { p5_own(lds, ws, G, wave, lane, args.flags & 2); } SEAM(5);
    if (IN(6)) {
        pg8::Gemm g{(const bf16*)(ws + WS_Q), (const bf16*)(ws + WS_WA), M, D, DA, (size_t)(WS_CB - WS_Q), (size_t)(WS_WC - WS_WA)}; pg8::DualOrder S; S.so.init(M, D, G, (int)blockIdx.x);
        pg8::EpiDual E{(const bf16*)(ws + WS_GA), (const bf16*)(ws + WS_GC), (bf16*)(ws + WS_MERGED), D};
        pg8::gemm_phase<pg8::EpiDual, pg8::DualOrder, true, true>(lds + RING_OFF, g, S, E);
    } SEAM(6);
    if (IN(8)) {
        bf16* const X1B = (bf16*)(ws + WS_X1B);
        pg8::Gemm g{(const bf16*)(ws + WS_MERGED), (const bf16*)(ws + WS_WO), M, D, D}; pg8::StaticOrder S; S.init(M, D, G, (int)blockIdx.x);
        pg8::EpiX1 E{(const float*)args.in[0], X1B, (float*)((unsigned*)ctl + CW_RSS), D};
        pg8::gemm_phase<pg8::EpiX1, pg8::StaticOrder, true, true>(lds + RING_OFF, g, S, E);
        const int gw = blockIdx.x * NWAVES + wave, NGW = G * NWAVES;
        v4u* padf = (v4u*)(X1B - 2 * D); v4u* padb = (v4u*)(X1B + (size_t)M * D);
        for (int i = gw * 64 + lane; i < 2 * D / 8; i += NGW * 64) padf[i] = (v4u){0u, 0u, 0u, 0u};
        for (int i = gw * 64 + lane; i < 128 * D / 8; i += NGW * 64) padb[i] = (v4u){0u, 0u, 0u, 0u};
    }
    if (IN(8)) {
        pg8::Gemm g{(const bf16*)(ws + WS_PB), (const bf16*)(ws + WS_WP), M, D, DPLE}; pg8::StaticOrder S; S.init(M, D, G, (int)blockIdx.x);
        pg8::EpiBf E{(bf16*)(ws + WS_PP), D};
        pg8::gemm_phase<pg8::EpiBf, pg8::StaticOrder, true, true>(lds + RING_OFF, g, S, E);
    } SEAM(8);
    if (IN(11)) {
        pg8::Gemm g{(const bf16*)(ws + WS_X1B) - 2 * D, (const bf16*)(ws + WS_WUP), 65 * 256, 2 * DFF, D, 0, 0, (size_t)254 * D * 2}; pg8::StaticOrder S; S.init(65 * 256, 2 * DFF, G, (int)blockIdx.x, GEMM_WGM);
        pg8::EpiFfn E{(bf16*)(ws + WS_ACT), (const float*)args.in[13], (LAS float*)(lds + RING_BYTES), M, DFF, (const float*)((const unsigned*)ctl + CW_RSS), 1.0f / D, RMS_EPS};
        pg8::gemm_phase<pg8::EpiFfn, pg8::StaticOrder, true, true>(lds + RING_OFF, g, S, E);
        p0_late_weights_queue(lds, args, ctl);
    } SEAM(11);
    if (IN(15)) {
        pg8::Gemm g{(const bf16*)(ws + WS_ACT), (const bf16*)(ws + WS_WDN), M, D, DFF}; pg8::StaticOrder S; S.init(M, D, G, (int)blockIdx.x, 4);
        pg8::EpiX2 E{(const bf16*)(ws + WS_X1B), XN, D};
        pg8::gemm_phase<pg8::EpiX2, pg8::StaticOrder, true, true>(lds + RING_OFF, g, S, E);
    } SEAM(15);
    if (IN(16)) {
        pg8::Gemm g{XN, (const bf16*)(ws + WS_WPG), M, D, D}; pg8::StaticOrder S; S.init(M, D, G, (int)blockIdx.x);
        pg8::EpiOut E{XN, (const bf16*)(ws + WS_PP), out, D};
        pg8::gemm_phase<pg8::EpiOut, pg8::StaticOrder, true, true>(lds + RING_OFF, g, S, E);
    }
#undef IN
#undef SEAM
}

extern "C" void kernel_launch(void* const* d_in, const int* in_sizes, int n_in, void* d_out, int out_size, void* d_ws, size_t ws_size, hipStream_t stream) {
    static int grid = 0;
    if (grid == 0) {
        if (n_in != 17 || in_sizes[0] != M * D || out_size != M * D || ws_size < WS_END) { fprintf(stderr, "kernel_launch: unexpected shapes / workspace (n_in %d, ws %zu, need %zu); nothing launched\n", n_in, ws_size, (size_t)WS_END); grid = -1; return; }
        int dev = 0, cus = 0, per_cu = 0;
        if (hipGetDevice(&dev) != hipSuccess || hipDeviceGetAttribute(&cus, hipDeviceAttributeMultiprocessorCount, dev) != hipSuccess) { grid = -1; return; }
        if (hipFuncSetAttribute((const void*)block_fwd, hipFuncAttributeMaxDynamicSharedMemorySize, LDS_BYTES) != hipSuccess) { fprintf(stderr, "kernel_launch: hipFuncSetAttribute failed\n"); grid = -1; return; }
        if (hipOccupancyMaxActiveBlocksPerMultiprocessor(&per_cu, (const void*)block_fwd, NWAVES * 64, LDS_BYTES) != hipSuccess || per_cu < 1) fprintf(stderr, "kernel_launch: occupancy query reports %d\n", per_cu);
        (void)hipGetLastError();
        grid = cus;
    }
    if (grid < 0) return;
    if (hipMemsetAsync((char*)d_ws + WS_CTL, 0, CTL_ZERO_BYTES, stream) != hipSuccess) return;
    Args a{};
    for (int i = 0; i < 17; ++i) a.in[i] = d_in[i];
    a.out = (float*)d_out; a.ws = (unsigned char*)d_ws; a.bar_off = 0;
#if MK_PER_PHASE
    for (int ph = 0; ph < NPH; ++ph) { a.ph_lo = ph; a.ph_hi = ph + 1; a.use_bar = 0; hipLaunchKernelGGL(block_fwd, dim3(grid), dim3(NWAVES * 64), LDS_BYTES, stream, a); }
#elif PROBE_PHASE >= 0
    a.ph_lo = 0; a.ph_hi = PROBE_PHASE + 1; a.use_bar = 1; a.bar_off = 0;
    hipLaunchKernelGGL(block_fwd, dim3(grid), dim3(NWAVES * 64), LDS_BYTES, stream, a);
    a.ph_lo = PROBE_PHASE; a.ph_hi = PROBE_PHASE + 1; a.use_bar = 0; a.flags = PROBE_FLAGS;
    hipLaunchKernelGGL(block_fwd, dim3(grid), dim3(NWAVES * 64), LDS_BYTES, stream, a);
    a.flags = 0;
    if (PROBE_PHASE + 1 < NPH) { a.ph_lo = PROBE_PHASE + 1; a.ph_hi = NPH; a.use_bar = 1; a.bar_off = XCD_BAR_WORDS;
        hipLaunchKernelGGL(block_fwd, dim3(grid), dim3(NWAVES * 64), LDS_BYTES, stream, a); }
#else
    a.ph_lo = 0; a.ph_hi = NPH; a.use_bar = 1;
    hipLaunchKernelGGL(block_fwd, dim3(grid), dim3(NWAVES * 64), LDS_BYTES, stream, a);
#endif
}
```

```cpp
#include <hip/hip_runtime.h>
#include <cstdio>
#include <cstdint>
#include <cmath>
namespace pg8 {
#define PG8_LAS __attribute__((address_space(3)))
typedef unsigned short bf16_t;
typedef short bf16x8 __attribute__((ext_vector_type(8)));
typedef float f32x4 __attribute__((ext_vector_type(4)));
typedef unsigned u32x4 __attribute__((ext_vector_type(4)));
constexpr int BM = 256, BK = 64, HALF = 128, HTB = HALF * BK * 2  , STAGE_BYTES = 8 * HTB, NXCD = 8, WGM = 8;

__host__ __device__ __forceinline__ int lds_byte(int r, int c) { const int st = (r >> 4) * 2 + (c >> 5), rr = r & 15, cc = c & 31, ob = rr * 64 + cc * 2; return st * 1024 + (ob ^ (((ob >> 9) & 1) << 5)); }
__host__ __device__ __forceinline__ void stage_rc(int b, int& R, int& C) { const int st = b / 1024, sb = b % 1024, swz = sb ^ (((sb >> 9) & 1) << 5); R = (st >> 1) * 16 + swz / 64; C = (st & 1) * 32 + (swz % 64) / 2; }
__host__ __device__ __forceinline__ int perm32(int rho) { const int n = rho >> 4, i = rho & 15; return 8 * (i >> 2) + 4 * n + (i & 3); }

struct Unit { int pm, pn, aux; };
struct Gemm { const bf16_t* A; const bf16_t* Bt; int M, N, K; size_t a_jump = 0, b_jump = 0, a_tstep = 0; };

struct StaticOrder {
    int nM, nN, nwg, G, c, wgm;
    __host__ __device__ void init(int M, int N, int G_, int c_, int wgm_ = WGM) { nM = M / BM; nN = N / BM; nwg = nM * nN; G = G_; c = c_; wgm = wgm_; }
    __host__ __device__ bool next(int i, Unit& u) const {
        const long L = (long)i * G + c; if (L >= nwg) return false;
        int wgid = (int)L; { const int q = nwg / NXCD, r = nwg % NXCD, xcd = wgid % NXCD, off = wgid / NXCD; wgid = (xcd < r ? xcd * (q + 1) : r * (q + 1) + (xcd - r) * q) + off; }
        const int nig = wgm * nN, gid = wgid / nig, fm = gid * wgm, gsz = (nM - fm) < wgm ? (nM - fm) : wgm;
        u.pm = fm + ((wgid % nig) % gsz); u.pn = (wgid % nig) / gsz; u.aux = 0; return true;
    }
    __device__ __forceinline__ void a_ready(const Unit&) const {}
    __device__ __forceinline__ void done(const Unit&) const {}
};

struct DualOrder {
    StaticOrder so;
    __host__ __device__ bool next(int i, Unit& u) const { if (!so.next(i >> 1, u)) return false; u.aux = i & 1; return true; }
    __device__ __forceinline__ void a_ready(const Unit&) const {}
    __device__ __forceinline__ void done(const Unit&) const {}
};

__device__ __forceinline__ unsigned cvt_pk_bf16(float lo, float hi) { unsigned r; asm volatile("s_nop 0\n\tv_cvt_pk_bf16_f32 %0, %1, %2" : "=v"(r) : "v"(lo), "v"(hi)); return r; }
typedef unsigned u32x2 __attribute__((ext_vector_type(2)));
__device__ __forceinline__ float bf_lo(unsigned w) { return __uint_as_float(w << 16); }
__device__ __forceinline__ float bf_hi(unsigned w) { return __uint_as_float(w & 0xffff0000u); }
__device__ __forceinline__ float sigm(float v) { return __builtin_amdgcn_rcpf(1.0f + __expf(-v)); }
__device__ __forceinline__ u32x4 pack8(const f32x4& v0, const f32x4& v1) { u32x4 w; w.x = cvt_pk_bf16(v0[0], v0[1]); w.y = cvt_pk_bf16(v0[2], v0[3]); w.z = cvt_pk_bf16(v1[0], v1[1]); w.w = cvt_pk_bf16(v1[2], v1[3]); return w; }

struct EpiZ {
    static constexpr bool PERM = true, AFTER_DRAIN = false, KEEP = false, APERM = false;
    bf16_t* Z; int M; int nostore;
    __device__ __forceinline__ void operator()(const f32x4 (&acc)[2][2][4][2], const Unit& u, int wr, int wc, int fr, int fq) const {
        const int row0 = u.pm * BM + wr * 64 + fr;
        if (u.pn < 48) {
            bf16_t* base = Z + (size_t)(u.pn >> 3) * ((size_t)M * 2048); const int col0 = (u.pn & 7) * 256 + wc * 32 + 8 * fq;
#pragma unroll
            for (int ai = 0; ai < 2; ++ai)
#pragma unroll
                for (int m = 0; m < 4; ++m) { bf16_t* rowp = base + (size_t)(row0 + ai * HALF + m * 16) * 2048 + col0;
#pragma unroll
                    for (int bj = 0; bj < 2; ++bj) *(u32x4*)(rowp + bj * HALF) = pack8(acc[ai][bj][m][0], acc[ai][bj][m][1]); }
        } else {
            bf16_t* GAb = Z + (size_t)6 * M * 2048; bf16_t* GCb = GAb + (size_t)M * 4096; const int col0 = (u.pn - 48) * 128 + wc * 32 + 8 * fq;
#pragma unroll
            for (int ai = 0; ai < 2; ++ai)
#pragma unroll
                for (int m = 0; m < 4; ++m) { const size_t o = (size_t)(row0 + ai * HALF + m * 16) * 4096 + col0;
                    f32x4 r0, r1, c0, c1;
#pragma unroll
                    for (int e = 0; e < 4; ++e) { c0[e] = fmaxf(sigm(acc[ai][1][m][0][e]), 1e-20f); c1[e] = fmaxf(sigm(acc[ai][1][m][1][e]), 1e-20f);
                        r0[e] = sigm(acc[ai][0][m][0][e]) * __builtin_amdgcn_rcpf(c0[e]); r1[e] = sigm(acc[ai][0][m][1][e]) * __builtin_amdgcn_rcpf(c1[e]); }
                    *(u32x4*)(GAb + o) = pack8(r0, r1); *(u32x4*)(GCb + o) = pack8(c0, c1); }
        }
    }
};
struct EpiBf {
    static constexpr bool PERM = true, AFTER_DRAIN = false, KEEP = false, APERM = false;
    bf16_t* O; int ldc;
    __device__ __forceinline__ void operator()(const f32x4 (&acc)[2][2][4][2], const Unit& u, int wr, int wc, int fr, int fq) const {
        const int row0 = u.pm * BM + wr * 64 + fr, col0 = u.pn * BM + wc * 32 + 8 * fq;
#pragma unroll
        for (int ai = 0; ai < 2; ++ai)
#pragma unroll
            for (int m = 0; m < 4; ++m) { bf16_t* rowp = O + (size_t)(row0 + ai * HALF + m * 16) * ldc + col0;
#pragma unroll
                for (int bj = 0; bj < 2; ++bj) *(u32x4*)(rowp + bj * HALF) = pack8(acc[ai][bj][m][0], acc[ai][bj][m][1]); }
    }
};
struct EpiDual {
    static constexpr bool PERM = true, AFTER_DRAIN = false, KEEP = true, APERM = false;
    const bf16_t* GA; const bf16_t* GC; bf16_t* O; int ldc;
    __device__ __forceinline__ void operator()(f32x4 (&acc)[2][2][4][2], const Unit& u, int wr, int wc, int fr, int fq) const {
        const int row0 = u.pm * BM + wr * 64 + fr, col0 = u.pn * BM + wc * 32 + 8 * fq;
        const bf16_t* src = u.aux == 0 ? GA : GC;
        u32x4 cq[2][4][2];
#pragma unroll
        for (int ai = 0; ai < 2; ++ai)
#pragma unroll
            for (int m = 0; m < 4; ++m)
#pragma unroll
                for (int bj = 0; bj < 2; ++bj) cq[ai][m][bj] = *(const u32x4*)(src + (size_t)(row0 + ai * HALF + m * 16) * ldc + col0 + bj * HALF);
        if (u.aux == 0) {
#pragma unroll
            for (int ai = 0; ai < 2; ++ai)
#pragma unroll
                for (int m = 0; m < 4; ++m)
#pragma unroll
                    for (int bj = 0; bj < 2; ++bj) { const u32x4 c = cq[ai][m][bj];
                        acc[ai][bj][m][0][0] *= bf_lo(c.x); acc[ai][bj][m][0][1] *= bf_hi(c.x); acc[ai][bj][m][0][2] *= bf_lo(c.y); acc[ai][bj][m][0][3] *= bf_hi(c.y);
                        acc[ai][bj][m][1][0] *= bf_lo(c.z); acc[ai][bj][m][1][1] *= bf_hi(c.z); acc[ai][bj][m][1][2] *= bf_lo(c.w); acc[ai][bj][m][1][3] *= bf_hi(c.w); }
        } else {
#pragma unroll
            for (int ai = 0; ai < 2; ++ai)
#pragma unroll
                for (int m = 0; m < 4; ++m)
#pragma unroll
                    for (int bj = 0; bj < 2; ++bj) { const size_t o = (size_t)(row0 + ai * HALF + m * 16) * ldc + col0 + bj * HALF; const u32x4 c = cq[ai][m][bj];
                        f32x4 v0 = acc[ai][bj][m][0], v1 = acc[ai][bj][m][1];
                        v0[0] *= bf_lo(c.x); v0[1] *= bf_hi(c.x); v0[2] *= bf_lo(c.y); v0[3] *= bf_hi(c.y); v1[0] *= bf_lo(c.z); v1[1] *= bf_hi(c.z); v1[2] *= bf_lo(c.w); v1[3] *= bf_hi(c.w);
                        *(u32x4*)(O + o) = pack8(v0, v1); }
        }
    }
};
#define DPP_F(OLD, SRC, CTRL) __builtin_bit_cast(float, __builtin_amdgcn_update_dpp(__builtin_bit_cast(int, (float)(OLD)), __builtin_bit_cast(int, (float)(SRC)), (CTRL), 0xf, 0xf, false))
struct EpiFfn {
    static constexpr bool PERM = true, AFTER_DRAIN = false, KEEP = false, APERM = true;
    bf16_t* ACT; const float* cw; PG8_LAS float* ex; int Mrows, DFFc; const float* rss; float inv_d, eps;
    __device__ __forceinline__ void operator()(f32x4 (&acc)[2][2][4][2], const Unit& u, int wr, int wc, int fr, int fq) const {
        const int wave = wr * 4 + wc;
#pragma unroll
        for (int ai = 0; ai < 2; ++ai)
#pragma unroll
            for (int m = 0; m < 4; ++m) { const int row = u.pm * 254 - 2 + ai * HALF + wr * 64 + 4 * fr + m;
                const int rc = row < 0 ? 0 : (row >= Mrows ? Mrows - 1 : row);
                const float rv = __builtin_amdgcn_rsqf(rss[rc] * inv_d + eps), rs = (row == rc) ? rv : 0.f;
#pragma unroll
                for (int bj = 0; bj < 2; ++bj)
#pragma unroll
                    for (int n = 0; n < 2; ++n) acc[ai][bj][m][n] *= rs; }
        if (fr == 15) {
#pragma unroll
            for (int ai = 0; ai < 2; ++ai)
#pragma unroll
                for (int bj = 0; bj < 2; ++bj)
#pragma unroll
                    for (int n = 0; n < 2; ++n)
#pragma unroll
                        for (int w = 0; w < 2; ++w) *(PG8_LAS f32x4*)(ex + ((((((wave * 2 + ai) * 2 + bj) * 2 + n) * 4 + fq) * 2 + w) << 2)) = acc[ai][bj][2 + w][n];
        }
        asm volatile("s_waitcnt lgkmcnt(0)" ::: "memory"); __builtin_amdgcn_s_barrier(); asm volatile("" ::: "memory");
        const int cg = u.pn * 128 + wc * 32 + 8 * fq;
        f32x4 wga[2][3], wva[2][3];
#pragma unroll
        for (int n = 0; n < 2; ++n)
#pragma unroll
            for (int j = 0; j < 3; ++j) { wga[n][j] = *(const f32x4*)(cw + (size_t)j * 2 * DFFc + cg + 4 * n); wva[n][j] = *(const f32x4*)(cw + (size_t)j * 2 * DFFc + DFFc + cg + 4 * n); }
#pragma unroll
        for (int ai = 0; ai < 2; ++ai) {
            u32x2 held[4];
#pragma unroll
            for (int n = 0; n < 2; ++n) {
                f32x4 wg[3], wv[3];
#pragma unroll
                for (int j = 0; j < 3; ++j) { wg[j] = wga[n][j]; wv[j] = wva[n][j]; }
                const int sw = wr == 1 ? wave - 4 : wave + 4, sai = wr == 1 ? ai : 0; const bool has = (wr == 1) || (ai == 1);
                const int hb = (((((sw * 2 + sai) * 2 + 0) * 2 + n) * 4 + fq) * 2) << 2, hv = (((((sw * 2 + sai) * 2 + 1) * 2 + n) * 4 + fq) * 2) << 2;
                const f32x4 z4 = (f32x4){0.f, 0.f, 0.f, 0.f};
                const f32x4 g62 = has ? *(const PG8_LAS f32x4*)(ex + hb) : z4, g63 = has ? *(const PG8_LAS f32x4*)(ex + hb + 4) : z4;
                const f32x4 v62 = has ? *(const PG8_LAS f32x4*)(ex + hv) : z4, v63 = has ? *(const PG8_LAS f32x4*)(ex + hv + 4) : z4;
                f32x4 gp3, gp2, vp3, vp2;
#pragma unroll
                for (int e = 0; e < 4; ++e) { gp3[e] = DPP_F(g63[e], acc[ai][0][3][n][e], 0x111); gp2[e] = DPP_F(g62[e], acc[ai][0][2][n][e], 0x111);
                                              vp3[e] = DPP_F(v63[e], acc[ai][1][3][n][e], 0x111); vp2[e] = DPP_F(v62[e], acc[ai][1][2][n][e], 0x111); }
#pragma unroll
                for (int m = 0; m < 4; ++m) {
                    const int rl = ai * HALF + wr * 64 + 4 * fr + m, row = u.pm * 254 - 2 + rl;
                    const f32x4 g0 = acc[ai][0][m][n], v0 = acc[ai][1][m][n];
                    const f32x4 g1 = m == 0 ? gp3 : acc[ai][0][m > 0 ? m - 1 : 0][n], g2 = m == 0 ? gp2 : (m == 1 ? gp3 : acc[ai][0][m > 1 ? m - 2 : 0][n]);
                    const f32x4 v1 = m == 0 ? vp3 : acc[ai][1][m > 0 ? m - 1 : 0][n], v2 = m == 0 ? vp2 : (m == 1 ? vp3 : acc[ai][1][m > 1 ? m - 2 : 0][n]);
                    f32x4 ov;
#pragma unroll
                    for (int e = 0; e < 4; ++e) {
                        const float ug = wg[2][e] * g0[e] + wg[1][e] * g1[e] + wg[0][e] * g2[e], uv = wv[2][e] * v0[e] + wv[1][e] * v1[e] + wv[0][e] * v2[e];
                        ov[e] = ug * __builtin_amdgcn_rcpf(1.0f + __expf(-ug)) * uv;
                    }
                    u32x2 w; w.x = cvt_pk_bf16(ov[0], ov[1]); w.y = cvt_pk_bf16(ov[2], ov[3]);
                    if (n == 0) held[m] = w;
                    else { const int rowc = (rl >= 2 && row < Mrows) ? row : Mrows;
                        *(u32x4*)(ACT + (size_t)rowc * DFFc + cg) = (u32x4){held[m].x, held[m].y, w.x, w.y}; }
                }
            }
        }
    }
};
struct EpiX1 {
    static constexpr bool PERM = true, AFTER_DRAIN = false, KEEP = false, APERM = false;
    const float* X; bf16_t* X1B; float* rss; int ldc;
    __device__ __forceinline__ void operator()(f32x4 (&acc)[2][2][4][2], const Unit& u, int wr, int wc, int fr, int fq) const {
        const int row0 = u.pm * BM + wr * 64 + fr, col0 = u.pn * BM + wc * 32 + 8 * fq;
#pragma unroll
        for (int ai = 0; ai < 2; ++ai) {
            f32x4 xq[4][2][2];
#pragma unroll
            for (int m = 0; m < 4; ++m)
#pragma unroll
                for (int bj = 0; bj < 2; ++bj) { const size_t o = (size_t)(row0 + ai * HALF + m * 16) * ldc + col0 + bj * HALF; xq[m][bj][0] = *(const f32x4*)(X + o); xq[m][bj][1] = *(const f32x4*)(X + o + 4); }
#pragma unroll
            for (int m = 0; m < 4; ++m) { const int row = row0 + ai * HALF + m * 16; const size_t ro = (size_t)row * ldc + col0; float ss = 0.f;
#pragma unroll
                for (int bj = 0; bj < 2; ++bj) { const size_t o = ro + bj * HALF;
                    const f32x4 v0 = xq[m][bj][0] + acc[ai][bj][m][0], v1 = xq[m][bj][1] + acc[ai][bj][m][1];
                    ss += (v0[0] * v0[0] + v0[1] * v0[1]) + (v0[2] * v0[2] + v0[3] * v0[3]) + (v1[0] * v1[0] + v1[1] * v1[1]) + (v1[2] * v1[2] + v1[3] * v1[3]);
                    *(u32x4*)(X1B + o) = pack8(v0, v1); }
                ss += __shfl_xor(ss, 16); ss += __shfl_xor(ss, 32);
                if (fq == 0) unsafeAtomicAdd(rss + row, ss); }
        }
    }
};
struct EpiX2 {
    static constexpr bool PERM = true, AFTER_DRAIN = false, KEEP = false, APERM = false;
    const bf16_t* X1B; bf16_t* XN; int ldc;
    __device__ __forceinline__ void operator()(f32x4 (&acc)[2][2][4][2], const Unit& u, int wr, int wc, int fr, int fq) const {
        const int row0 = u.pm * BM + wr * 64 + fr, col0 = u.pn * BM + wc * 32 + 8 * fq;
        u32x4 tq[2][4][2];
#pragma unroll
        for (int ai = 0; ai < 2; ++ai)
#pragma unroll
            for (int m = 0; m < 4; ++m)
#pragma unroll
                for (int bj = 0; bj < 2; ++bj) tq[ai][m][bj] = *(const u32x4*)(X1B + (size_t)(row0 + ai * HALF + m * 16) * ldc + col0 + bj * HALF);
#pragma unroll
        for (int ai = 0; ai < 2; ++ai)
#pragma unroll
            for (int m = 0; m < 4; ++m)
#pragma unroll
                for (int bj = 0; bj < 2; ++bj) { const size_t o = (size_t)(row0 + ai * HALF + m * 16) * ldc + col0 + bj * HALF; const u32x4 t = tq[ai][m][bj];
                    f32x4 v0 = acc[ai][bj][m][0], v1 = acc[ai][bj][m][1];
                    v0[0] += bf_lo(t.x); v0[1] += bf_hi(t.x); v0[2] += bf_lo(t.y); v0[3] += bf_hi(t.y); v1[0] += bf_lo(t.z); v1[1] += bf_hi(t.z); v1[2] += bf_lo(t.w); v1[3] += bf_hi(t.w);
                    *(u32x4*)(XN + o) = pack8(v0, v1); }
    }
};
struct EpiOut {
    static constexpr bool PERM = true, AFTER_DRAIN = false, KEEP = false, APERM = false;
    const bf16_t* XN; const bf16_t* PP; float* out; int ldc;
    __device__ __forceinline__ void operator()(f32x4 (&acc)[2][2][4][2], const Unit& u, int wr, int wc, int fr, int fq) const {
        const int row0 = u.pm * BM + wr * 64 + fr, col0 = u.pn * BM + wc * 32 + 8 * fq;
#pragma unroll
        for (int ai = 0; ai < 2; ++ai) {
            u32x4 tq[4][2], pq[4][2];
#pragma unroll
            for (int m = 0; m < 4; ++m)
#pragma unroll
                for (int bj = 0; bj < 2; ++bj) { const size_t o = (size_t)(row0 + ai * HALF + m * 16) * ldc + col0 + bj * HALF; tq[m][bj] = *(const u32x4*)(XN + o); pq[m][bj] = *(const u32x4*)(PP + o); }
#pragma unroll
            for (int m = 0; m < 4; ++m)
#pragma unroll
                for (int bj = 0; bj < 2; ++bj) { const size_t o = (size_t)(row0 + ai * HALF + m * 16) * ldc + col0 + bj * HALF; const u32x4 t = tq[m][bj], p = pq[m][bj];
                    const f32x4 a0 = acc[ai][bj][m][0], a1 = acc[ai][bj][m][1]; f32x4 v0, v1;
                    v0[0] = bf_lo(t.x) + sigm(a0[0]) * bf_lo(p.x); v0[1] = bf_hi(t.x) + sigm(a0[1]) * bf_hi(p.x); v0[2] = bf_lo(t.y) + sigm(a0[2]) * bf_lo(p.y); v0[3] = bf_hi(t.y) + sigm(a0[3]) * bf_hi(p.y);
                    v1[0] = bf_lo(t.z) + sigm(a1[0]) * bf_lo(p.z); v1[1] = bf_hi(t.z) + sigm(a1[1]) * bf_hi(p.z); v1[2] = bf_lo(t.w) + sigm(a1[2]) * bf_lo(p.w); v1[3] = bf_hi(t.w) + sigm(a1[3]) * bf_hi(p.w);
                    *(f32x4*)(out + o) = v0; *(f32x4*)(out + o + 4) = v1; }
        }
    }
};

template <class Epi, class Sched, bool ALIGN_EPI = false, bool SP2 = false>
__device__ __forceinline__ void gemm_phase(PG8_LAS unsigned char* lds, const Gemm g, const Sched& S, const Epi& E) {
    const int tid = threadIdx.x, wid = __builtin_amdgcn_readfirstlane(tid >> 6), lane = tid & 63, wr = wid >> 2, wc = wid & 3, fr = lane & 15, fq = lane >> 4;
    const int K = g.K, nt = K / BK;
    unsigned voffA[2], voffB[2];
#pragma unroll
    for (int i = 0; i < 2; ++i) { int R, C; stage_rc(tid * 16 + i * 8192, R, C); const int Rb = Epi::PERM ? ((R & ~31) + perm32(R & 31)) : R;
        const int Ra = Epi::APERM ? ((R & ~63) + 4 * (R & 15) + ((R & 63) >> 4)) : R;
        voffA[i] = (unsigned)(Ra * K + C) * 2u; voffB[i] = (unsigned)(Rb * K + C) * 2u; }
    const size_t kstep = (size_t)(BK * 2);
    const size_t hstep = (size_t)HALF * K * 2;
    const size_t tstep = 2 * hstep; const size_t atstep = g.a_tstep ? g.a_tstep : tstep;
    const unsigned ldsw = (unsigned)wid * 1024u;
    const int aoff = lds_byte(wr * 64 + fr, fq * 8), boff = lds_byte(wc * 32 + fr, fq * 8);
#define PG8_SA(b, h) (((b) * 2 + (h)) * HTB)
#define PG8_SB(b, h) ((4 + (b) * 2 + (h)) * HTB)
#define PG8_STAGE(bufoff, gbase, voff) do { _Pragma("unroll") for (int _i = 0; _i < 2; ++_i) \
        __builtin_amdgcn_global_load_lds((const unsigned*)((const char*)(gbase) + (voff)[_i]), (PG8_LAS unsigned*)(lds + (bufoff) + ldsw + _i * 8192), 16, 0, 0); } while (0)
#define PG8_LDA(dst, b, h) do { _Pragma("unroll") for (int m = 0; m < 4; ++m) _Pragma("unroll") for (int k = 0; k < 2; ++k) dst[m][k] = *(const PG8_LAS bf16x8*)(lds + PG8_SA(b, h) + aoff + m * 2048 + k * 1024); } while (0)
#define PG8_LDB(dst, b, h) do { _Pragma("unroll") for (int n = 0; n < 2; ++n) _Pragma("unroll") for (int k = 0; k < 2; ++k) dst[n][k] = *(const PG8_LAS bf16x8*)(lds + PG8_SB(b, h) + boff + n * 2048 + k * 1024); } while (0)
#define PG8_MMA(ai, bj, At, Bt) do { __builtin_amdgcn_s_setprio(1); _Pragma("unroll") for (int k = 0; k < 2; ++k) _Pragma("unroll") for (int m = 0; m < 4; ++m) _Pragma("unroll") for (int n_ = 0; n_ < 2; ++n_) { const int n = (m & 1) ? 1 - n_ : n_; \
        acc[ai][bj][m][n] = __builtin_amdgcn_mfma_f32_16x16x32_bf16(Bt[n][k], At[m][k], acc[ai][bj][m][n], 0, 0, 0); } __builtin_amdgcn_s_setprio(0); } while (0)
#define PG8_WAIT_V(n) asm volatile("s_waitcnt vmcnt(" #n ")" ::: "memory")
#define PG8_WAIT_L(n) asm volatile("s_waitcnt lgkmcnt(" #n ")" ::: "memory")
#define PG8_BAR __builtin_amdgcn_s_barrier()
#define PG8_SCHED __builtin_amdgcn_sched_barrier(0)
    Unit cur, nxt; int ui = 0;
    if (!S.next(0, cur)) return;
    f32x4 acc[2][2][4][2];
#pragma unroll
    for (int a = 0; a < 2; ++a)
#pragma unroll
        for (int b = 0; b < 2; ++b)
#pragma unroll
            for (int m = 0; m < 4; ++m)
#pragma unroll
                for (int n = 0; n < 2; ++n) acc[a][b][m][n] = (f32x4){0.f, 0.f, 0.f, 0.f};
    bf16x8 At[4][2], B0[2][2], B1[2][2];
    const char* cA = (const char*)g.A + (size_t)cur.pm * atstep + (cur.aux ? g.a_jump : 0); const char* cB = (const char*)g.Bt + (size_t)cur.pn * tstep + (cur.aux ? g.b_jump : 0);
    S.a_ready(cur);
    if constexpr (SP2) {
        PG8_STAGE(PG8_SB(0, 0), cB, voffB); PG8_STAGE(PG8_SB(0, 1), cB + hstep, voffB); PG8_STAGE(PG8_SA(0, 0), cA, voffA); PG8_STAGE(PG8_SA(0, 1), cA + hstep, voffA);
        if (wr == 1) PG8_BAR;
        PG8_WAIT_V(2); PG8_BAR;
        PG8_STAGE(PG8_SB(1, 0), cB + kstep, voffB); PG8_STAGE(PG8_SA(1, 0), cA + kstep, voffA); PG8_STAGE(PG8_SB(1, 1), cB + hstep + kstep, voffB);
        PG8_WAIT_V(6); PG8_BAR;
    } else {
        PG8_STAGE(PG8_SB(0, 0), cB, voffB); PG8_STAGE(PG8_SA(0, 0), cA, voffA); PG8_STAGE(PG8_SB(0, 1), cB + hstep, voffB); PG8_STAGE(PG8_SA(0, 1), cA + hstep, voffA);
        if (wr == 1) PG8_BAR;
        PG8_WAIT_V(4); PG8_BAR;
        PG8_STAGE(PG8_SB(1, 0), cB + kstep, voffB); PG8_STAGE(PG8_SA(1, 0), cA + kstep, voffA); PG8_STAGE(PG8_SB(1, 1), cB + hstep + kstep, voffB);
        PG8_WAIT_V(6); PG8_BAR;
    }
    for (;;) {
        const bool has_next = S.next(ui + 1, nxt);
        const char* nA = has_next ? (const char*)g.A + (size_t)nxt.pm * atstep + (nxt.aux ? g.a_jump : 0) : cA; const char* nB = has_next ? (const char*)g.Bt + (size_t)nxt.pn * tstep + (nxt.aux ? g.b_jump : 0) : cB;
        for (int t = 0; t < nt; t += 2) {
            const bool last = (t == nt - 2);
            const char* a1 = cA + (size_t)(t + 1) * kstep;
            const char* a2 = last ? nA : cA + (size_t)(t + 2) * kstep; const char* b2 = last ? nB : cB + (size_t)(t + 2) * kstep;
            const char* a3 = a2 + kstep; const char* b3 = b2 + kstep;
            if (last && has_next) S.a_ready(nxt);
            if constexpr (SP2) {
            PG8_LDB(B0, 0, 0); PG8_LDB(B1, 0, 1); PG8_SCHED; PG8_LDA(At, 0, 0); PG8_STAGE(PG8_SA(1, 1), a1 + hstep, voffA);
            PG8_WAIT_V(8); PG8_WAIT_L(0); PG8_BAR; PG8_MMA(0, 0, At, B0); PG8_MMA(0, 1, At, B1); PG8_BAR; PG8_SCHED;
            PG8_LDA(At, 0, 1); PG8_STAGE(PG8_SB(0, 0), b2, voffB); PG8_STAGE(PG8_SB(0, 1), b2 + hstep, voffB); PG8_STAGE(PG8_SA(0, 0), a2, voffA);
            PG8_WAIT_V(8); PG8_WAIT_L(0); PG8_BAR; PG8_MMA(1, 0, At, B0); PG8_MMA(1, 1, At, B1); PG8_BAR; PG8_SCHED;
            PG8_LDB(B0, 1, 0); PG8_LDB(B1, 1, 1); PG8_SCHED; PG8_LDA(At, 1, 0); PG8_STAGE(PG8_SA(0, 1), a2 + hstep, voffA);
            PG8_WAIT_V(8); PG8_WAIT_L(0); PG8_BAR; PG8_MMA(0, 0, At, B0); PG8_MMA(0, 1, At, B1); PG8_BAR; PG8_SCHED;
            PG8_LDA(At, 1, 1); PG8_STAGE(PG8_SB(1, 0), b3, voffB); PG8_STAGE(PG8_SB(1, 1), b3 + hstep, voffB); PG8_STAGE(PG8_SA(1, 0), a3, voffA);
            PG8_WAIT_V(8); PG8_WAIT_L(0); PG8_BAR; PG8_MMA(1, 0, At, B0); PG8_MMA(1, 1, At, B1); PG8_BAR; PG8_SCHED;
            } else {
            PG8_LDB(B0, 0, 0); PG8_SCHED; PG8_LDA(At, 0, 0); PG8_STAGE(PG8_SA(1, 1), a1 + hstep, voffA);
            PG8_WAIT_L(8); PG8_BAR; PG8_WAIT_L(0); PG8_MMA(0, 0, At, B0); PG8_BAR; PG8_SCHED;
            PG8_LDB(B1, 0, 1); PG8_STAGE(PG8_SB(0, 0), b2, voffB);
            PG8_BAR; PG8_WAIT_L(0); PG8_MMA(0, 1, At, B1); PG8_BAR;
            PG8_LDA(At, 0, 1); PG8_STAGE(PG8_SA(0, 0), a2, voffA);
            PG8_BAR; PG8_WAIT_L(0); PG8_MMA(1, 0, At, B0); PG8_BAR; PG8_SCHED;
            PG8_STAGE(PG8_SB(0, 1), b2 + hstep, voffB);
            PG8_WAIT_V(6); PG8_BAR; PG8_MMA(1, 1, At, B1); PG8_BAR;
            PG8_LDB(B0, 1, 0); PG8_SCHED; PG8_LDA(At, 1, 0); PG8_STAGE(PG8_SA(0, 1), a2 + hstep, voffA);
            PG8_WAIT_L(8); PG8_BAR; PG8_WAIT_L(0); PG8_MMA(0, 0, At, B0); PG8_BAR; PG8_SCHED;
            PG8_LDB(B1, 1, 1); PG8_STAGE(PG8_SB(1, 0), b3, voffB);
            PG8_BAR; PG8_WAIT_L(0); PG8_MMA(0, 1, At, B1); PG8_BAR;
            PG8_LDA(At, 1, 1); PG8_STAGE(PG8_SA(1, 0), a3, voffA);
            PG8_BAR; PG8_WAIT_L(0); PG8_MMA(1, 0, At, B0); PG8_BAR; PG8_SCHED;
            PG8_STAGE(PG8_SB(1, 1), b3 + hstep, voffB);
            PG8_WAIT_V(6); PG8_BAR; PG8_MMA(1, 1, At, B1); PG8_BAR;
            }
        }
        if constexpr (ALIGN_EPI) { if (wr == 0) PG8_BAR; }
        asm volatile("s_nop 15\n\ts_nop 7" ::: "memory");
        if constexpr (!Epi::AFTER_DRAIN) { E(acc, cur, wr, wc, fr, fq); S.done(cur); }
        if (!has_next) break;
        if (!Epi::KEEP || cur.aux != 0) {
#pragma unroll
        for (int a = 0; a < 2; ++a)
#pragma unroll
            for (int b = 0; b < 2; ++b)
#pragma unroll
                for (int m = 0; m < 4; ++m)
#pragma unroll
                    for (int n = 0; n < 2; ++n) acc[a][b][m][n] = (f32x4){0.f, 0.f, 0.f, 0.f};
        }
        cur = nxt; cA = nA; cB = nB; ++ui;
        if constexpr (ALIGN_EPI) { if (wr == 1) PG8_BAR; }
    }
    PG8_WAIT_V(0);
    if constexpr (!ALIGN_EPI) { if (wr == 0) PG8_BAR; }
    PG8_BAR;
    if constexpr (Epi::AFTER_DRAIN) { E.fused(acc, cur, wr, wc, fr, fq, lds, wid, lane); S.done(cur); }
#undef PG8_SA
#undef PG8_SB
#undef PG8_STAGE
#undef PG8_LDA
#undef PG8_LDB
#undef PG8_MMA
#undef PG8_WAIT_V
#undef PG8_WAIT_L
#undef PG8_BAR
#undef PG8_SCHED
}
}
#define GAS __attribute__((address_space(1)))
#define LAS __attribute__((address_space(3)))
typedef unsigned short bf16;
typedef unsigned v4u __attribute__((ext_vector_type(4)));
typedef float f32x4 __attribute__((ext_vector_type(4)));
typedef short bf16x8 __attribute__((ext_vector_type(8)));
typedef GAS unsigned gu32;
typedef GAS unsigned long long gu64;
#define RLX_AGENT __ATOMIC_RELAXED, __HIP_MEMORY_SCOPE_AGENT
#define LDS_WAIT() asm volatile("s_waitcnt lgkmcnt(0)" ::: "memory")
#define VM_WAIT() asm volatile("s_waitcnt vmcnt(0)" ::: "memory")
__device__ __forceinline__ unsigned long long rt() { return __builtin_amdgcn_s_memrealtime(); }
__device__ __forceinline__ unsigned f2bf(float f) { unsigned u = __builtin_bit_cast(unsigned, f); return (u + 0x7fffu + ((u >> 16) & 1u)) >> 16; }
typedef float pk2_f32x2 __attribute__((ext_vector_type(2))); typedef __bf16 pk2_bf16x2 __attribute__((ext_vector_type(2)));
__device__ __forceinline__ unsigned pk2(float lo, float hi) { pk2_f32x2 v = {lo, hi}; pk2_bf16x2 b = __builtin_convertvector(v, pk2_bf16x2); return __builtin_bit_cast(unsigned, b); }

#define XB_TMO      128
#define XB_XCNT(j)  (256  + 64 * (j))
#define XB_XSUB(j)  (1280 + 64 * (j))
#define XB_XGEN(j)  (2304 + 64 * (j))
#define XB_TOP      3328
#define XB_TOPGEN   3392
#define XCD_BAR_WORDS 3456
#define XB_SPIN_CAP (1u << 18)

__device__ __forceinline__ unsigned xb_ld(unsigned* p)              { return __hip_atomic_load(p, __ATOMIC_RELAXED, __HIP_MEMORY_SCOPE_AGENT); }
__device__ __forceinline__ unsigned xb_add(unsigned* p, unsigned v) { return __hip_atomic_fetch_add(p, v, __ATOMIC_RELAXED, __HIP_MEMORY_SCOPE_AGENT); }
__device__ __forceinline__ unsigned xb_xcc_id() { return (unsigned)__builtin_amdgcn_s_getreg((3 << 11) | 20) & 0xFu; }
#define XB_SPIN(cond, bar) do { unsigned _sp = 0; while (cond) { __builtin_amdgcn_s_sleep(1); \
    if ((++_sp & 255u) == 0u) { if (xb_ld(&(bar)[XB_TMO])) break; if (_sp > XB_SPIN_CAP) { atomicAdd(&(bar)[XB_TMO], 1u); break; } } } } while (0)

struct XcdBarrier {
    unsigned* bar; unsigned x;
    volatile LAS unsigned* st;
};

__device__ __forceinline__ XcdBarrier xcd_barrier_post(unsigned* bar, volatile LAS unsigned* st) {
    XcdBarrier b; b.bar = bar; b.x = xb_xcc_id(); b.st = st;
    if (threadIdx.x == 0) (void)xb_add(&bar[XB_XCNT(b.x)], 1u);
    return b;
}
__device__ __forceinline__ void xcd_barrier_complete(unsigned* bar, unsigned x, unsigned& nloc, unsigned& nx) {
    const unsigned G = gridDim.x * gridDim.y * gridDim.z;
    unsigned sum, cnt, mine, sp = 0u;
    for (;;) {
        sum = 0u; cnt = 0u; mine = 0u;
#pragma unroll
        for (unsigned j = 0; j < 16; ++j) { const unsigned c = xb_ld(&bar[XB_XCNT(j)]); sum += c; cnt += (c > 0u) ? 1u : 0u; mine = (j == x) ? c : mine; }
        if (sum == G) break;
        __builtin_amdgcn_s_sleep(1);
        if ((++sp & 255u) == 0u) { if (xb_ld(&bar[XB_TMO])) break; if (sp > XB_SPIN_CAP) { atomicAdd(&bar[XB_TMO], 1u); break; } }
    }
    nloc = mine > 0u ? mine : 1u; nx = cnt > 0u ? cnt : 1u;
}

__device__ __forceinline__ void xcd_barrier(const XcdBarrier& b) {
    asm volatile("s_waitcnt vmcnt(0)" ::: "memory");
    __syncthreads();
    if (threadIdx.x == 0) {
        unsigned* bar = b.bar;
        __builtin_amdgcn_s_waitcnt(0);
        unsigned nloc = b.st[0], nx = b.st[1];
        if (nloc == 0u) { xcd_barrier_complete(bar, b.x, nloc, nx); b.st[0] = nloc; b.st[1] = nx; }
        const unsigned old = xb_add(&bar[XB_XSUB(b.x)], 1u);
        const unsigned gen = old / nloc;
        if (old + 1u == (gen + 1u) * nloc) {
            __builtin_amdgcn_fence(__ATOMIC_RELEASE, "agent");
            asm volatile("s_waitcnt vmcnt(0)" ::: "memory");
            const unsigned og = xb_add(&bar[XB_TOP], 1u);
            const unsigned tg = og / nx;
            if (og + 1u == (tg + 1u) * nx) xb_add(&bar[XB_TOPGEN], 1u);
            else XB_SPIN(xb_ld(&bar[XB_TOPGEN]) == tg, bar);
            __builtin_amdgcn_fence(__ATOMIC_ACQUIRE, "agent");
            xb_add(&bar[XB_XGEN(b.x)], 1u);
            asm volatile("s_waitcnt vmcnt(0)" ::: "memory");
        } else {
            XB_SPIN(xb_ld(&bar[XB_XGEN(b.x)]) == gen, bar);
            __builtin_amdgcn_fence(__ATOMIC_ACQUIRE, "agent");
            asm volatile("s_waitcnt vmcnt(0)" ::: "memory");
        }
    }
    __syncthreads();
}

constexpr int NWAVES = 8;
constexpr int M = 16384, D = 4096, DIN = 20480, DA = 2048, NH = 16, HD = 128, DFF = 11008, DFH = 5504, DPLE = 256, NBLK = 64, BLK = 256;
constexpr float RMS_EPS = 1e-6f;
constexpr float ATT_SCALE = 0.08838834764831845f;
#ifndef MK_PER_PHASE
#define MK_PER_PHASE 0
#endif
#ifndef PROBE_PHASE
#define PROBE_PHASE -1
#endif
#ifndef PROBE_FLAGS
#define PROBE_FLAGS 0
#endif
constexpr int NPH = 17;
#ifndef GEMM_WGM
#define GEMM_WGM 4
#endif

constexpr size_t MiB = 1u << 20;
constexpr size_t WS_CTL = 0, CTL_ZERO_BYTES = 1 * MiB;
constexpr size_t WS_KMH = 1 * MiB, WS_KML = 1 * MiB + 256 * 1024;
constexpr size_t WS_LSE = 2 * MiB;
constexpr size_t WS_PB = 8 * MiB;
constexpr size_t WS_WUP = 16 * MiB, WS_WDN = 188 * MiB, WS_WPG = 274 * MiB, WS_WP = 306 * MiB;
constexpr size_t WS_XN = 309 * MiB;
constexpr size_t WS_WO = 438 * MiB, WS_WA = 470 * MiB, WS_WC = 486 * MiB, WS_WIN = 502 * MiB;
constexpr size_t WS_Z = 662 * MiB;
constexpr size_t WS_Q = WS_Z, WS_K = WS_Z + 64 * MiB, WS_V = WS_Z + 128 * MiB, WS_CB = WS_Z + 192 * MiB, WS_CC = WS_Z + 256 * MiB, WS_CX = WS_Z + 320 * MiB, WS_GA = WS_Z + 384 * MiB, WS_GC = WS_Z + 512 * MiB;
constexpr size_t WS_LIST = 1302 * MiB;
constexpr size_t WS_TAB = 1336 * MiB;
constexpr size_t WS_END = 1344 * MiB;
constexpr size_t WS_S0 = WS_XN, WS_S1 = WS_XN + 64 * MiB, WS_S2 = WS_CC;
constexpr size_t WS_T1 = WS_XN, WS_MERGED = WS_K, WS_PP = WS_GC, WS_Y = 438 * MiB, WS_ACT = 782 * MiB;
constexpr size_t WS_X1B = 502 * MiB;
static_assert(WS_Y + (size_t)M * DFF * 2 <= WS_ACT && WS_ACT + (size_t)(M + 1) * DFF * 2 <= WS_PP && WS_LIST + (size_t)16 * 516096 * 4 <= WS_TAB && WS_GC + 128 * MiB == WS_LIST, "d_ws map");
constexpr int CW_TMO = 0, CW_CODE = 1, CW_QHEAD = 64, CW_BAR = 4096, CW_CNT = 16384, CW_RSS = 32768;
constexpr int LIST_PER_HEAD = 516096;
__host__ __device__ __forceinline__ int list_base(int h, int j) { return h * LIST_PER_HEAD + 256 * (63 * j - (j * (j - 1)) / 2); }

constexpr int RING_OFF = 0, RING_BYTES = 131072;
constexpr int MISC_OFF = 153600;
constexpr int LDS_BYTES = 155648;

struct Args { const void* in[17]; float* out; unsigned char* ws; int ph_lo, ph_hi, use_bar, bar_off, flags, pad; };

__device__ __forceinline__ float wave_sum(float v) {
#pragma unroll
    for (int o = 1; o < 64; o <<= 1) v += __shfl_xor(v, o);
    return v;
}
__device__ __forceinline__ float wave_max(float v) {
#pragma unroll
    for (int o = 1; o < 64; o <<= 1) v = fmaxf(v, __shfl_xor(v, o));
    return v;
}
__device__ __forceinline__ float bflo(unsigned w) { return __uint_as_float(w << 16); }
__device__ __forceinline__ float bfhi(unsigned w) { return __uint_as_float(w & 0xffff0000u); }

template <int RM> __device__ __forceinline__ int rowmap(int n) {
    if (RM == 0) return n;
    if (RM == 2) {
        if (n < 6 * DA) return n;
        const int g = n - 6 * DA; return g < D ? 6 * DA + (g >> 7) * 256 + (g & 127) : 6 * DA + ((g - D) >> 7) * 256 + 128 + ((g - D) & 127);
    }
    if (n < DFF) return (n >> 7) * 256 + (n & 127);
    const int n2 = n - DFF; return (n2 >> 7) * 256 + 128 + (n2 & 127);
}
template <int RM> __device__ __forceinline__ void p0_transpose_item(const float* W, int K, int N, bf16* WT, LAS float* scrf, int item, int lane, const float* kscale = nullptr) {
    LAS unsigned* scr = (LAS unsigned*)scrf;
    const int nblk = N / 64, kb = item / nblk, nb = item % nblk, k0 = 64 * kb, n0 = 64 * nb;
    const float* src = W + (size_t)k0 * N + n0 + lane;
    float v[64];
#pragma unroll
    for (int i = 0; i < 64; ++i) v[i] = __builtin_nontemporal_load(src + (size_t)i * N);
    if (kscale) {
#pragma unroll
        for (int i = 0; i < 64; ++i) v[i] *= kscale[k0 + i]; }
#pragma unroll
    for (int i = 0; i < 32; ++i) scr[i * 65 + lane] = pk2(v[2 * i], v[2 * i + 1]);
    LDS_WAIT(); asm volatile("" ::: "memory");
    const int c = lane & 7, nl = lane >> 3;
#pragma unroll
    for (int j = 0; j < 8; ++j) { const int n = nl + 8 * j; const LAS unsigned* s = scr + (4 * c) * 65 + n;
        v4u o; o.x = s[0 * 65]; o.y = s[1 * 65]; o.z = s[2 * 65]; o.w = s[3 * 65];
        *(v4u*)(WT + (size_t)rowmap<RM>(n0 + n) * K + k0 + 8 * c) = o; }
    LDS_WAIT(); asm volatile("" ::: "memory");
}
__device__ __forceinline__ void rms_row_to_bf16(const float* xrow, const f32x4 (&gv)[16], bf16* orow, int lane) {
    const f32x4* xr = (const f32x4*)xrow + lane;
    f32x4 v[16]; float s = 0.f;
#pragma unroll
    for (int j = 0; j < 16; ++j) { v[j] = __builtin_nontemporal_load(xr + 64 * j); s += (v[j].x * v[j].x + v[j].y * v[j].y) + (v[j].z * v[j].z + v[j].w * v[j].w); }
    const float r = 1.0f / sqrtf(wave_sum(s) * (1.f / D) + RMS_EPS);
    unsigned long long* o8 = (unsigned long long*)orow + lane;
#pragma unroll
    for (int j = 0; j < 16; ++j)
        o8[64 * j] = (unsigned long long)pk2(v[j].x * r * gv[j].x, v[j].y * r * gv[j].y) | ((unsigned long long)pk2(v[j].z * r * gv[j].z, v[j].w * r * gv[j].w) << 32);
}

__device__ __forceinline__ void p0_weights(LAS unsigned char* lds, const Args& a, int wave, int lane, int gw, int NGW, int part) {
    unsigned char* ws = a.ws;
    LAS float* scr = (LAS float*)lds + wave * (64 * 65);
    constexpr int I_IN = (D / 64) * (DIN / 64), I_A = (DA / 64) * (D / 64), I_O = (D / 64) * (D / 64), I_UP = (D / 64) * (2 * DFF / 64), I_DN = (DFF / 64) * (D / 64), I_P = (DPLE / 64) * (D / 64);
    if (part == 0) {
        for (int it = gw; it < I_IN + I_UP + 2 * I_A + I_O + I_P; it += NGW) {
            int r = it;
            if (r < I_IN) { p0_transpose_item<2>((const float*)a.in[4], D, DIN, (bf16*)(ws + WS_WIN), scr, r, lane); continue; } r -= I_IN;
            if (r < I_UP) { p0_transpose_item<1>((const float*)a.in[12], D, 2 * DFF, (bf16*)(ws + WS_WUP), scr, r, lane, (const float*)a.in[11]); continue; } r -= I_UP;
            if (r < I_A) { p0_transpose_item<0>((const float*)a.in[8], DA, D, (bf16*)(ws + WS_WA), scr, r, lane); continue; } r -= I_A;
            if (r < I_A) { p0_transpose_item<0>((const float*)a.in[9], DA, D, (bf16*)(ws + WS_WC), scr, r, lane); continue; } r -= I_A;
            if (r < I_O) { p0_transpose_item<0>((const float*)a.in[10], D, D, (bf16*)(ws + WS_WO), scr, r, lane); continue; } r -= I_O;
            p0_transpose_item<0>((const float*)a.in[15], DPLE, D, (bf16*)(ws + WS_WP), scr, r, lane);
        }
    } else {
        for (int it = gw; it < I_UP + I_DN + I_O; it += NGW) {
            int r = it;
            if (r < I_UP) { p0_transpose_item<1>((const float*)a.in[12], D, 2 * DFF, (bf16*)(ws + WS_WUP), scr, r, lane, (const float*)a.in[11]); continue; } r -= I_UP;
            if (r < I_DN) { p0_transpose_item<0>((const float*)a.in[14], DFF, D, (bf16*)(ws + WS_WDN), scr, r, lane); continue; } r -= I_DN;
            p0_transpose_item<0>((const float*)a.in[16], D, D, (bf16*)(ws + WS_WPG), scr, r, lane);
        }
    }
}
constexpr int CW_CONVQ = CW_QHEAD + 128;
struct P0It { const float* src; bf16* WT; int N, K, k0, n0; };
__device__ __forceinline__ P0It p0_late_resolve(const Args& a, unsigned char* ws, int it) {
    constexpr int I_DN = (DFF / 64) * (D / 64);
    P0It d; int r = it;
    if (r < I_DN) { d.N = D; d.K = DFF; d.WT = (bf16*)(ws + WS_WDN); d.src = (const float*)a.in[14]; }
    else { r -= I_DN; d.N = D; d.K = D; d.WT = (bf16*)(ws + WS_WPG); d.src = (const float*)a.in[16]; }
    const int nblk = d.N / 64, kb = r / nblk, nb = r % nblk; d.k0 = 64 * kb; d.n0 = 64 * nb;
    d.src += (size_t)d.k0 * d.N + d.n0;
    return d;
}
__device__ __forceinline__ void p0_late_load(const P0It& d, float (&v)[64], int lane) {
    const float* sp = d.src + lane;
#pragma unroll
    for (int i = 0; i < 64; ++i) v[i] = __builtin_nontemporal_load(sp + (size_t)i * d.N);
}
__device__ __forceinline__ void p0_late_finish(const P0It& d, float (&v)[64], LAS unsigned* scr, int lane) {
#pragma unroll
    for (int i = 0; i < 32; ++i) scr[i * 65 + lane] = pk2(v[2 * i], v[2 * i + 1]);
    LDS_WAIT(); asm volatile("" ::: "memory");
    const int c = lane & 7, nl = lane >> 3;
#pragma unroll
    for (int j = 0; j < 8; ++j) { const int n = nl + 8 * j; const LAS unsigned* s = scr + (4 * c) * 65 + n;
        v4u o; o.x = s[0 * 65]; o.y = s[1 * 65]; o.z = s[2 * 65]; o.w = s[3 * 65];
        *(v4u*)(d.WT + (size_t)(d.n0 + n) * d.K + d.k0 + 8 * c) = o; }
    LDS_WAIT(); asm volatile("" ::: "memory");
}
__device__ __forceinline__ void p0_late_weights_queue(LAS unsigned char* lds, const Args& a, gu32* ctl) {
    int tl_ = threadIdx.x; asm volatile("" : "+v"(tl_)); int lane = tl_ & 63; const int wave = __builtin_amdgcn_readfirstlane(tl_ >> 6);
    asm volatile("" : "+v"(lane));
    unsigned char* ws = a.ws;
    LAS unsigned* scr = (LAS unsigned*)((LAS float*)lds + wave * (64 * 65));
    constexpr int I_O = (D / 64) * (D / 64), I_DN = (DFF / 64) * (D / 64), NIT = I_DN + I_O, CH = 16, NCH = NIT / CH;
    static_assert(NIT % CH == 0, "whole chunks");
    unsigned c = 0u; if (lane == 0) c = __hip_atomic_fetch_add((unsigned*)ctl + CW_CONVQ, 1u, __ATOMIC_RELAXED, __HIP_MEMORY_SCOPE_AGENT);
    c = (unsigned)__builtin_amdgcn_readfirstlane((int)c);
    while (c < (unsigned)NCH) {
        unsigned cn = 0u; if (lane == 0) cn = __hip_atomic_fetch_add((unsigned*)ctl + CW_CONVQ, 1u, __ATOMIC_RELAXED, __HIP_MEMORY_SCOPE_AGENT);
        const int i0 = (int)c * CH;
        float va[64], vb[64];
        P0It da = p0_late_resolve(a, ws, i0), db = da; p0_late_load(da, va, lane);
#pragma unroll 1
        for (int q = 0; q < CH; q += 2) {
            db = p0_late_resolve(a, ws, i0 + q + 1); p0_late_load(db, vb, lane);
            p0_late_finish(da, va, scr, lane);
            if (q + 2 < CH) { da = p0_late_resolve(a, ws, i0 + q + 2); p0_late_load(da, va, lane); }
            p0_late_finish(db, vb, scr, lane);
        }
        c = (unsigned)__builtin_amdgcn_readfirstlane((int)cn);
    }
}
__device__ __forceinline__ void p0_prologue(LAS unsigned char* lds, const Args& a, int G, int wave, int lane) {
    unsigned char* ws = a.ws;
    const int gw = blockIdx.x * NWAVES + wave, NGW = G * NWAVES;
    p0_weights(lds, a, wave, lane, gw, NGW, 0);
    const float* x = (const float*)a.in[0]; const float* g1 = (const float*)a.in[3]; bf16* XN = (bf16*)(ws + WS_XN);
    f32x4 gv[16];
#pragma unroll
    for (int j = 0; j < 16; ++j) gv[j] = ((const f32x4*)g1)[lane + 64 * j];
    for (int m = gw; m < M; m += NGW) rms_row_to_bf16(x + (size_t)m * D, gv, XN + (size_t)m * D, lane);
    const f32x4* p4 = (const f32x4*)a.in[1]; v4u* pb = (v4u*)(ws + WS_PB);
    for (int i = gw * 64 + lane; i < M * DPLE / 8; i += NGW * 64) { const f32x4 u0 = p4[2 * i], u1 = p4[2 * i + 1]; v4u o; o.x = pk2(u0.x, u0.y); o.y = pk2(u0.z, u0.w); o.z = pk2(u1.x, u1.y); o.w = pk2(u1.z, u1.w); pb[i] = o; }
}

__device__ __forceinline__ void p0_rope_table(unsigned char* ws, const int* pos, int G, int wave, int lane) {
    typedef float f32x2v __attribute__((ext_vector_type(2)));
    f32x2v* tab = (f32x2v*)(ws + WS_TAB);
    const float ifr = (float)pow(10000.0, -(double)lane / 64.0);
    const int gw = blockIdx.x * NWAVES + wave, NGW = G * NWAVES;
    for (int t = gw; t < M; t += NGW) { const float a = (float)pos[t] * ifr; tab[(size_t)t * 64 + lane] = (f32x2v){cosf(a), sinf(a)}; }
}
__device__ __forceinline__ void p2_qk(LAS unsigned char* lds, unsigned char* ws, const float* qn, const float* kn, int G, int tid, int nost) {
    (void)nost;
    LAS float* red = (LAS float*)lds;
    bf16* __restrict__ Qb = (bf16*)(ws + WS_Q); bf16* __restrict__ Kb = (bf16*)(ws + WS_K);
    const f32x4* tab = (const f32x4*)(ws + WS_TAB);
    bf16* kmh = (bf16*)(ws + WS_KMH); bf16* kml = (bf16*)(ws + WS_KML);
    const int gidx = tid >> 3, c = tid & 7, hl = gidx & 3, ts = gidx >> 2;
    float gq[16], gk[16];
#pragma unroll
    for (int e = 0; e < 8; ++e) { gq[e] = qn[8 * c + e]; gq[8 + e] = qn[64 + 8 * c + e]; gk[e] = kn[8 * c + e]; gk[8 + e] = kn[64 + 8 * c + e]; }
    for (int it = blockIdx.x; it < NBLK * 4; it += G) {
        const int jb = it >> 2, hg = it & 3, head = hg * 4 + hl;
        float ks[16];
#pragma unroll
        for (int e = 0; e < 16; ++e) ks[e] = 0.f;
#pragma unroll 2
        for (int i = 0; i < 16; ++i) {
            const int t = jb * BLK + 16 * i + ts;
            const f32x4* tp = tab + (size_t)t * 32 + 4 * c;
            const f32x4 cs0 = tp[0], cs1 = tp[1], cs2 = tp[2], cs3 = tp[3];
            const float cs[16] = {cs0.x, cs0.y, cs0.z, cs0.w, cs1.x, cs1.y, cs1.z, cs1.w, cs2.x, cs2.y, cs2.z, cs2.w, cs3.x, cs3.y, cs3.z, cs3.w};
#pragma unroll
            for (int ten = 0; ten < 2; ++ten) {
                bf16* ptr = (ten ? Kb : Qb) + (size_t)t * DA + head * HD + 8 * c;
                const v4u lo = *(const v4u*)ptr, hi = *(const v4u*)(ptr + 64);
                float x[16];
#pragma unroll
                for (int e = 0; e < 4; ++e) { x[2 * e] = bflo(lo[e]); x[2 * e + 1] = bfhi(lo[e]); x[8 + 2 * e] = bflo(hi[e]); x[9 + 2 * e] = bfhi(hi[e]); }
                float ss = 0.f;
#pragma unroll
                for (int e = 0; e < 16; ++e) ss += x[e] * x[e];
                ss += __shfl_xor(ss, 1); ss += __shfl_xor(ss, 2); ss += __shfl_xor(ss, 4);
                const float r = 1.0f / sqrtf(ss * (1.f / HD) + RMS_EPS);
                float o[16];
#pragma unroll
                for (int e = 0; e < 8; ++e) { const float y0 = x[e] * r * (ten ? gk[e] : gq[e]), y1 = x[8 + e] * r * (ten ? gk[8 + e] : gq[8 + e]); const float cc = cs[2 * e], sn = cs[2 * e + 1];
                    o[e] = y0 * cc - y1 * sn; o[8 + e] = y1 * cc + y0 * sn; }
                v4u wl, wh;
#pragma unroll
                for (int e = 0; e < 4; ++e) { wl[e] = pk2(o[2 * e], o[2 * e + 1]); wh[e] = pk2(o[8 + 2 * e], o[9 + 2 * e]); }
                *(v4u*)ptr = wl; *(v4u*)(ptr + 64) = wh;
                if (ten) {
#pragma unroll
                    for (int e = 0; e < 16; ++e) ks[e] += o[e]; }
            }
        }
        __syncthreads();
#pragma unroll
        for (int e = 0; e < 4; ++e) *(LAS f32x4*)(red + (gidx * 8 + c) * 16 + 4 * e) = (f32x4){ks[4 * e], ks[4 * e + 1], ks[4 * e + 2], ks[4 * e + 3]};
        __syncthreads();
        {
            const int h2 = tid >> 7, d = tid & 127, c2 = (d & 63) >> 3, e2 = (d & 7) + ((d >> 6) << 3);
            float s = 0.f;
#pragma unroll
            for (int t2 = 0; t2 < 16; ++t2) s += red[((t2 * 4 + h2) * 8 + c2) * 16 + e2];
            s *= (1.f / BLK);
            const unsigned hb = f2bf(s); const float hf = __uint_as_float(hb << 16);
            const size_t o = ((size_t)(hg * 4 + h2) * NBLK + jb) * HD + d;
            kmh[o] = (bf16)hb; kml[o] = (bf16)f2bf(s - hf);
        }
    }
}
__device__ __forceinline__ void p2_conv(unsigned char* ws, const float* cw, int G, int wave, int lane, int nost) {
    (void)nost;
    bf16* __restrict__ CB = (bf16*)(ws + WS_CB); const bf16* __restrict__ CC = (const bf16*)(ws + WS_CC); const bf16* __restrict__ CX = (const bf16*)(ws + WS_CX);
    const int gw = blockIdx.x * NWAVES + wave, NGW = G * NWAVES;
    for (int it = gw; it < (M / 32) * 4; it += NGW) {
        const int rc = it >> 2, st = it & 3, c = st * 512 + lane * 8, t0 = rc * 32;
        float w0[8], w1[8], w2[8], p1[8], p2[8];
#pragma unroll
        for (int e = 0; e < 8; ++e) { w0[e] = cw[c + e]; w1[e] = cw[DA + c + e]; w2[e] = cw[2 * DA + c + e]; p1[e] = 0.f; p2[e] = 0.f; }
        if (t0 >= 2) {
            const v4u a2 = *(const v4u*)(CC + (size_t)(t0 - 2) * DA + c), b2 = *(const v4u*)(CX + (size_t)(t0 - 2) * DA + c);
            const v4u a1 = *(const v4u*)(CC + (size_t)(t0 - 1) * DA + c), b1 = *(const v4u*)(CX + (size_t)(t0 - 1) * DA + c);
#pragma unroll
            for (int e = 0; e < 4; ++e) { p2[2 * e] = bflo(a2[e]) * bflo(b2[e]); p2[2 * e + 1] = bfhi(a2[e]) * bfhi(b2[e]); p1[2 * e] = bflo(a1[e]) * bflo(b1[e]); p1[2 * e + 1] = bfhi(a1[e]) * bfhi(b1[e]); }
        }
#pragma unroll 1
        for (int tb = 0; tb < 32; tb += 8) {
            v4u ra[8], rb[8], rg[8];
#pragma unroll
            for (int k = 0; k < 8; ++k) { const size_t o = (size_t)(t0 + tb + k) * DA + c; ra[k] = *(const v4u*)(CC + o); rb[k] = *(const v4u*)(CX + o); rg[k] = *(const v4u*)(CB + o); }
#pragma unroll
            for (int k = 0; k < 8; ++k) {
                const size_t o = (size_t)(t0 + tb + k) * DA + c;
                float pr[8], out[8];
#pragma unroll
                for (int e = 0; e < 4; ++e) { pr[2 * e] = bflo(ra[k][e]) * bflo(rb[k][e]); pr[2 * e + 1] = bfhi(ra[k][e]) * bfhi(rb[k][e]); }
#pragma unroll
                for (int e = 0; e < 8; ++e) { const float gb = (e & 1) ? bfhi(rg[k][e >> 1]) : bflo(rg[k][e >> 1]); out[e] = gb * (w2[e] * pr[e] + w1[e] * p1[e] + w0[e] * p2[e]); p2[e] = p1[e]; p1[e] = pr[e]; }
                v4u ov; ov.x = pk2(out[0], out[1]); ov.y = pk2(out[2], out[3]); ov.z = pk2(out[4], out[5]); ov.w = pk2(out[6], out[7]);
                *(v4u*)(CB + o) = ov;
            }
        }
    }
}

typedef float f32x16g __attribute__((ext_vector_type(16)));
#define P3_BETTER(v, j, bv, bj) ((v) > (bv) || ((v) == (bv) && (j) < (bj)))
#define P3_INSERT(v, j) do { const bool b0_ = P3_BETTER(v, j, t0v, t0j), b1_ = P3_BETTER(v, j, t1v, t1j), b2_ = P3_BETTER(v, j, t2v, t2j); \
    t2v = b1_ ? t1v : (b2_ ? (v) : t2v); t2j = b1_ ? t1j : (b2_ ? (j) : t2j); t1v = b0_ ? t0v : (b1_ ? (v) : t1v); t1j = b0_ ? t0j : (b1_ ? (j) : t1j); t0v = b0_ ? (v) : t0v; t0j = b0_ ? (j) : t0j; } while (0)
__device__ __forceinline__ void p3_gate(LAS unsigned char* lds, unsigned char* ws, gu32* ctl, int G, int tid, int wave, int lane, int nost) {
    const bf16* Qb = (const bf16*)(ws + WS_Q); const bf16* kmh = (const bf16*)(ws + WS_KMH); const bf16* kml = (const bf16*)(ws + WS_KML); unsigned* list = (unsigned*)(ws + WS_LIST);
    LAS unsigned* lcnt = (LAS unsigned*)(lds + 32768); LAS unsigned* lbase = (LAS unsigned*)(lds + 32768 + 256);
    const int r = lane & 31, hi = lane >> 5;
    int koff[8];
#pragma unroll
    for (int ds = 0; ds < 8; ++ds) koff[ds] = r * 256 + (((2 * ds + hi) ^ (r & 15)) << 4);
    for (int it = blockIdx.x; it < NH * (NBLK - 1); it += G) {
        const int h = it / (NBLK - 1), qb = 1 + it % (NBLK - 1);
        __syncthreads();
#pragma unroll
        for (int i = 0; i < 2; ++i) { const int n = wave * 2 + i, p = n * 64 + lane, j = p >> 4, pc = p & 15, ck = pc ^ (j & 15);
            __builtin_amdgcn_global_load_lds((const unsigned*)(kmh + ((size_t)h * NBLK + j) * HD + ck * 8), (LAS unsigned*)(lds + n * 1024), 16, 0, 0);
            __builtin_amdgcn_global_load_lds((const unsigned*)(kml + ((size_t)h * NBLK + j) * HD + ck * 8), (LAS unsigned*)(lds + 16384 + n * 1024), 16, 0, 0); }
        if (tid < 64) lcnt[tid] = 0u;
        const int t = qb * BLK + wave * 32 + r;
        bf16x8 qf[8];
#pragma unroll
        for (int ds = 0; ds < 8; ++ds) qf[ds] = *(const bf16x8*)(Qb + (size_t)t * DA + h * HD + 16 * ds + 8 * hi);
        asm volatile("s_waitcnt vmcnt(0)" ::: "memory");
        __syncthreads();
        f32x16g g0, g1;
#pragma unroll
        for (int e = 0; e < 16; ++e) { g0[e] = 0.f; g1[e] = 0.f; }
#pragma unroll
        for (int ds = 0; ds < 8; ++ds) {
            const bf16x8 a0 = *(const LAS bf16x8*)(lds + koff[ds]), a1 = *(const LAS bf16x8*)(lds + koff[ds] + 8192);
            const bf16x8 b0 = *(const LAS bf16x8*)(lds + 16384 + koff[ds]), b1 = *(const LAS bf16x8*)(lds + 16384 + koff[ds] + 8192);
            g0 = __builtin_amdgcn_mfma_f32_32x32x16_bf16(a0, qf[ds], g0, 0, 0, 0); g1 = __builtin_amdgcn_mfma_f32_32x32x16_bf16(a1, qf[ds], g1, 0, 0, 0);
            g0 = __builtin_amdgcn_mfma_f32_32x32x16_bf16(b0, qf[ds], g0, 0, 0, 0); g1 = __builtin_amdgcn_mfma_f32_32x32x16_bf16(b1, qf[ds], g1, 0, 0, 0);
        }
        float vv[32];
#pragma unroll
        for (int e = 0; e < 16; ++e) { const int j = (e & 3) + 8 * (e >> 2) + 4 * hi; vv[e] = j < qb ? g0[e] : -INFINITY; vv[16 + e] = (32 + j) < qb ? g1[e] : -INFINITY; }
        float t0v, t1v, t2v; int t0j, t1j, t2j;
#define P3_SCAN(TV, TJ, SENT) do { TV = -INFINITY; TJ = (SENT); \
    _Pragma("unroll") for (int e = 0; e < 32; ++e) { const int j = 32 * (e >> 4) + ((e & 15) & 3) + 8 * ((e & 15) >> 2) + 4 * hi; if (vv[e] > TV) { TV = vv[e]; TJ = j; } } \
    _Pragma("unroll") for (int e = 0; e < 32; ++e) { const int j = 32 * (e >> 4) + ((e & 15) & 3) + 8 * ((e & 15) >> 2) + 4 * hi; if (j == TJ) vv[e] = -INFINITY; } } while (0)
        P3_SCAN(t0v, t0j, 64); P3_SCAN(t1v, t1j, 65); P3_SCAN(t2v, t2j, 66);
#undef P3_SCAN
        {
            const float p0v = __shfl_xor(t0v, 32), p1v = __shfl_xor(t1v, 32), p2v = __shfl_xor(t2v, 32);
            const int p0j = __shfl_xor(t0j, 32), p1j = __shfl_xor(t1j, 32), p2j = __shfl_xor(t2j, 32);
            P3_INSERT(p0v, p0j); P3_INSERT(p1v, p1j); P3_INSERT(p2v, p2j);
        }
        const int nvalid = qb < 3 ? qb : 3;
        unsigned rk0 = 0u, rk1 = 0u, rk2 = 0u;
        if (hi == 0) {
            rk0 = __hip_atomic_fetch_add(lcnt + t0j, 1u, __ATOMIC_RELAXED, __HIP_MEMORY_SCOPE_WORKGROUP);
            if (nvalid > 1) rk1 = __hip_atomic_fetch_add(lcnt + t1j, 1u, __ATOMIC_RELAXED, __HIP_MEMORY_SCOPE_WORKGROUP);
            if (nvalid > 2) rk2 = __hip_atomic_fetch_add(lcnt + t2j, 1u, __ATOMIC_RELAXED, __HIP_MEMORY_SCOPE_WORKGROUP);
        }
        __syncthreads();
        if (tid < 64) { const unsigned n = lcnt[tid]; lbase[tid] = (n && !nost) ? __hip_atomic_fetch_add((unsigned*)ctl + CW_CNT + h * NBLK + tid, n, __ATOMIC_RELAXED, __HIP_MEMORY_SCOPE_AGENT) : 0u; }
        __syncthreads();
        if (hi == 0 && !nost) {
            list[list_base(h, t0j) + lbase[t0j] + rk0] = (unsigned)t;
            if (nvalid > 1) list[list_base(h, t1j) + lbase[t1j] + rk1] = (1u << 14) | (unsigned)t;
            if (nvalid > 2) list[list_base(h, t2j) + lbase[t2j] + rk2] = (2u << 14) | (unsigned)t;
        }
    }
}

typedef float f32x16 __attribute__((ext_vector_type(16)));
typedef short s16x4 __attribute__((ext_vector_type(4)));
typedef float f32x2_t __attribute__((ext_vector_type(2)));
typedef __bf16 bf16x2_t __attribute__((ext_vector_type(2)));
__device__ __forceinline__ unsigned cvtpk(float lo, float hi) { f32x2_t v = {lo, hi}; bf16x2_t b = __builtin_convertvector(v, bf16x2_t); return __builtin_bit_cast(unsigned, b); }
__device__ __forceinline__ int crow(int r, int hi) { return (r & 3) + 8 * (r >> 2) + 4 * hi; }
constexpr int ATT_K_OFF = 0, ATT_V_OFF = 65536, ATT_PRE_OFF = 131072;
constexpr float ATT_C = ATT_SCALE * 1.4426950408889634f, LN2F = 0.6931471805599453f;

__device__ __forceinline__ void stage_kv(LAS unsigned char* lds, const bf16* Kb, const bf16* Vb, int h, int j, int wave, int lane) {
#pragma unroll
    for (int i = 0; i < 8; ++i) {
        const int n = wave * 8 + i, p = n * 64 + lane, key = p >> 4, pc = p & 15;
        const int ck = pc ^ (key & 15), cv = pc ^ ((key & 3) << 2);
        const size_t ro = (size_t)(j * BLK + key) * DA + h * HD;
        __builtin_amdgcn_global_load_lds((const unsigned*)(Kb + ro + ck * 8), (LAS unsigned*)(lds + ATT_K_OFF + n * 1024), 16, 0, 0);
        __builtin_amdgcn_global_load_lds((const unsigned*)(Vb + ro + cv * 8), (LAS unsigned*)(lds + ATT_V_OFF + n * 1024), 16, 0, 0);
    }
}
#define AT_SB() __builtin_amdgcn_sched_barrier(0)
#define AT_LOADK(HF, KF) do { _Pragma("unroll") for (int i_ = 0; i_ < 4; ++i_) { KF[2 * i_] = *(const LAS bf16x8*)(kb + koff[4 * (HF) + i_]); KF[2 * i_ + 1] = *(const LAS bf16x8*)(kb + koff[4 * (HF) + i_] + 8192); } } while (0)
#define AT_MMAK(HF, KF) do { _Pragma("unroll") for (int i_ = 0; i_ < 4; ++i_) { s0 = __builtin_amdgcn_mfma_f32_32x32x16_bf16(KF[2 * i_], qf[4 * (HF) + i_], s0, 0, 0, 0); s1 = __builtin_amdgcn_mfma_f32_32x32x16_bf16(KF[2 * i_ + 1], qf[4 * (HF) + i_], s1, 0, 0, 0); } } while (0)
#define AT_LOADV(PR, VF) do { _Pragma("unroll") for (int k_ = 0; k_ < 2; ++k_) _Pragma("unroll") for (int db_ = 0; db_ < 4; ++db_) { \
    const s16x4 lo_ = __builtin_bit_cast(s16x4, __builtin_amdgcn_ds_read_tr16_b64_v4i16((LAS s16x4*)(vb + voff[db_] + (2 * (PR) + k_) * 4096))); \
    const s16x4 hi_ = __builtin_bit_cast(s16x4, __builtin_amdgcn_ds_read_tr16_b64_v4i16((LAS s16x4*)(vb + voff[db_] + (2 * (PR) + k_) * 4096 + 2048))); \
    VF[4 * k_ + db_] = (bf16x8){lo_[0], lo_[1], lo_[2], lo_[3], hi_[0], hi_[1], hi_[2], hi_[3]}; } } while (0)
#define AT_MMAV(PR, VF) do { const f32x16& P_ = ((PR) == 0) ? s0 : s1; _Pragma("unroll") for (int k_ = 0; k_ < 2; ++k_) { \
    v4u pw_; pw_.x = cvtpk(P_[8 * k_ + 0], P_[8 * k_ + 1]); pw_.y = cvtpk(P_[8 * k_ + 2], P_[8 * k_ + 3]); pw_.z = cvtpk(P_[8 * k_ + 4], P_[8 * k_ + 5]); pw_.w = cvtpk(P_[8 * k_ + 6], P_[8 * k_ + 7]); \
    const bf16x8 pf_ = __builtin_bit_cast(bf16x8, pw_); \
    _Pragma("unroll") for (int db_ = 0; db_ < 4; ++db_) o[db_] = __builtin_amdgcn_mfma_f32_32x32x16_bf16(VF[4 * k_ + db_], pf_, o[db_], 0, 0, 0); } } while (0)
struct NoHook { __device__ __forceinline__ void operator()(bf16x8 (&)[8]) {} };
template <bool CAUSAL, class Hook>
__device__ __forceinline__ void attn_tile(LAS unsigned char* lds, bf16x8 (&qf)[8], int nsteps, int ql, int lane, float& m, float& l, f32x16 (&o)[4], Hook& hook) {
    const int r = lane & 31, hi = lane >> 5, i16 = lane & 15, g = lane >> 4, kq = i16 >> 2;
    int koff[8], voff[4];
#pragma unroll
    for (int ds = 0; ds < 8; ++ds) koff[ds] = ATT_K_OFF + r * 256 + (((2 * ds + hi) ^ (r & 15)) << 4);
#pragma unroll
    for (int db = 0; db < 4; ++db) voff[db] = ATT_V_OFF + (4 * hi + kq) * 256 + ((db ^ kq) << 6) + ((g & 1) << 5) + (((i16 & 3) >> 1) << 4) + ((i16 & 1) << 3);
    m = -INFINITY; l = 0.f;
#pragma unroll
    for (int db = 0; db < 4; ++db)
#pragma unroll
        for (int e = 0; e < 16; ++e) o[db][e] = 0.f;
#pragma unroll 1
    for (int st = 0; st < nsteps; ++st) {
        f32x16 s0, s1;
#pragma unroll
        for (int e = 0; e < 16; ++e) { s0[e] = 0.f; s1[e] = 0.f; }
        LAS unsigned char* kb = lds + st * 16384; LAS unsigned char* vb = kb;
        bf16x8 fr[8];
        AT_LOADK(0, fr); AT_SB(); AT_MMAK(0, fr); AT_SB();
        AT_LOADK(1, fr); AT_SB(); AT_MMAK(1, fr); AT_SB();
        if (st == nsteps - 1) { hook(qf); AT_SB(); }
        float mx = -INFINITY;
#pragma unroll
        for (int e = 0; e < 16; ++e) {
            if (CAUSAL) { const int key = 64 * st + crow(e, hi); if (key > ql) s0[e] = -INFINITY; if (key + 32 > ql) s1[e] = -INFINITY; }
            mx = fmaxf(mx, fmaxf(s0[e], s1[e]));
        }
        mx = fmaxf(mx, __shfl_xor(mx, 32));
        if (__any(mx > m + (8.0f / ATT_C))) {
            const float mn = fmaxf(m, mx), alpha = __builtin_amdgcn_exp2f((m - mn) * ATT_C);
            m = mn; l *= alpha;
#pragma unroll
            for (int db = 0; db < 4; ++db)
#pragma unroll
                for (int e = 0; e < 16; ++e) o[db][e] *= alpha;
        }
        const float nb = -m * ATT_C;
        float ls = 0.f;
#pragma unroll
        for (int e = 0; e < 16; ++e) { s0[e] = __builtin_amdgcn_exp2f(__builtin_fmaf(s0[e], ATT_C, nb)); s1[e] = __builtin_amdgcn_exp2f(__builtin_fmaf(s1[e], ATT_C, nb)); ls += s0[e] + s1[e]; }
        l += ls;
        AT_SB();
        AT_LOADV(0, fr); AT_SB(); AT_MMAV(0, fr); AT_SB();
        AT_LOADV(1, fr); AT_SB(); AT_MMAV(1, fr); AT_SB();
    }
    m *= ATT_C;
}
__device__ __forceinline__ void half_swap(unsigned& x, unsigned& y) { const auto r_ = __builtin_amdgcn_permlane32_swap(x, y, false, false); x = r_[0]; y = r_[1]; }
constexpr int P4_LCAP = 4096;
#define P4_FETCH(S_, T_, SL_, VALID_, QF_) do { int e_ = (S_) * 32 + r; VALID_ = e_ < n; if (!VALID_) e_ = n - 1; \
    const unsigned ent_ = e_ < P4_LCAP ? llist[e_] : list[lb + e_]; T_ = (int)(ent_ & 16383u); SL_ = (int)(ent_ >> 14); \
    _Pragma("unroll") for (int ds_ = 0; ds_ < 8; ++ds_) QF_[ds_] = *(const bf16x8*)(Qb + (size_t)T_ * DA + h * HD + 16 * ds_ + 8 * hi); } while (0)
struct P4Pref {
    LAS unsigned* lctl; LAS unsigned* llist; const unsigned* list; const bf16* Qb; int lb, n, nsub, h, r, hi, lane;
    int s_n, t_n, sl_n; bool v_n;
    __device__ __forceinline__ void operator()(bf16x8 (&qf)[8]) {
        unsigned sv = 0u; if (lane == 0) sv = __hip_atomic_fetch_add(lctl + 1, 1u, __ATOMIC_RELAXED, __HIP_MEMORY_SCOPE_WORKGROUP);
        s_n = (int)__builtin_amdgcn_readfirstlane(sv);
        if (s_n < nsub) { P4_FETCH(s_n, t_n, sl_n, v_n, qf); }
    }
};
__device__ __forceinline__ void p4_routed(LAS unsigned char* lds, unsigned char* ws, gu32* ctl, int G, int tid, int wave, int lane, int qsel, int nost = 0) {
    LAS unsigned* lctl = (LAS unsigned*)(lds + ATT_PRE_OFF); LAS unsigned* llist = (LAS unsigned*)(lds + ATT_PRE_OFF + 64);
    const bf16* Qb = (const bf16*)(ws + WS_Q); const bf16* Kb = (const bf16*)(ws + WS_K); const bf16* Vb = (const bf16*)(ws + WS_V);
    const unsigned* list = (const unsigned*)(ws + WS_LIST); float* lse = (float*)(ws + WS_LSE);
    const int r = lane & 31, hi = lane >> 5;
    LAS unsigned* lcnt = llist + P4_LCAP;
    lcnt[tid] = __hip_atomic_load((unsigned*)ctl + CW_CNT + tid, __ATOMIC_RELAXED, __HIP_MEMORY_SCOPE_AGENT); lcnt[tid + 512] = __hip_atomic_load((unsigned*)ctl + CW_CNT + tid + 512, __ATOMIC_RELAXED, __HIP_MEMORY_SCOPE_AGENT);
    for (;;) {
        __syncthreads();
        if (tid == 0) { lctl[0] = __hip_atomic_fetch_add((unsigned*)ctl + CW_QHEAD + 64 * qsel, 1u, __ATOMIC_RELAXED, __HIP_MEMORY_SCOPE_AGENT); lctl[1] = 0u; }
        __syncthreads();
        const int i = (int)lctl[0];
        if (i >= NH * (NBLK - 1)) break;
        const int j = i >> 4, h = i & 15;
        const int n = (int)lcnt[h * NBLK + j];
        if (n == 0) continue;
        stage_kv(lds, Kb, Vb, h, j, wave, lane);
        const int lb = list_base(h, j);
        {
            const int nl = n < P4_LCAP ? n : P4_LCAP; unsigned tmp[P4_LCAP / (NWAVES * 64)];
#pragma unroll
            for (int k = 0; k < P4_LCAP / (NWAVES * 64); ++k) { const int e = tid + k * NWAVES * 64; tmp[k] = e < nl ? list[lb + e] : 0u; }
#pragma unroll
            for (int k = 0; k < P4_LCAP / (NWAVES * 64); ++k) { const int e = tid + k * NWAVES * 64; if (e < nl) llist[e] = tmp[k]; }
        }
        asm volatile("s_waitcnt vmcnt(0) lgkmcnt(0)" ::: "memory");
        __syncthreads();
        const int nsub = (n + 31) >> 5;
        int s_cur; { unsigned sv = 0u; if (lane == 0) sv = __hip_atomic_fetch_add(lctl + 1, 1u, __ATOMIC_RELAXED, __HIP_MEMORY_SCOPE_WORKGROUP); s_cur = (int)__builtin_amdgcn_readfirstlane(sv); }
        int t_c = 0, sl_c = 0; bool v_c = false; bf16x8 qc[8];
#pragma unroll
        for (int ds = 0; ds < 8; ++ds) qc[ds] = (bf16x8){0, 0, 0, 0, 0, 0, 0, 0};
        if (s_cur < nsub) P4_FETCH(s_cur, t_c, sl_c, v_c, qc);
        while (s_cur < nsub) {
            P4Pref pf{lctl, llist, list, Qb, lb, n, nsub, h, r, hi, lane, nsub, 0, 0, false};
            float m, l; f32x16 o[4];
            attn_tile<false>(lds, qc, 4, 0, lane, m, l, o, pf);
            const float lt = l + __shfl_xor(l, 32), il = 1.0f / lt;
            v4u ow[4][2];
#pragma unroll
            for (int db = 0; db < 4; ++db)
#pragma unroll
                for (int p = 0; p < 2; ++p) {
                    unsigned x0 = cvtpk(o[db][8 * p] * il, o[db][8 * p + 1] * il), x1 = cvtpk(o[db][8 * p + 2] * il, o[db][8 * p + 3] * il);
                    unsigned y0 = cvtpk(o[db][8 * p + 4] * il, o[db][8 * p + 5] * il), y1 = cvtpk(o[db][8 * p + 6] * il, o[db][8 * p + 7] * il);
                    half_swap(x0, y0); half_swap(x1, y1);
                    ow[db][p] = (v4u){x0, x1, y0, y1}; }
            if (v_c) {
                bf16* So = (bf16*)(ws + (sl_c == 0 ? WS_S0 : (sl_c == 1 ? WS_S1 : WS_S2))) + (size_t)t_c * DA + h * HD + 8 * hi;
#pragma unroll
                for (int db = 0; db < 4; ++db)
#pragma unroll
                    for (int p = 0; p < 2; ++p) *(v4u*)(So + 32 * db + 16 * p) = ow[db][p];
                if (hi == 0) lse[((size_t)sl_c * NH + h) * M + t_c] = (m + __builtin_amdgcn_logf(lt)) * LN2F;
            }
            s_cur = pf.s_n; t_c = pf.t_n; sl_c = pf.sl_n; v_c = pf.v_n;
        }
    }
}
#undef P4_FETCH
__device__ __forceinline__ void p5_own(LAS unsigned char* lds, unsigned char* ws, int G, int wave, int lane, int nost) {
    bf16* Qb = (bf16*)(ws + WS_Q); const bf16* Kb = (const bf16*)(ws + WS_K); const bf16* Vb = (const bf16*)(ws + WS_V);
    const float* lse = (const float*)(ws + WS_LSE);
    const int r = lane & 31, hi = lane >> 5;
    for (int it = blockIdx.x; it < NH * NBLK; it += G) {
        const int h = it & 15, j = it >> 4;
        __syncthreads();
        stage_kv(lds, Kb, Vb, h, j, wave, lane);
        const int t = j * BLK + wave * 32 + r;
        bf16x8 qf[8];
#pragma unroll
        for (int ds = 0; ds < 8; ++ds) qf[ds] = *(const bf16x8*)(Qb + (size_t)t * DA + h * HD + 16 * ds + 8 * hi);
        asm volatile("s_waitcnt vmcnt(0)" ::: "memory");
        __syncthreads();
        float m, l; f32x16 o[4];
        NoHook nh; attn_tile<true>(lds, qf, (wave >> 1) + 1, wave * 32 + r, lane, m, l, o, nh);
        const float lt = l + __shfl_xor(l, 32);
        const int nvalid = j < 3 ? j : 3;
        const float lown = (m + __builtin_amdgcn_logf(lt)) * LN2F;
        float ls[3]; float mx = lown;
#pragma unroll
        for (int s = 0; s < 3; ++s) { ls[s] = (s < nvalid) ? lse[((size_t)s * NH + h) * M + t] : -INFINITY; mx = fmaxf(mx, ls[s]); }
        const float wown = __expf(lown - mx); float wsum = wown; float wv[3];
#pragma unroll
        for (int s = 0; s < 3; ++s) { wv[s] = (s < nvalid) ? __expf(ls[s] - mx) : 0.f; wsum += wv[s]; }
        const float iw = 1.0f / wsum, wo = wown / lt * iw;
        const size_t ro = (size_t)t * DA + h * HD + 8 * hi;
        pg8::u32x2 pq[3][4][4];
        {
            v4u lq[3][4][2];
#pragma unroll
            for (int s = 0; s < 3; ++s)
#pragma unroll
                for (int db = 0; db < 4; ++db)
#pragma unroll
                    for (int p = 0; p < 2; ++p) lq[s][db][p] = (s < nvalid) ? *(const v4u*)((const bf16*)(ws + (s == 0 ? WS_S0 : (s == 1 ? WS_S1 : WS_S2))) + ro + 32 * db + 16 * p) : (v4u){0u, 0u, 0u, 0u};
#pragma unroll
            for (int s = 0; s < 3; ++s)
#pragma unroll
                for (int db = 0; db < 4; ++db)
#pragma unroll
                    for (int p = 0; p < 2; ++p) { unsigned x0 = lq[s][db][p].x, x1 = lq[s][db][p].y, y0 = lq[s][db][p].z, y1 = lq[s][db][p].w; half_swap(x0, y0); half_swap(x1, y1);
                        pq[s][db][2 * p] = (pg8::u32x2){x0, x1}; pq[s][db][2 * p + 1] = (pg8::u32x2){y0, y1}; }
        }
        const float w0 = wv[0] * iw, w1 = wv[1] * iw, w2s = wv[2] * iw;
#pragma unroll
        for (int db = 0; db < 4; ++db)
#pragma unroll
            for (int p = 0; p < 2; ++p) {
                pg8::u32x2 wn[2];
#pragma unroll
                for (int q = 0; q < 2; ++q) { const int g4 = 2 * p + q;
                    float a0 = o[db][4 * g4] * wo, a1 = o[db][4 * g4 + 1] * wo, a2 = o[db][4 * g4 + 2] * wo, a3 = o[db][4 * g4 + 3] * wo;
                    { const pg8::u32x2 pw = pq[0][db][g4]; a0 += w0 * bflo(pw.x); a1 += w0 * bfhi(pw.x); a2 += w0 * bflo(pw.y); a3 += w0 * bfhi(pw.y); }
                    { const pg8::u32x2 pw = pq[1][db][g4]; a0 += w1 * bflo(pw.x); a1 += w1 * bfhi(pw.x); a2 += w1 * bflo(pw.y); a3 += w1 * bfhi(pw.y); }
                    { const pg8::u32x2 pw = pq[2][db][g4]; a0 += w2s * bflo(pw.x); a1 += w2s * bfhi(pw.x); a2 += w2s * bflo(pw.y); a3 += w2s * bfhi(pw.y); }
                    wn[q].x = cvtpk(a0, a1); wn[q].y = cvtpk(a2, a3); }
                unsigned x0 = wn[0].x, x1 = wn[0].y, y0 = wn[1].x, y1 = wn[1].y; half_swap(x0, y0); half_swap(x1, y1);
                *(v4u*)(Qb + ro + 32 * db + 16 * p) = (v4u){x0, x1, y0, y1};
            }
    }
}

__global__ void __launch_bounds__(NWAVES * 64, 2) block_fwd(Args args) {
    extern __shared__ __attribute__((aligned(16))) unsigned char lds_raw[];
    LAS unsigned char* lds = (LAS unsigned char*)lds_raw;
    volatile LAS unsigned* MISC = (volatile LAS unsigned*)(lds + MISC_OFF);
    const int tid = threadIdx.x, lane = tid & 63, wave = __builtin_amdgcn_readfirstlane(tid >> 6), G = gridDim.x;
    unsigned char* ws = args.ws; gu32* ctl = (gu32*)(ws + WS_CTL);
    for (int u = tid; u < (LDS_BYTES - MISC_OFF) / 4; u += NWAVES * 64) ((LAS unsigned*)(lds + MISC_OFF))[u] = 0u;
    __syncthreads();
    XcdBarrier bar; bar.bar = (unsigned*)ctl + CW_BAR + args.bar_off; bar.x = 0; bar.st = nullptr;
    if (args.use_bar) bar = xcd_barrier_post((unsigned*)ctl + CW_BAR + args.bar_off, MISC + 8);
    const int lo = args.ph_lo, hi = args.ph_hi;
#define IN(k) (lo <= (k) && (k) < hi)
#define SEAM(k) do { if (IN(k) && IN((k) + 1)) xcd_barrier(bar); } while (0)
    bf16* const XN = (bf16*)(ws + WS_XN);
    float* const out = args.out;

    if (IN(0)) { p0_prologue(lds, args, G, wave, lane); p0_rope_table(ws, (const int*)args.in[2], G, wave, lane); } SEAM(0);
    if (IN(1)) {
        pg8::Gemm g{XN, (const bf16*)(ws + WS_WIN), M, DIN, D}; pg8::StaticOrder S; S.init(M, DIN, G, (int)blockIdx.x, GEMM_WGM);
        pg8::EpiZ E{(bf16*)(ws + WS_Z), M, args.flags & 1};
        pg8::gemm_phase<pg8::EpiZ, pg8::StaticOrder, true, true>(lds + RING_OFF, g, S, E);
    } SEAM(1);
    if (IN(2)) { p2_qk(lds, ws, (const float*)args.in[5], (const float*)args.in[6], G, tid, args.flags & 2); p2_conv(ws, (const float*)args.in[7], G, wave, lane, args.flags & 2); } SEAM(2);
    if (IN(3)) { p3_gate(lds, ws, ctl, G, tid, wave, lane, args.flags & 2); } SEAM(3);
    if (IN(4)) { p4_routed(lds, ws, ctl, G, tid, wave, lane, (args.flags >> 2) & 1, args.flags & 8); } SEAM(4);
    if (IN(5)) { p5_own(lds, ws, G, wave, lane, args.flags & 2); } SEAM(5);
    if (IN(6)) {
        pg8::Gemm g{(const bf16*)(ws + WS_Q), (const bf16*)(ws + WS_WA), M, D, DA, (size_t)(WS_CB - WS_Q), (size_t)(WS_WC - WS_WA)}; pg8::DualOrder S; S.so.init(M, D, G, (int)blockIdx.x);
        pg8::EpiDual E{(const bf16*)(ws + WS_GA), (const bf16*)(ws + WS_GC), (bf16*)(ws + WS_MERGED), D};
        pg8::gemm_phase<pg8::EpiDual, pg8::DualOrder, true, true>(lds + RING_OFF, g, S, E);
    } SEAM(6);
    if (IN(8)) {
        bf16* const X1B = (bf16*)(ws + WS_X1B);
        pg8::Gemm g{(const bf16*)(ws + WS_MERGED), (const bf16*)(ws + WS_WO), M, D, D}; pg8::StaticOrder S; S.init(M, D, G, (int)blockIdx.x);
        pg8::EpiX1 E{(const float*)args.in[0], X1B, (float*)((unsigned*)ctl + CW_RSS), D};
        pg8::gemm_phase<pg8::EpiX1, pg8::StaticOrder, true, true>(lds + RING_OFF, g, S, E);
        const int gw = blockIdx.x * NWAVES + wave, NGW = G * NWAVES;
        v4u* padf = (v4u*)(X1B - 2 * D); v4u* padb = (v4u*)(X1B + (size_t)M * D);
        for (int i = gw * 64 + lane; i < 2 * D / 8; i += NGW * 64) padf[i] = (v4u){0u, 0u, 0u, 0u};
        for (int i = gw * 64 + lane; i < 128 * D / 8; i += NGW * 64) padb[i] = (v4u){0u, 0u, 0u, 0u};
    }
    if (IN(8)) {
        pg8::Gemm g{(const bf16*)(ws + WS_PB), (const bf16*)(ws + WS_WP), M, D, DPLE}; pg8::StaticOrder S; S.init(M, D, G, (int)blockIdx.x);
        pg8::EpiBf E{(bf16*)(ws + WS_PP), D};
        pg8::gemm_phase<pg8::EpiBf, pg8::StaticOrder, true, true>(lds + RING_OFF, g, S, E);
    } SEAM(8);
    if (IN(11)) {
        pg8::Gemm g{(const bf16*)(ws + WS_X1B) - 2 * D, (const bf16*)(ws + WS_WUP), 65 * 256, 2 * DFF, D, 0, 0, (size_t)254 * D * 2}; pg8::StaticOrder S; S.init(65 * 256, 2 * DFF, G, (int)blockIdx.x, GEMM_WGM);
        pg8::EpiFfn E{(bf16*)(ws + WS_ACT), (const float*)args.in[13], (LAS float*)(lds + RING_BYTES), M, DFF, (const float*)((const unsigned*)ctl + CW_RSS), 1.0f / D, RMS_EPS};
        pg8::gemm_phase<pg8::EpiFfn, pg8::StaticOrder, true, true>(lds + RING_OFF, g, S, E);
        p0_late_weights_queue(lds, args, ctl);
    } SEAM(11);
    if (IN(15)) {
        pg8::Gemm g{(const bf16*)(ws + WS_ACT), (const bf16*)(ws + WS_WDN), M, D, DFF}; pg8::StaticOrder S; S.init(M, D, G, (int)blockIdx.x, 4);
        pg8::EpiX2 E{(const bf16*)(ws + WS_X1B), XN, D};
        pg8::gemm_phase<pg8::EpiX2, pg8::StaticOrder, true, true>(lds + RING_OFF, g, S, E);
    } SEAM(15);
    if (IN(16)) {
        pg8::Gemm g{XN, (const bf16*)(ws + WS_WPG), M, D, D}; pg8::StaticOrder S; S.init(M, D, G, (int)blockIdx.x);
        pg8::EpiOut E{XN, (const bf16*)(ws + WS_PP), out, D};
        pg8::gemm_phase<pg8::EpiOut, pg8::StaticOrder, true, true>(lds + RING_OFF, g, S, E);
    }
#undef IN
#undef SEAM
}

extern "C" void kernel_launch(void* const* d_in, const int* in_sizes, int n_in, void* d_out, int out_size, void* d_ws, size_t ws_size, hipStream_t stream) {
    static int grid = 0;
    if (grid == 0) {
        if (n_in != 17 || in_sizes[0] != M * D || out_size != M * D || ws_size < WS_END) { fprintf(stderr, "kernel_launch: unexpected shapes / workspace (n_in %d, ws %zu, need %zu); nothing launched\n", n_in, ws_size, (size_t)WS_END); grid = -1; return; }
        int dev = 0, cus = 0, per_cu = 0;
        if (hipGetDevice(&dev) != hipSuccess || hipDeviceGetAttribute(&cus, hipDeviceAttributeMultiprocessorCount, dev) != hipSuccess) { grid = -1; return; }
        if (hipFuncSetAttribute((const void*)block_fwd, hipFuncAttributeMaxDynamicSharedMemorySize, LDS_BYTES) != hipSuccess) { fprintf(stderr, "kernel_launch: hipFuncSetAttribute failed\n"); grid = -1; return; }
        if (hipOccupancyMaxActiveBlocksPerMultiprocessor(&per_cu, (const void*)block_fwd, NWAVES * 64, LDS_BYTES) != hipSuccess || per_cu < 1) fprintf(stderr, "kernel_launch: occupancy query reports %d\n", per_cu);
        (void)hipGetLastError();
        grid = cus;
    }
    if (grid < 0) return;
    if (hipMemsetAsync((char*)d_ws + WS_CTL, 0, CTL_ZERO_BYTES, stream) != hipSuccess) return;
    Args a{};
    for (int i = 0; i < 17; ++i) a.in[i] = d_in[i];
    a.out = (float*)d_out; a.ws = (unsigned char*)d_ws; a.bar_off = 0;
#if MK_PER_PHASE
    for (int ph = 0; ph < NPH; ++ph) { a.ph_lo = ph; a.ph_hi = ph + 1; a.use_bar = 0; hipLaunchKernelGGL(block_fwd, dim3(grid), dim3(NWAVES * 64), LDS_BYTES, stream, a); }
#elif PROBE_PHASE >= 0
    a.ph_lo = 0; a.ph_hi = PROBE_PHASE + 1; a.use_bar = 1; a.bar_off = 0;
    hipLaunchKernelGGL(block_fwd, dim3(grid), dim3(NWAVES * 64), LDS_BYTES, stream, a);
    a.ph_lo = PROBE_PHASE; a.ph_hi = PROBE_PHASE + 1; a.use_bar = 0; a.flags = PROBE_FLAGS;
    hipLaunchKernelGGL(block_fwd, dim3(grid), dim3(NWAVES * 64), LDS_BYTES, stream, a);
    a.flags = 0;
    if (PROBE_PHASE + 1 < NPH) { a.ph_lo = PROBE_PHASE + 1; a.ph_hi = NPH; a.use_bar = 1; a.bar_off = XCD_BAR_WORDS;
        hipLaunchKernelGGL(block_fwd, dim3(grid), dim3(NWAVES * 64), LDS_BYTES, stream, a); }
#else
    a.ph_lo = 0; a.ph_hi = NPH; a.use_bar = 1;
    hipLaunchKernelGGL(block_fwd, dim3(grid), dim3(NWAVES * 64), LDS_BYTES, stream, a);
#endif
}
```
